# Optimizing an MI355X kernel written in HIP

```python
import math
import jax
import jax.numpy as jnp
from jax import lax
import numpy as np

D_MODEL = 1024
BATCH = 16
SEQ = 2048
DEPTH = 2

HEAD_DIM = 64
DSA_HEADS = 4
IDX_HEADS = 4
IDX_DIM = 32
DSA_TOPK = 256
MOBA_HEADS = 4
MOBA_BLOCK = 256
MOBA_TOPK = 3
MOBA_Q_CHUNK = 32
MLA_HEADS = 4
MLA_Q_LORA = 384
MLA_KV_LORA = 256
MLA_NOPE = 64
MLA_ROPE = 32
MLA_V = 64
ROPE_THETA = 10000.0
DIL_PATTERNS = ((128, 1), (512, 4), (2048, 16))
DIL_GROUPS = 3
DIL_HEADS = 4
N_BRANCH = 4
BRANCH_WIDTH = 4 * HEAD_DIM
D_FF = 2816
REL_BUCKETS = 32
REL_MAX_DIST = 2048
N_BIAS_HEADS = DSA_HEADS + MOBA_HEADS + DIL_GROUPS * DIL_HEADS
Q_BLOCK = 128
RMS_EPS = 1e-6

IN_SPLITS = (
    DSA_HEADS * HEAD_DIM,
    HEAD_DIM,
    HEAD_DIM,
    IDX_HEADS * IDX_DIM,
    IDX_DIM,
    IDX_HEADS,
    3 * MOBA_HEADS * HEAD_DIM,
    MLA_Q_LORA,
    MLA_KV_LORA,
    MLA_ROPE,
    3 * DIL_GROUPS * DIL_HEADS * HEAD_DIM,
    N_BRANCH * D_MODEL,
)
IN_WIDTH = sum(IN_SPLITS)
IN_OFFSETS = tuple(int(o) for o in np.cumsum(IN_SPLITS)[:-1])

kernel_name = 'hybrid_gated_sparse_mixer_trunk'


def rms_norm(x, gain):
    xf = x.astype(jnp.float32)
    xf = xf * lax.rsqrt(jnp.mean(xf * xf, axis=-1, keepdims=True) + RMS_EPS)
    return (xf * gain.astype(jnp.float32)).astype(x.dtype)


def rel_bucket(dist):
    n = jnp.maximum(dist, 0)
    max_exact = REL_BUCKETS // 2
    nf = jnp.maximum(n, 1).astype(jnp.float32)
    log_b = max_exact + (jnp.log(nf / max_exact) / math.log(REL_MAX_DIST / max_exact)
                         * (REL_BUCKETS - max_exact)).astype(jnp.int32)
    return jnp.where(n < max_exact, n, jnp.minimum(log_b, REL_BUCKETS - 1))


def masked_softmax(logits, mask):
    return jax.nn.softmax(jnp.where(mask, logits, -jnp.inf), axis=-1)


def apply_rope(x, pos):
    half = x.shape[-1] // 2
    freqs = ROPE_THETA ** (-jnp.arange(half, dtype=jnp.float32) / half)
    ang = pos.astype(jnp.float32)[:, None] * freqs[None, :]
    cos = jnp.cos(ang)[None, :, None, :]
    sin = jnp.sin(ang)[None, :, None, :]
    xf = x.astype(jnp.float32)
    x1, x2 = xf[..., :half], xf[..., half:]
    return jnp.concatenate([x1 * cos - x2 * sin, x1 * sin + x2 * cos], axis=-1).astype(x.dtype)


def to_blocks(a, block):
    b, t = a.shape[:2]
    return jnp.swapaxes(a.reshape(b, t // block, block, *a.shape[2:]), 0, 1)


def from_blocks(a):
    a = jnp.swapaxes(a, 0, 1)
    return a.reshape(a.shape[0], a.shape[1] * a.shape[2], *a.shape[3:])


def dsa_attention(q, k, v, iq, ik, iw, bias_table):
    b, t_len, _, dh = q.shape
    n_sel = min(DSA_TOPK, t_len // 4)
    key_pos = jnp.arange(t_len)
    gather = jax.vmap(lambda a, i: a[i])
    scale = dh ** -0.5

    def block(args):
        qb, iqb, iwb, start = args
        t = start + jnp.arange(Q_BLOCK)
        rel = jax.nn.relu(jnp.einsum('bqhc,bsc->bqsh', iqb, ik).astype(jnp.float32) * IDX_DIM ** -0.5)
        score = jnp.einsum('bqsh,bqh->bqs', rel, iwb.astype(jnp.float32))
        score = jnp.where(key_pos[None, None, :] <= t[None, :, None], score, -jnp.inf)
        _, sel = lax.top_k(score, n_sel)
        kg = gather(k, sel)
        vg = gather(v, sel)
        dist = t[None, :, None] - sel
        bias = jnp.moveaxis(bias_table[:, rel_bucket(dist)], 0, 2)
        logits = jnp.einsum('bqhc,bqkc->bqhk', qb, kg).astype(jnp.float32) * scale + bias
        p = masked_softmax(logits, (dist >= 0)[:, :, None, :])
        return jnp.einsum('bqhk,bqkc->bqhc', p.astype(vg.dtype), vg)

    starts = jnp.arange(t_len // Q_BLOCK) * Q_BLOCK
    out = lax.map(block, (to_blocks(q, Q_BLOCK), to_blocks(iq, Q_BLOCK), to_blocks(iw, Q_BLOCK), starts))
    return from_blocks(out)


def moba_attention(q, k, v, bias_table):
    b, t_len, h, dh = q.shape
    nb = -(-t_len // MOBA_BLOCK)
    t_pad = nb * MOBA_BLOCK
    pad = ((0, 0), (0, t_pad - t_len), (0, 0), (0, 0))
    kp = jnp.pad(k, pad)
    vp = jnp.pad(v, pad)
    kb = kp.reshape(b, nb, MOBA_BLOCK, h, dh)
    k_mean = jnp.mean(kb.astype(jnp.float32), axis=2)
    kbh = kb.transpose(0, 3, 1, 2, 4)
    vbh = vp.reshape(b, nb, MOBA_BLOCK, h, dh).transpose(0, 3, 1, 2, 4)
    n_sel = min(MOBA_TOPK, nb - 1)
    blk_ids = jnp.arange(nb)
    offs = jnp.arange(MOBA_BLOCK)
    head_ids = jnp.arange(h)[None, :, None, None]
    gather = jax.vmap(jax.vmap(lambda a, i: a[i]))
    scale = dh ** -0.5
    qc_len = MOBA_Q_CHUNK

    def chunk(args):
        qc, start = args
        t = start + jnp.arange(qc_len)
        own = start // MOBA_BLOCK
        ko = lax.dynamic_slice_in_dim(kp, own * MOBA_BLOCK, MOBA_BLOCK, axis=1)
        vo = lax.dynamic_slice_in_dim(vp, own * MOBA_BLOCK, MOBA_BLOCK, axis=1)
        own_dist = t[:, None] - (own * MOBA_BLOCK + offs)[None, :]
        logits = [jnp.einsum('bqhc,bkhc->bhqk', qc, ko).astype(jnp.float32) * scale
                  + bias_table[:, rel_bucket(own_dist)][None]]
        masks = [jnp.broadcast_to((own_dist >= 0)[None, None], (b, h, qc_len, MOBA_BLOCK))]
        if n_sel > 0:
            gate = jnp.einsum('bqhc,bnhc->bhqn', qc.astype(jnp.float32), k_mean)
            gate = jnp.where(blk_ids < own, gate, -jnp.inf)
            _, sel = lax.top_k(gate, n_sel)
            kg = gather(kbh, sel)
            vg = gather(vbh, sel)
            kpos = sel[..., None] * MOBA_BLOCK + offs
            past_dist = (t[:, None, None] - kpos).reshape(b, h, qc_len, n_sel * MOBA_BLOCK)
            past_logits = jnp.einsum('bqhc,bhqnkc->bhqnk', qc, kg).astype(jnp.float32) * scale
            logits.append(past_logits.reshape(b, h, qc_len, n_sel * MOBA_BLOCK)
                          + bias_table[head_ids, rel_bucket(past_dist)])
            masks.append(jnp.broadcast_to((sel < own)[..., None], sel.shape + (MOBA_BLOCK,))
                         .reshape(b, h, qc_len, n_sel * MOBA_BLOCK))
        p = masked_softmax(jnp.concatenate(logits, axis=-1), jnp.concatenate(masks, axis=-1))
        out = jnp.einsum('bhqk,bkhc->bqhc', p[..., :MOBA_BLOCK].astype(vo.dtype), vo)
        if n_sel > 0:
            p_past = p[..., MOBA_BLOCK:].reshape(b, h, qc_len, n_sel, MOBA_BLOCK)
            out = out + jnp.einsum('bhqnk,bhqnkc->bqhc', p_past.astype(vg.dtype), vg)
        return out

    starts = jnp.arange(t_len // qc_len) * qc_len
    out = lax.map(chunk, (to_blocks(q, qc_len), starts))
    return from_blocks(out)


def causal_dense_attention(q, k, v):
    t_len, c = q.shape[1], q.shape[-1]
    key_pos = jnp.arange(t_len)
    scale = c ** -0.5

    def block(args):
        qb, start = args
        t = start + jnp.arange(Q_BLOCK)
        logits = jnp.einsum('bqhc,bkhc->bhqk', qb, k).astype(jnp.float32) * scale
        p = masked_softmax(logits, key_pos[None, :] <= t[:, None])
        return jnp.einsum('bhqk,bkhc->bqhc', p.astype(v.dtype), v)

    starts = jnp.arange(t_len // Q_BLOCK) * Q_BLOCK
    return from_blocks(lax.map(block, (to_blocks(q, Q_BLOCK), starts)))


def dilated_attention(q, k, v, bias_table):
    b, t_len, _, h, dh = q.shape
    scale = dh ** -0.5
    outs, lses = [], []
    for g, (window, dil) in enumerate(DIL_PATTERNS):
        span = window // dil
        m = t_len // dil
        nbk = -(-m // span)
        mp = nbk * span

        def to_band(a):
            a = a.reshape(b, m, dil, h, dh).transpose(0, 2, 1, 3, 4)
            a = jnp.pad(a, ((0, 0), (0, 0), (0, mp - m), (0, 0), (0, 0)))
            return a.reshape(b, dil, nbk, span, h, dh)

        def with_prev(a):
            prev = jnp.pad(a[:, :, :-1], ((0, 0), (0, 0), (1, 0), (0, 0), (0, 0), (0, 0)))
            return jnp.concatenate([prev, a], axis=3)

        qs = to_band(q[:, :, g])
        kc = with_prev(to_band(k[:, :, g]))
        vc = with_prev(to_band(v[:, :, g]))
        qi = jnp.arange(span)[:, None]
        kj = jnp.arange(2 * span)[None, :]
        dist = span + qi - kj
        key_sub = (jnp.arange(nbk)[:, None, None] - 1) * span + kj[None]
        mask = (dist >= 0) & (dist <= span) & (key_sub >= 0)
        bias = bias_table[g * h:(g + 1) * h][:, rel_bucket(dist * dil)]
        logits = jnp.einsum('brnqhc,brnkhc->brnhqk', qs, kc).astype(jnp.float32) * scale + bias
        logits = jnp.where(mask[:, None], logits, -jnp.inf)
        lse = jax.nn.logsumexp(logits, axis=-1, keepdims=True)
        p = jnp.exp(logits - lse)
        o = jnp.einsum('brnhqk,brnkhc->brnqhc', p.astype(vc.dtype), vc)
        o = o.reshape(b, dil, mp, h, dh)[:, :, :m].transpose(0, 2, 1, 3, 4).reshape(b, t_len, h, dh)
        l = lse[..., 0].transpose(0, 1, 2, 4, 3).reshape(b, dil, mp, h)[:, :, :m]
        l = l.transpose(0, 2, 1, 3).reshape(b, t_len, h)
        outs.append(o)
        lses.append(l)
    alpha = jax.nn.softmax(jnp.stack(lses, axis=0), axis=0)
    return jnp.einsum('gbth,gbthc->bthc', alpha.astype(q.dtype), jnp.stack(outs, axis=0))


def swiglu(h, w_in, w_out):
    gate, up = jnp.split(h @ w_in, 2, axis=-1)
    return (jax.nn.silu(gate) * up) @ w_out


def hybrid_mixer(h, w_in, b_gate, qk_a, qk_b, qk_c, qk_d, mla_nq, w_uq, mla_nkv, w_ukv,
                 w_branch, w_out, rel_bias):
    b, t_len, _ = h.shape
    pos = jnp.arange(t_len)
    (a_q, a_k, a_v, i_q, i_k, i_w, b_qkv, c_q, c_kv, c_kr, d_qkv, gate_logits) = \
        jnp.split(h @ w_in, IN_OFFSETS, axis=-1)

    qa = rms_norm(a_q.reshape(b, t_len, DSA_HEADS, HEAD_DIM), qk_a[0])
    ka = rms_norm(a_k, qk_a[1])
    out_a = dsa_attention(qa, ka, a_v, i_q.reshape(b, t_len, IDX_HEADS, IDX_DIM), i_k,
                          i_w * IDX_HEADS ** -0.5, rel_bias[:DSA_HEADS])

    bqkv = b_qkv.reshape(b, t_len, 3, MOBA_HEADS, HEAD_DIM)
    out_b = moba_attention(rms_norm(bqkv[:, :, 0], qk_b[0]), rms_norm(bqkv[:, :, 1], qk_b[1]),
                           bqkv[:, :, 2], rel_bias[DSA_HEADS:DSA_HEADS + MOBA_HEADS])

    cq = (rms_norm(c_q, mla_nq) @ w_uq).reshape(b, t_len, MLA_HEADS, MLA_NOPE + MLA_ROPE)
    ckv = (rms_norm(c_kv, mla_nkv) @ w_ukv).reshape(b, t_len, MLA_HEADS, MLA_NOPE + MLA_V)
    kfull = jnp.concatenate(
        [ckv[..., :MLA_NOPE], jnp.broadcast_to(c_kr[:, :, None, :], (b, t_len, MLA_HEADS, MLA_ROPE))], axis=-1)
    qn = rms_norm(cq, qk_c[0])
    kn = rms_norm(kfull, qk_c[1])
    qn = jnp.concatenate([qn[..., :MLA_NOPE], apply_rope(qn[..., MLA_NOPE:], pos)], axis=-1)
    kn = jnp.concatenate([kn[..., :MLA_NOPE], apply_rope(kn[..., MLA_NOPE:], pos)], axis=-1)
    out_c = causal_dense_attention(qn, kn, ckv[..., MLA_NOPE:])

    dqkv = d_qkv.reshape(b, t_len, 3, DIL_GROUPS, DIL_HEADS, HEAD_DIM)
    out_d = dilated_attention(rms_norm(dqkv[:, :, 0], qk_d[0]), rms_norm(dqkv[:, :, 1], qk_d[1]),
                              dqkv[:, :, 2], rel_bias[DSA_HEADS + MOBA_HEADS:])

    branches = jnp.stack([o.reshape(b, t_len, BRANCH_WIDTH) for o in (out_a, out_b, out_c, out_d)], axis=2)
    gates = jax.nn.sigmoid(gate_logits.reshape(b, t_len, N_BRANCH, D_MODEL) + b_gate)
    merged = jnp.einsum('btnc,ncd->btnd', branches, w_branch)
    return jnp.sum(gates * merged, axis=2) @ w_out


def setup_inputs(seed: int = 0) -> dict:
    key = jax.random.key(seed)
    ks = jax.random.split(key, 17)

    def nrm(k, shape, scale):
        return scale * jax.random.normal(k, shape, jnp.float32)

    def gain(k, shape):
        return 1.0 + 0.05 * jax.random.normal(k, shape, jnp.float32)

    return {
        'x': nrm(ks[0], (BATCH, SEQ, D_MODEL), 1.0),
        'norm_gain': gain(ks[1], (DEPTH, 3, D_MODEL)),
        'w_in': nrm(ks[2], (DEPTH, D_MODEL, IN_WIDTH), D_MODEL ** -0.5),
        'b_gate': nrm(ks[3], (DEPTH, N_BRANCH, D_MODEL), 0.02),
        'qk_gain_a': gain(ks[4], (DEPTH, 2, HEAD_DIM)),
        'qk_gain_b': gain(ks[5], (DEPTH, 2, HEAD_DIM)),
        'qk_gain_c': gain(ks[6], (DEPTH, 2, MLA_NOPE + MLA_ROPE)),
        'qk_gain_d': gain(ks[7], (DEPTH, 2, HEAD_DIM)),
        'mla_norm_q': gain(ks[8], (DEPTH, MLA_Q_LORA)),
        'w_mla_uq': nrm(ks[9], (DEPTH, MLA_Q_LORA, MLA_HEADS * (MLA_NOPE + MLA_ROPE)), MLA_Q_LORA ** -0.5),
        'mla_norm_kv': gain(ks[10], (DEPTH, MLA_KV_LORA)),
        'w_mla_ukv': nrm(ks[11], (DEPTH, MLA_KV_LORA, MLA_HEADS * (MLA_NOPE + MLA_V)), MLA_KV_LORA ** -0.5),
        'w_branch': nrm(ks[12], (DEPTH, N_BRANCH, BRANCH_WIDTH, D_MODEL), BRANCH_WIDTH ** -0.5),
        'w_out': nrm(ks[13], (DEPTH, D_MODEL, D_MODEL), D_MODEL ** -0.5),
        'rel_bias': nrm(ks[14], (N_BIAS_HEADS, REL_BUCKETS), 0.5),
        'w_ffn_in': nrm(ks[15], (DEPTH, 2, D_MODEL, 2 * D_FF), D_MODEL ** -0.5),
        'w_ffn_out': nrm(ks[16], (DEPTH, 2, D_FF, D_MODEL), D_FF ** -0.5),
    }


def reference(x, norm_gain, w_in, b_gate, qk_gain_a, qk_gain_b, qk_gain_c, qk_gain_d, mla_norm_q,
              w_mla_uq, mla_norm_kv, w_mla_ukv, w_branch, w_out, rel_bias, w_ffn_in, w_ffn_out):
    for l in range(DEPTH):
        x = x + 0.5 * swiglu(rms_norm(x, norm_gain[l, 0]), w_ffn_in[l, 0], w_ffn_out[l, 0])
        x = x + hybrid_mixer(rms_norm(x, norm_gain[l, 1]), w_in[l], b_gate[l], qk_gain_a[l], qk_gain_b[l],
                             qk_gain_c[l], qk_gain_d[l], mla_norm_q[l], w_mla_uq[l], mla_norm_kv[l],
                             w_mla_ukv[l], w_branch[l], w_out[l], rel_bias)
        x = x + 0.5 * swiglu(rms_norm(x, norm_gain[l, 2]), w_ffn_in[l, 1], w_ffn_out[l, 1])
    return x
```

```cpp
#include <hip/hip_runtime.h>
#include <cstdio>
#include <cstdint>
#include <cmath>
namespace pg8 {
#define PG8_LAS __attribute__((address_space(3)))
typedef unsigned short bf16_t;
typedef short bf16x8 __attribute__((ext_vector_type(8)));
typedef float f32x4 __attribute__((ext_vector_type(4)));
typedef unsigned u32x4 __attribute__((ext_vector_type(4)));
constexpr int BM = 256, BK = 64, HALF = 128, HTB = HALF * BK * 2  , STAGE_BYTES = 8 * HTB, NXCD = 8, WGM = 4;

__host__ __device__ __forceinline__ int lds_byte(int r, int c) { const int st = (r >> 4) * 2 + (c >> 5), rr = r & 15, cc = c & 31, ob = rr * 64 + cc * 2; return st * 1024 + (ob ^ (((ob >> 9) & 1) << 5)); }
__host__ __device__ __forceinline__ void stage_rc(int b, int& R, int& C) { const int st = b / 1024, sb = b % 1024, swz = sb ^ (((sb >> 9) & 1) << 5); R = (st >> 1) * 16 + swz / 64; C = (st & 1) * 32 + (swz % 64) / 2; }
__host__ __device__ __forceinline__ int perm32(int rho) { const int n = rho >> 4, i = rho & 15; return 8 * (i >> 2) + 4 * n + (i & 3); }

struct Unit { int pm, pn; int ao, bo; };
struct Gemm { const bf16_t* A; const bf16_t* Bt; int M, N, K; };

struct StaticOrder {
    int nM, nN, nwg, G, c, wgm;
    __host__ __device__ void init(int M, int N, int G_, int c_, int wgm_ = WGM) { nM = M / BM; nN = N / BM; nwg = nM * nN; G = G_; c = c_; wgm = wgm_; }
    __host__ __device__ __forceinline__ bool next(int i, Unit& u) const {
        const long L = (long)i * G + c; if (L >= nwg) return false;
        int wgid = (int)L; { const int q = nwg / NXCD, r = nwg % NXCD, xcd = wgid % NXCD, off = wgid / NXCD; wgid = (xcd < r ? xcd * (q + 1) : r * (q + 1) + (xcd - r) * q) + off; }
        const int nig = wgm * nN, gid = wgid / nig, fm = gid * wgm, gsz = (nM - fm) < wgm ? (nM - fm) : wgm;
        u.pm = fm + ((wgid % nig) % gsz); u.pn = (wgid % nig) / gsz; u.ao = 0; u.bo = 0; return true;
    }
    __device__ __forceinline__ void a_ready(const Unit&) const {}
    __device__ __forceinline__ void done(const Unit&) const {}
};

__device__ __forceinline__ unsigned cvt_pk_bf16(float lo, float hi) { unsigned r; asm volatile("v_cvt_pk_bf16_f32 %0, %1, %2" : "=v"(r) : "v"(lo), "v"(hi)); return r; }
typedef float f32x2 __attribute__((ext_vector_type(2)));
__device__ __forceinline__ const char* uni_ptr(const char* p) { const unsigned long long v = (unsigned long long)p; return (const char*)(((unsigned long long)(unsigned)__builtin_amdgcn_readfirstlane((int)(v >> 32)) << 32) | (unsigned)__builtin_amdgcn_readfirstlane((int)v)); }
template <class Epi, class Sched, bool ALIGN_EPI = false, bool SP2 = false>
__device__ __forceinline__ void gemm_phase(PG8_LAS unsigned char* lds, const Gemm g, const Sched& S, const Epi& E) {
    int tid_ = threadIdx.x; asm volatile("" : "+v"(tid_));
    const int tid = tid_, wid = __builtin_amdgcn_readfirstlane(tid >> 6), lane = tid & 63, wr = wid >> 2, wc = wid & 3, fr = lane & 15, fq = lane >> 4;
    const int K = g.K, nt = K / BK;
    unsigned voffA[2], voffB[2];
#pragma unroll
    for (int i = 0; i < 2; ++i) { int R, C; stage_rc(tid * 16 + i * 8192, R, C); const int Rb = Epi::PERM ? ((R & ~31) + perm32(R & 31)) : R;
        voffA[i] = (unsigned)(R * K + C) * 2u; voffB[i] = (unsigned)(Rb * K + C) * 2u; }
    const size_t kstep = (size_t)(BK * 2);
    const size_t hstep = (size_t)HALF * K * 2;
    const size_t tstep = 2 * hstep;
    const unsigned ldsw = (unsigned)wid * 1024u;
    const int aoff = lds_byte(wr * 64 + fr, fq * 8), boff = lds_byte(wc * 32 + fr, fq * 8);
#define PG8_SA(b, h) (((b) * 2 + (h)) * HTB)
#define PG8_SB(b, h) ((4 + (b) * 2 + (h)) * HTB)
#define PG8_STAGE(bufoff, gbase, voff) do { _Pragma("unroll") for (int _i = 0; _i < 2; ++_i) \
        __builtin_amdgcn_global_load_lds((const unsigned*)((const char*)(gbase) + (voff)[_i]), (PG8_LAS unsigned*)(lds + (bufoff) + ldsw + _i * 8192), 16, 0, 0); } while (0)
#define PG8_LDA(dst, b, h) do { _Pragma("unroll") for (int m = 0; m < 4; ++m) _Pragma("unroll") for (int k = 0; k < 2; ++k) dst[m][k] = *(const PG8_LAS bf16x8*)(lds + PG8_SA(b, h) + aoff + m * 2048 + k * 1024); } while (0)
#define PG8_LDB(dst, b, h) do { _Pragma("unroll") for (int n = 0; n < 2; ++n) _Pragma("unroll") for (int k = 0; k < 2; ++k) dst[n][k] = *(const PG8_LAS bf16x8*)(lds + PG8_SB(b, h) + boff + n * 2048 + k * 1024); } while (0)
#define PG8_MMA(ai, bj, At, Bt) do { __builtin_amdgcn_s_setprio(1); _Pragma("unroll") for (int m = 0; m < 4; ++m) _Pragma("unroll") for (int n = 0; n < 2; ++n) _Pragma("unroll") for (int k = 0; k < 2; ++k) \
        acc[ai][bj][m][n] = __builtin_amdgcn_mfma_f32_16x16x32_bf16(Bt[n][k], At[m][k], acc[ai][bj][m][n], 0, 0, 0); __builtin_amdgcn_s_setprio(0); } while (0)
#define PG8_WAIT_V(n) asm volatile("s_waitcnt vmcnt(" #n ")" ::: "memory")
#define PG8_WAIT_L(n) asm volatile("s_waitcnt lgkmcnt(" #n ")" ::: "memory")
#define PG8_WAIT_VE asm volatile("s_waitcnt vmcnt(%0)" :: "n"(8 + Epi::VM_OPS) : "memory")
#define PG8_BAR __builtin_amdgcn_s_barrier()
#define PG8_SCHED __builtin_amdgcn_sched_barrier(0)
    Unit cur, nxt; int ui = 0;
    if (!S.next(0, cur)) return;
    f32x4 acc[2][2][4][2];
#pragma unroll
    for (int a = 0; a < 2; ++a)
#pragma unroll
        for (int b = 0; b < 2; ++b)
#pragma unroll
            for (int m = 0; m < 4; ++m)
#pragma unroll
                for (int n = 0; n < 2; ++n) acc[a][b][m][n] = (f32x4){0.f, 0.f, 0.f, 0.f};
    bf16x8 At[4][2], B0[2][2], B1[2][2];
    const char* cA = uni_ptr((const char*)g.A + (size_t)cur.pm * tstep + cur.ao); const char* cB = uni_ptr((const char*)g.Bt + (size_t)cur.pn * tstep + cur.bo);
    S.a_ready(cur);
    if constexpr (SP2) {
        PG8_STAGE(PG8_SB(0, 0), cB, voffB); PG8_STAGE(PG8_SB(0, 1), cB + hstep, voffB); PG8_STAGE(PG8_SA(0, 0), cA, voffA); PG8_STAGE(PG8_SA(0, 1), cA + hstep, voffA);
        if (wr == 1) PG8_BAR;
        PG8_WAIT_V(2); PG8_BAR;
        PG8_STAGE(PG8_SB(1, 0), cB + kstep, voffB); PG8_STAGE(PG8_SA(1, 0), cA + kstep, voffA); PG8_STAGE(PG8_SB(1, 1), cB + hstep + kstep, voffB); PG8_STAGE(PG8_SA(1, 1), cA + hstep + kstep, voffA);
        PG8_WAIT_V(8); PG8_BAR;
    } else {
        PG8_STAGE(PG8_SB(0, 0), cB, voffB); PG8_STAGE(PG8_SA(0, 0), cA, voffA); PG8_STAGE(PG8_SB(0, 1), cB + hstep, voffB); PG8_STAGE(PG8_SA(0, 1), cA + hstep, voffA);
        if (wr == 1) PG8_BAR;
        PG8_WAIT_V(4); PG8_BAR;
        PG8_STAGE(PG8_SB(1, 0), cB + kstep, voffB); PG8_STAGE(PG8_SA(1, 0), cA + kstep, voffA); PG8_STAGE(PG8_SB(1, 1), cB + hstep + kstep, voffB);
        PG8_WAIT_V(6); PG8_BAR;
    }
    for (;;) {
        const bool has_next = S.next(ui + 1, nxt);
        const char* nA = uni_ptr(has_next ? (const char*)g.A + (size_t)nxt.pm * tstep + nxt.ao : cA); const char* nB = uni_ptr(has_next ? (const char*)g.Bt + (size_t)nxt.pn * tstep + nxt.bo : cB);
        for (int t = 0; t < nt; t += 2) {
            const bool last = (t == nt - 2);
            const char* a1 = cA + (size_t)(t + 1) * kstep;
            const char* a2 = last ? nA : cA + (size_t)(t + 2) * kstep; const char* b2 = last ? nB : cB + (size_t)(t + 2) * kstep;
            const char* a3 = a2 + kstep; const char* b3 = b2 + kstep;
            if (last && has_next) S.a_ready(nxt);
            if constexpr (SP2) {
            const int fresh = __builtin_amdgcn_readfirstlane((t == 0 && ui > 0) ? 1 : 0);
#define PG8_WAIT_V8F asm volatile("s_waitcnt vmcnt(%1)\n\ts_cmp_lg_u32 %0, 0\n\ts_cbranch_scc1 .Lpg8f%=\n\ts_waitcnt vmcnt(8)\n.Lpg8f%=:" :: "s"(fresh), "n"(8 + Epi::VM_OPS) : "memory", "scc")
            PG8_LDB(B0, 0, 0); PG8_LDB(B1, 0, 1); PG8_SCHED; PG8_LDA(At, 0, 0);
            PG8_WAIT_V8F; PG8_WAIT_L(0); PG8_BAR; PG8_MMA(0, 0, At, B0); PG8_MMA(0, 1, At, B1); PG8_BAR; PG8_SCHED;
            PG8_LDA(At, 0, 1); PG8_STAGE(PG8_SB(0, 0), b2, voffB); PG8_STAGE(PG8_SB(0, 1), b2 + hstep, voffB); PG8_STAGE(PG8_SA(0, 0), a2, voffA);
            PG8_WAIT_V8F; PG8_WAIT_L(0); PG8_BAR; PG8_MMA(1, 0, At, B0); PG8_MMA(1, 1, At, B1); PG8_BAR; PG8_SCHED;
            PG8_LDB(B0, 1, 0); PG8_LDB(B1, 1, 1); PG8_SCHED; PG8_LDA(At, 1, 0); PG8_STAGE(PG8_SA(0, 1), a2 + hstep, voffA);
            PG8_WAIT_V8F; PG8_WAIT_L(0); PG8_BAR; PG8_MMA(0, 0, At, B0); PG8_MMA(0, 1, At, B1); PG8_BAR; PG8_SCHED;
#undef PG8_WAIT_V8F
            PG8_LDA(At, 1, 1); PG8_STAGE(PG8_SB(1, 0), b3, voffB); PG8_STAGE(PG8_SB(1, 1), b3 + hstep, voffB); PG8_STAGE(PG8_SA(1, 0), a3, voffA);
            PG8_WAIT_V(8); PG8_WAIT_L(0); PG8_BAR; PG8_MMA(1, 0, At, B0); PG8_MMA(1, 1, At, B1); PG8_BAR; PG8_SCHED;
            PG8_STAGE(PG8_SA(1, 1), a3 + hstep, voffA); PG8_SCHED;
            } else {
            PG8_LDB(B0, 0, 0); PG8_SCHED; PG8_LDA(At, 0, 0); PG8_STAGE(PG8_SA(1, 1), a1 + hstep, voffA);
            PG8_WAIT_L(8); PG8_BAR; PG8_WAIT_L(0); PG8_MMA(0, 0, At, B0); PG8_BAR; PG8_SCHED;
            PG8_LDB(B1, 0, 1); PG8_STAGE(PG8_SB(0, 0), b2, voffB);
            PG8_BAR; PG8_WAIT_L(0); PG8_MMA(0, 1, At, B1); PG8_BAR;
            PG8_LDA(At, 0, 1); PG8_STAGE(PG8_SA(0, 0), a2, voffA);
            PG8_BAR; PG8_WAIT_L(0); PG8_MMA(1, 0, At, B0); PG8_BAR; PG8_SCHED;
            PG8_STAGE(PG8_SB(0, 1), b2 + hstep, voffB);
            PG8_WAIT_V(6); PG8_BAR; PG8_MMA(1, 1, At, B1); PG8_BAR;
            PG8_LDB(B0, 1, 0); PG8_SCHED; PG8_LDA(At, 1, 0); PG8_STAGE(PG8_SA(0, 1), a2 + hstep, voffA);
            PG8_WAIT_L(8); PG8_BAR; PG8_WAIT_L(0); PG8_MMA(0, 0, At, B0); PG8_BAR; PG8_SCHED;
            PG8_LDB(B1, 1, 1); PG8_STAGE(PG8_SB(1, 0), b3, voffB);
            PG8_BAR; PG8_WAIT_L(0); PG8_MMA(0, 1, At, B1); PG8_BAR;
            PG8_LDA(At, 1, 1); PG8_STAGE(PG8_SA(1, 0), a3, voffA);
            PG8_BAR; PG8_WAIT_L(0); PG8_MMA(1, 0, At, B0); PG8_BAR; PG8_SCHED;
            PG8_STAGE(PG8_SB(1, 1), b3 + hstep, voffB);
            PG8_WAIT_V(6); PG8_BAR; PG8_MMA(1, 1, At, B1); PG8_BAR;
            }
        }
        if constexpr (ALIGN_EPI) { if (wr == 0) PG8_BAR; }
        bool keep_acc = false;
        if constexpr (Epi::CHAIN) { keep_acc = E.chain(acc, cur, wr, wc, fr, fq); S.done(cur); }
        else if constexpr (!Epi::AFTER_DRAIN) { E(acc, cur, wr, wc, fr, fq); S.done(cur); }
        if (!has_next) break;
        if (!keep_acc) {
#pragma unroll
        for (int a = 0; a < 2; ++a)
#pragma unroll
            for (int b = 0; b < 2; ++b)
#pragma unroll
                for (int m = 0; m < 4; ++m)
#pragma unroll
                    for (int n = 0; n < 2; ++n) acc[a][b][m][n] = (f32x4){0.f, 0.f, 0.f, 0.f};
        }
        cur = nxt; cA = nA; cB = nB; ++ui;
        if constexpr (ALIGN_EPI) { if (wr == 1) PG8_BAR; }
    }
    PG8_WAIT_V(0);
    if constexpr (!ALIGN_EPI) { if (wr == 0) PG8_BAR; }
    PG8_BAR;
    if constexpr (Epi::AFTER_DRAIN) { E.fused(acc, cur, wr, wc, fr, fq, lds, wid, lane); S.done(cur); }
#undef PG8_SA
#undef PG8_SB
#undef PG8_STAGE
#undef PG8_LDA
#undef PG8_LDB
#undef PG8_MMA
#undef PG8_WAIT_V
#undef PG8_WAIT_L
#undef PG8_WAIT_VE
#undef PG8_BAR
#undef PG8_SCHED
}
}
#define LAS __attribute__((address_space(3)))
#define XB_TMO      128
#define XB_XCNT(j)  (256  + 64 * (j))
#define XB_XSUB(j)  (1280 + 64 * (j))
#define XB_XGEN(j)  (2304 + 64 * (j))
#define XB_TOP      3328
#define XB_TOPGEN   3392
#define XCD_BAR_WORDS 3456
#define XB_SPIN_CAP (1u << 18)

__device__ __forceinline__ unsigned xb_ld(unsigned* p)              { return __hip_atomic_load(p, __ATOMIC_RELAXED, __HIP_MEMORY_SCOPE_AGENT); }
__device__ __forceinline__ unsigned xb_add(unsigned* p, unsigned v) { return __hip_atomic_fetch_add(p, v, __ATOMIC_RELAXED, __HIP_MEMORY_SCOPE_AGENT); }
__device__ __forceinline__ unsigned xb_xcc_id() { return (unsigned)__builtin_amdgcn_s_getreg((3 << 11) | 20) & 0xFu; }
#define XB_SPIN(cond, bar) do { unsigned _sp = 0; while (cond) { __builtin_amdgcn_s_sleep(1); \
    if ((++_sp & 255u) == 0u) { if (xb_ld(&(bar)[XB_TMO])) break; if (_sp > XB_SPIN_CAP) { atomicAdd(&(bar)[XB_TMO], 1u); break; } } } } while (0)

struct XcdBarrier {
    unsigned* bar; unsigned x;
    volatile LAS unsigned* st;
};

__device__ __forceinline__ XcdBarrier xcd_barrier_post(unsigned* bar, volatile LAS unsigned* st) {
    XcdBarrier b; b.bar = bar; b.x = xb_xcc_id(); b.st = st;
    if (threadIdx.x == 0) (void)xb_add(&bar[XB_XCNT(b.x)], 1u);
    return b;
}
__device__ __forceinline__ void xcd_barrier_complete(unsigned* bar, unsigned x, unsigned& nloc, unsigned& nx) {
    const unsigned G = gridDim.x * gridDim.y * gridDim.z;
    unsigned sum, cnt, mine, sp = 0u;
    for (;;) {
        sum = 0u; cnt = 0u; mine = 0u;
#pragma unroll
        for (unsigned j = 0; j < 16; ++j) { const unsigned c = xb_ld(&bar[XB_XCNT(j)]); sum += c; cnt += (c > 0u) ? 1u : 0u; mine = (j == x) ? c : mine; }
        if (sum == G) break;
        __builtin_amdgcn_s_sleep(1);
        if ((++sp & 255u) == 0u) { if (xb_ld(&bar[XB_TMO])) break; if (sp > XB_SPIN_CAP) { atomicAdd(&bar[XB_TMO], 1u); break; } }
    }
    nloc = mine > 0u ? mine : 1u; nx = cnt > 0u ? cnt : 1u;
}

__device__ __forceinline__ void xcd_barrier(const XcdBarrier& b) {
    asm volatile("s_waitcnt vmcnt(0)" ::: "memory");
    __syncthreads();
    if (threadIdx.x == 0) {
        unsigned* bar = b.bar; unsigned bx = b.x; asm volatile("" : "+s"(bar), "+s"(bx));
        __builtin_amdgcn_s_waitcnt(0);
        unsigned nloc = b.st[0], nx = b.st[1];
        if (nloc == 0u) { xcd_barrier_complete(bar, bx, nloc, nx); b.st[0] = nloc; b.st[1] = nx; }
        const unsigned old = xb_add(&bar[XB_XSUB(bx)], 1u);
        const unsigned gen = old / nloc;
        if (old + 1u == (gen + 1u) * nloc) {
            __builtin_amdgcn_fence(__ATOMIC_RELEASE, "agent");
            asm volatile("s_waitcnt vmcnt(0)" ::: "memory");
            const unsigned og = xb_add(&bar[XB_TOP], 1u);
            const unsigned tg = og / nx;
            if (og + 1u == (tg + 1u) * nx) xb_add(&bar[XB_TOPGEN], 1u);
            else XB_SPIN(xb_ld(&bar[XB_TOPGEN]) == tg, bar);
            __builtin_amdgcn_fence(__ATOMIC_ACQUIRE, "agent");
            xb_add(&bar[XB_XGEN(bx)], 1u);
            asm volatile("s_waitcnt vmcnt(0)" ::: "memory");
        } else {
            XB_SPIN(xb_ld(&bar[XB_XGEN(bx)]) == gen, bar);
            __builtin_amdgcn_fence(__ATOMIC_ACQUIRE, "agent");
            asm volatile("s_waitcnt vmcnt(0)" ::: "memory");
        }
    }
    __syncthreads();
}
typedef unsigned short bf16;
typedef unsigned v4u __attribute__((ext_vector_type(4)));
typedef unsigned v2u __attribute__((ext_vector_type(2)));
typedef float f32x4 __attribute__((ext_vector_type(4)));
typedef float f32x16 __attribute__((ext_vector_type(16)));
typedef short bf16x8 __attribute__((ext_vector_type(8)));
typedef short s16x4 __attribute__((ext_vector_type(4)));
constexpr int DM = 1024, NB = 16, SEQ = 2048, DEPTH = 2, DFF = 2816, INW = 8388;
constexpr int M = NB * SEQ, MH = M / 2, HBAT = NB / 2;
constexpr int O_AQ = 0, O_AK = 256, O_AV = 320, O_IQ = 384, O_IK = 512, O_IW = 544, O_B = 548, O_CQ = 1316, O_CKV = 1700, O_CKR = 1956, O_D = 1988, O_G = 4292;
constexpr int NT_IN = 33, N_INP = NT_IN * 256;
constexpr float EPS = 1e-6f, LOG2E = 1.4426950408889634f;
constexpr float C2A = 0.125f * LOG2E;
constexpr float C2C = 0.10206207261596577f * LOG2E;
constexpr int NWAVES = 8, NTHR = 512;
#ifndef WGM_FFO
#define WGM_FFO 4
#endif
#ifndef WGM_FFI
#define WGM_FFI 4
#endif
#ifndef WGM_INP
#define WGM_INP 4
#endif
constexpr size_t MiB = (size_t)1 << 20;
constexpr size_t WS_CTL = 0, CTL_BYTES = 1 * MiB;
constexpr size_t WS_BIAS = 1 * MiB;
constexpr size_t WS_BIASD = WS_BIAS + 20 * 2112 * 4;
constexpr size_t WS_BID = WS_BIASD + 12 * 192 * 4;
constexpr size_t WS_ROPE = 2 * MiB;
constexpr size_t WS_KMEAN = 3 * MiB;
constexpr size_t WS_WFI = 4 * MiB;
constexpr size_t WS_WFO = 48 * MiB;
constexpr size_t WS_WIN = 70 * MiB;
constexpr size_t WS_WO = 103 * MiB;
constexpr size_t WS_WB = 107 * MiB;
constexpr size_t WS_WUQ = 111 * MiB;
constexpr size_t WS_WUKV = 112 * MiB;
constexpr size_t WS_XB = 113 * MiB;
constexpr size_t WS_SSQ = 177 * MiB;
constexpr size_t WS_R = 180 * MiB;
constexpr size_t TILE_B = (size_t)MH * 256 * 2;
constexpr size_t WS_CQL = WS_R + 2 * TILE_B;
constexpr size_t WS_XS = WS_CQL + (size_t)MH * 384 * 2;
constexpr size_t WS_CKVL = WS_R + 4 * TILE_B;
constexpr size_t WS_DC = WS_R + 2 * TILE_B;
constexpr size_t WS_U = WS_R + 11 * TILE_B;
constexpr size_t WS_QN = 444 * MiB, WS_KN = 456 * MiB, WS_VC = 468 * MiB, WS_OC = 476 * MiB;
constexpr size_t WS_IWF = 484 * MiB;
constexpr size_t WS_SSL = 485 * MiB;
constexpr size_t WS_MASK = 486 * MiB;
constexpr size_t WS_LSED = 490 * MiB;
constexpr size_t WS_END = 492 * MiB;
constexpr int CW_BAR = 4096, CW_QUEUE = 16384, CW_SEAM = 32768;
constexpr int PH_PRO = 0, PH_L0 = 1, PH_PER_LAYER = 16, N_PHASES = 1 + 2 * PH_PER_LAYER;
enum { PO_F1I = 0, PO_F1O = 1, PO_INP = 2, PO_PREP = 3, PO_ATT = 4, PO_CMB = 5, PO_MRG = 6, PO_OUT = 7,   PO_F2I = 14, PO_F2O = 15 };

struct Args { const float* in[17]; float* out; unsigned char* ws; int ph_lo, ph_hi; };

__device__ __forceinline__ float bf2f(bf16 b) { return __uint_as_float(((unsigned)b) << 16); }
__device__ __forceinline__ unsigned f2bf(float f) { unsigned u = __float_as_uint(f); return (u + 0x7fffu + ((u >> 16) & 1u)) >> 16; }
typedef float f32x2_t __attribute__((ext_vector_type(2))); typedef __bf16 bf16x2_t __attribute__((ext_vector_type(2)));
__device__ __forceinline__ unsigned pk2(float lo, float hi) { f32x2_t v = {lo, hi}; bf16x2_t b = __builtin_convertvector(v, bf16x2_t); return __builtin_bit_cast(unsigned, b); }
#define CAS __attribute__((address_space(4)))
__device__ __forceinline__ float bperm_f(int srclane, float v) { return __int_as_float(__builtin_amdgcn_ds_bpermute(srclane << 2, __float_as_int(v))); }
__device__ __forceinline__ int bperm_i(int srclane, int v) { return __builtin_amdgcn_ds_bpermute(srclane << 2, v); }
__device__ __forceinline__ float xsum32(float v) { auto rr = __builtin_amdgcn_permlane32_swap(__float_as_uint(v), __float_as_uint(v), false, false); return __uint_as_float(rr[0]) + __uint_as_float(rr[1]); }
__device__ __forceinline__ float xmax32(float v) { auto rr = __builtin_amdgcn_permlane32_swap(__float_as_uint(v), __float_as_uint(v), false, false); return fmaxf(__uint_as_float(rr[0]), __uint_as_float(rr[1])); }
__host__ __device__ __forceinline__ int inproj_srccol(int n) {
    const int pn = n >> 8, c = n & 255;
    if (pn >= 17) { const int g = pn - 17; return O_G + (g >> 2) * 1024 + (g & 3) * 256 + c; }
    const int slot = (c >> 5) & 3, e = 32 * (c >> 7) + (c & 31);
    switch (pn) {
        case 0: return O_AQ + slot * 64 + e;
        case 1: return slot == 0 ? O_AK + e : slot == 1 ? O_AV + e : O_IQ + (slot - 2) * 64 + e;
        case 2: return O_CQ + slot * 64 + e;
        case 3: if (slot < 2) return O_CQ + 256 + slot * 64 + e; if (slot == 2) return e < 32 ? O_IK + e : O_CKR + (e - 32); return e < 4 ? O_IW + e : -1;
        case 4: return O_CKV + slot * 64 + e;
        default: if (pn <= 7) return O_B + (pn - 5) * 256 + slot * 64 + e; return O_D + (pn - 8) * 256 + slot * 64 + e;
    }
}
__device__ __forceinline__ float row_scale(const float* ssq, int row, int fr, int fq) {
    const f32x4 a = *(const f32x4*)(ssq + (size_t)row * 16 + 4 * fq); float s = (a[0] + a[1]) + (a[2] + a[3]);
    s += bperm_f(((fq ^ 1) << 4) | fr, s); s = xsum32(s);
    return rsqrtf(s * (1.0f / 1024.0f) + EPS);
}
__device__ __forceinline__ void row_scales8(const float* ssq, int row0, int fr, int fq, float (&rs)[2][4]) {
    f32x4 a[2][4];
#pragma unroll
    for (int ai = 0; ai < 2; ++ai)
#pragma unroll
        for (int m = 0; m < 4; ++m) a[ai][m] = *(const f32x4*)(ssq + (size_t)(row0 + ai * 128 + m * 16) * 16 + 4 * fq);
    __builtin_amdgcn_sched_barrier(0);
    float s[2][4], o[2][4];
#pragma unroll
    for (int ai = 0; ai < 2; ++ai)
#pragma unroll
        for (int m = 0; m < 4; ++m) { s[ai][m] = (a[ai][m][0] + a[ai][m][1]) + (a[ai][m][2] + a[ai][m][3]); o[ai][m] = bperm_f(((fq ^ 1) << 4) | fr, s[ai][m]); }
#pragma unroll
    for (int ai = 0; ai < 2; ++ai)
#pragma unroll
        for (int m = 0; m < 4; ++m) rs[ai][m] = rsqrtf(xsum32(s[ai][m] + o[ai][m]) * (1.0f / 1024.0f) + EPS);
}
__device__ __forceinline__ float fast_sigmoid(float x) { return __builtin_amdgcn_rcpf(1.0f + __builtin_amdgcn_exp2f(-x * LOG2E)); }
__device__ __forceinline__ v4u pack8(const f32x4 a, const f32x4 b) { v4u w; w.x = pk2(a[0], a[1]); w.y = pk2(a[2], a[3]); w.z = pk2(b[0], b[1]); w.w = pk2(b[2], b[3]); return w; }

struct EpiFfnIn {
    static constexpr int VM_OPS = 16;
    static constexpr bool CHAIN = false;
    static constexpr bool PERM = true, AFTER_DRAIN = false;
    const float* ssq; bf16* h2;
    __device__ __forceinline__ void operator()(const pg8::f32x4 (&acc)[2][2][4][2], const pg8::Unit& u, int wr, int wc, int fr, int fq) const {
        const int row0 = u.pm * 256 + wr * 64 + fr, colh = u.pn * 128 + wc * 32 + fq * 8;
        float rs[2][4]; row_scales8(ssq, row0, fr, fq, rs);
#pragma unroll
        for (int ai = 0; ai < 2; ++ai)
#pragma unroll
            for (int m = 0; m < 4; ++m) { const int row = row0 + ai * 128 + m * 16; const float s = rs[ai][m], sm = -s * LOG2E, ss = s * s;
                unsigned w[4];
#pragma unroll
                for (int n = 0; n < 2; ++n)
#pragma unroll
                    for (int jp = 0; jp < 2; ++jp) { const f32x2_t a = {acc[ai][0][m][n][2 * jp], acc[ai][0][m][n][2 * jp + 1]}, b = {acc[ai][1][m][n][2 * jp], acc[ai][1][m][n][2 * jp + 1]};
                        const f32x2_t t = a * sm; f32x2_t d = {__builtin_amdgcn_exp2f(t.x), __builtin_amdgcn_exp2f(t.y)}; d = d + 1.0f;
                        const f32x2_t r = {__builtin_amdgcn_rcpf(d.x), __builtin_amdgcn_rcpf(d.y)}, h = ((a * b) * ss) * r; w[2 * n + jp] = pk2(h.x, h.y); }
                v4u wv; wv.x = w[0]; wv.y = w[1]; wv.z = w[2]; wv.w = w[3];
                __builtin_nontemporal_store(wv, (v4u*)(h2 + (size_t)row * DFF + colh)); }
    }
};
struct EpiResid {
    static constexpr int VM_OPS = 32;
    static constexpr bool CHAIN = false;
    static constexpr bool PERM = true, AFTER_DRAIN = false;
    float* out; bf16* xb; float* ssq; float alpha;
    __device__ __forceinline__ void operator()(const pg8::f32x4 (&acc)[2][2][4][2], const pg8::Unit& u, int wr, int wc, int fr, int fq) const {
        const int row0 = u.pm * 256 + wr * 64 + fr, col0 = u.pn * 256 + wc * 32 + fq * 8;
        const bool fin = out != nullptr;
#pragma unroll
        for (int ai = 0; ai < 2; ++ai) {
            v4u bv[4][2];
#pragma unroll
            for (int m = 0; m < 4; ++m)
#pragma unroll
                for (int bj = 0; bj < 2; ++bj) bv[m][bj] = *(const v4u*)(xb + (size_t)(row0 + ai * 128 + m * 16) * DM + col0 + bj * 128);
            __builtin_amdgcn_sched_barrier(0);
#pragma unroll
            for (int m = 0; m < 4; ++m) { const int row = row0 + ai * 128 + m * 16; float ss = 0.f;
#pragma unroll
                for (int bj = 0; bj < 2; ++bj) { const size_t o = (size_t)row * DM + col0 + bj * 128; const v4u b = bv[m][bj];
                    f32x4 x0, x1;
                    x0[0] = __uint_as_float(b.x << 16); x0[1] = __uint_as_float(b.x & 0xffff0000u); x0[2] = __uint_as_float(b.y << 16); x0[3] = __uint_as_float(b.y & 0xffff0000u);
                    x1[0] = __uint_as_float(b.z << 16); x1[1] = __uint_as_float(b.z & 0xffff0000u); x1[2] = __uint_as_float(b.w << 16); x1[3] = __uint_as_float(b.w & 0xffff0000u);
#pragma unroll
                    for (int j = 0; j < 4; ++j) { x0[j] += alpha * acc[ai][bj][m][0][j]; x1[j] += alpha * acc[ai][bj][m][1][j]; ss += x0[j] * x0[j] + x1[j] * x1[j]; }
                    if (fin) { *(f32x4*)(out + o) = x0; *(f32x4*)(out + o + 4) = x1; }
                    *(v4u*)(xb + o) = pack8(x0, x1); }
                ss += bperm_f(((fq ^ 1) << 4) | fr, ss); ss = xsum32(ss);
                if (fq == 0) ssq[(size_t)row * 16 + u.pn * 4 + wc] = ss; }
            __builtin_amdgcn_sched_barrier(0);
        }
    }
};
struct EpiInProj {
    static constexpr int VM_OPS = 24;
    static constexpr bool CHAIN = false;
    static constexpr bool PERM = true, AFTER_DRAIN = false;
    const float* ssq;
    unsigned char* ws;
    const float* g_a; const float* g_b; const float* g_d;
    const float* bgate;
    __device__ __forceinline__ void operator()(const pg8::f32x4 (&acc)[2][2][4][2], const pg8::Unit& u, int wr, int wc, int fr, int fq) const {
        const int pn = u.pn, row0 = u.pm * 256 + wr * 64 + fr;
        bf16* const tiles = (bf16*)(ws + WS_R);
        float rs[2][4]; row_scales8(ssq, row0, fr, fq, rs);
        if (pn >= 17) {
            const int g = pn - 17, nb = g >> 2, ch = g & 3; const float* bg = bgate + nb * 1024 + ch * 256 + wc * 32 + fq * 8;
            f32x4 bv[2][2];
#pragma unroll
            for (int bj = 0; bj < 2; ++bj) { bv[bj][0] = *(const f32x4*)(bg + bj * 128); bv[bj][1] = *(const f32x4*)(bg + bj * 128 + 4); }
            unsigned char* dst = (unsigned char*)(tiles + (size_t)pn * MH * 256) + wc * 32 + fq * 8;
#pragma unroll
            for (int ai = 0; ai < 2; ++ai)
#pragma unroll
                for (int m = 0; m < 4; ++m) { const int row = row0 + ai * 128 + m * 16; const float s = rs[ai][m];
#pragma unroll
                    for (int bj = 0; bj < 2; ++bj) { unsigned q[8];
#pragma unroll
                        for (int j = 0; j < 4; ++j) { q[j] = (unsigned)fmaxf(fast_sigmoid(acc[ai][bj][m][0][j] * s + bv[bj][0][j]) * 255.0f + 0.5f, 1.0f); q[4 + j] = (unsigned)fmaxf(fast_sigmoid(acc[ai][bj][m][1][j] * s + bv[bj][1][j]) * 255.0f + 0.5f, 1.0f); }
                        v2u w; w.x = q[0] | (q[1] << 8) | (q[2] << 16) | (q[3] << 24); w.y = q[4] | (q[5] << 8) | (q[6] << 16) | (q[7] << 24);
                        *(v2u*)(dst + (size_t)row * 256 + bj * 128) = w; } }
            return;
        }
        bf16* dst; int ld; int mode = 0  ; const float* gain = nullptr; float scale = 1.f; float* ssl = nullptr; bool iw = false;
        switch (pn) {
            case 0: dst = tiles + wc * 64; ld = 256; mode = 1; gain = g_a; scale = C2A; break;
            case 1: dst = tiles + (size_t)1 * MH * 256 + wc * 64; ld = 256; if (wc == 0) { mode = 1; gain = g_a + 64; } break;
            case 2: dst = (bf16*)(ws + WS_CQL) + wc * 64; ld = 384; ssl = (float*)(ws + WS_SSL) + wc; break;
            case 3: if (wc < 2) { dst = (bf16*)(ws + WS_CQL) + 256 + wc * 64; ld = 384; ssl = (float*)(ws + WS_SSL) + 4 + wc; } else { dst = (bf16*)(ws + WS_XS) + (wc - 2) * 64; ld = 128; iw = (wc == 3); } break;
            case 4: dst = (bf16*)(ws + WS_CKVL) + wc * 64; ld = 256; ssl = (float*)(ws + WS_SSL) + 6 + wc; break;
            default: dst = tiles + (size_t)pn * MH * 256 + wc * 64; ld = 256;
                if (pn == 5) { mode = 1; gain = g_b; scale = C2A; } else if (pn == 6) { mode = 1; gain = g_b + 64; }
                else if (pn >= 8 && pn <= 10) { mode = 1; gain = g_d; scale = C2A; } else if (pn >= 11 && pn <= 13) { mode = 1; gain = g_d + 64; }
                break;
        }
        f32x4 gv[2][2];
#pragma unroll
        for (int bj = 0; bj < 2; ++bj)
#pragma unroll
            for (int n = 0; n < 2; ++n) gv[bj][n] = mode ? *(const f32x4*)(gain + 32 * bj + 8 * fq + 4 * n) : (f32x4){1.f, 1.f, 1.f, 1.f};
#pragma unroll
        for (int ai = 0; ai < 2; ++ai)
#pragma unroll
            for (int m = 0; m < 4; ++m) { const int row = row0 + ai * 128 + m * 16; const float s = rs[ai][m];
                f32x4 v[2][2]; float ss = 0.f;
#pragma unroll
                for (int bj = 0; bj < 2; ++bj)
#pragma unroll
                    for (int n = 0; n < 2; ++n)
#pragma unroll
                        for (int j = 0; j < 4; ++j) { const float t = acc[ai][bj][m][n][j] * s; v[bj][n][j] = t; ss += t * t; }
                if (mode || ssl) { ss += bperm_f(((fq ^ 1) << 4) | fr, ss); ss = xsum32(ss); }
                if (ssl && fq == 0) ssl[(size_t)row * 16] = ss;
                if (iw && fq == 0) *(f32x4*)((float*)(ws + WS_IWF) + (size_t)row * 4) = v[0][0];
                const float r = mode ? rsqrtf(ss * (1.0f / 64.0f) + EPS) * scale : 1.f;
#pragma unroll
                for (int bj = 0; bj < 2; ++bj) { f32x4 a, b;
#pragma unroll
                    for (int j = 0; j < 4; ++j) { a[j] = v[bj][0][j] * r * gv[bj][0][j]; b[j] = v[bj][1][j] * r * gv[bj][1][j]; }
                    *(v4u*)(dst + (size_t)row * ld + 32 * bj + 8 * fq) = pack8(a, b); } }
    }
};

struct MergeOrder {
    pg8::StaticOrder S; int a1, a2, a3;
    const unsigned* ready; unsigned* tmo;
    __device__ __forceinline__ bool next(int i, pg8::Unit& u) const { pg8::Unit t; if (!S.next(i >> 2, t)) return false; const int n = i & 3; u.pm = t.pm; u.pn = t.pn; u.ao = __builtin_amdgcn_readfirstlane(n == 0 ? 0 : n == 1 ? a1 : n == 2 ? a2 : a3); u.bo = __builtin_amdgcn_readfirstlane(n * (DM * 256 * 2)); return true; }
    __device__ __forceinline__ void a_ready(const pg8::Unit& u) const {
        if (u.bo != 3 * (DM * 256 * 2)) return;
        if (threadIdx.x < 64) { unsigned spins = 0;
            while ((unsigned)__builtin_amdgcn_readfirstlane(__hip_atomic_load(ready + 64 * u.pm, __ATOMIC_RELAXED, __HIP_MEMORY_SCOPE_AGENT)) < 32u) {
                __builtin_amdgcn_s_sleep(2);
                if (++spins > (1u << 22)) { if (threadIdx.x == 0) __hip_atomic_store(tmo, 1u, __ATOMIC_RELAXED, __HIP_MEMORY_SCOPE_AGENT); break; } }
            __builtin_amdgcn_fence(__ATOMIC_ACQUIRE, "agent");
            asm volatile("s_waitcnt vmcnt(0)" ::: "memory"); }
        asm volatile("" ::: "memory"); __builtin_amdgcn_s_barrier(); asm volatile("" ::: "memory");
    }
    __device__ __forceinline__ void done(const pg8::Unit&) const {}
};
struct EpiMerge {
    static constexpr int VM_OPS = 0;
    static constexpr bool PERM = true, AFTER_DRAIN = false, CHAIN = true;
    const bf16* gates;
    bf16* U;
    __device__ __forceinline__ bool chain(pg8::f32x4 (&acc)[2][2][4][2], const pg8::Unit& u, int wr, int wc, int fr, int fq) const {
        const int n = (int)(u.bo / (DM * 256 * 2)); const int row0 = u.pm * 256 + wr * 64 + fr, ct = wc * 32 + fq * 8;
        const unsigned char* gt = (const unsigned char*)(gates + (size_t)(n * 4 + u.pn) * MH * 256) + (size_t)row0 * 256 + ct; bf16* up = U + u.pn * 256 + ct;
        const size_t gnext = (n < 3) ? (size_t)4 * MH * 256 * 2 : 0;
        v2u gv[16], gw[16];
#pragma unroll
        for (int i = 0; i < 16; ++i) { const unsigned char* gp = gt + (size_t)((i >> 3) * 128 + ((i >> 1) & 3) * 16) * 256 + (i & 1) * 128; gv[i] = *(const v2u*)gp; gw[i] = *(const v2u*)(gp + gnext); }
        __builtin_amdgcn_sched_barrier(0);
#pragma unroll
        for (int ai = 0; ai < 2; ++ai)
#pragma unroll
            for (int m = 0; m < 4; ++m) { const int row = row0 + ai * 128 + m * 16;
#pragma unroll
                for (int bj = 0; bj < 2; ++bj) { const v2u a = gv[ai * 8 + m * 2 + bj], b = gw[ai * 8 + m * 2 + bj];
                    if (n < 3) {
#pragma unroll
                        for (int k = 0; k < 4; ++k) { acc[ai][bj][m][0][k] *= (float)((a.x >> (8 * k)) & 0xffu) * __builtin_amdgcn_rcpf((float)((b.x >> (8 * k)) & 0xffu));
                            acc[ai][bj][m][1][k] *= (float)((a.y >> (8 * k)) & 0xffu) * __builtin_amdgcn_rcpf((float)((b.y >> (8 * k)) & 0xffu)); }
                    } else { f32x4 x0, x1; constexpr float Q = 1.0f / 255.0f;
#pragma unroll
                        for (int k = 0; k < 4; ++k) { x0[k] = (float)((a.x >> (8 * k)) & 0xffu) * Q * acc[ai][bj][m][0][k]; x1[k] = (float)((a.y >> (8 * k)) & 0xffu) * Q * acc[ai][bj][m][1][k]; }
                        *(v4u*)(up + (size_t)row * DM + bj * 128) = pack8(x0, x1); } } }
        return n < 3;
    }
};
struct EpiNull {
    static constexpr int VM_OPS = 0;
    static constexpr bool CHAIN = false, PERM = true, AFTER_DRAIN = false;
    float* dummy;
    __device__ __forceinline__ void operator()(const pg8::f32x4 (&acc)[2][2][4][2], const pg8::Unit& u, int wr, int wc, int fr, int fq) const {
        float s = 0.f;
#pragma unroll
        for (int ai = 0; ai < 2; ++ai)
#pragma unroll
            for (int bj = 0; bj < 2; ++bj)
#pragma unroll
                for (int m = 0; m < 4; ++m)
#pragma unroll
                    for (int n = 0; n < 2; ++n) s += acc[ai][bj][m][n][0] + acc[ai][bj][m][n][1] + acc[ai][bj][m][n][2] + acc[ai][bj][m][n][3];
        if (s == 1.2345e-30f) dummy[0] = s;
    }
};
struct EpiFfnInCheap {
    static constexpr int VM_OPS = 0;
    static constexpr bool CHAIN = false;
    static constexpr bool PERM = true, AFTER_DRAIN = false;
    const float* ssq; bf16* h2;
    __device__ __forceinline__ void operator()(const pg8::f32x4 (&acc)[2][2][4][2], const pg8::Unit& u, int wr, int wc, int fr, int fq) const {
        const int row0 = u.pm * 256 + wr * 64 + fr, colh = u.pn * 128 + wc * 32 + fq * 8;
#pragma unroll
        for (int ai = 0; ai < 2; ++ai)
#pragma unroll
            for (int m = 0; m < 4; ++m) { const int row = row0 + ai * 128 + m * 16; f32x4 a = acc[ai][0][m][0] + acc[ai][1][m][0], b = acc[ai][0][m][1] + acc[ai][1][m][1];
#if defined(PROBE_K) && PROBE_K == 4
                __builtin_nontemporal_store(pack8(a, b), (v4u*)(h2 + (size_t)row * DFF + colh)); }
#else
                *(v4u*)(h2 + (size_t)row * DFF + colh) = pack8(a, b); }
#endif
    }
};

struct EpiMergeCheap {
    static constexpr int VM_OPS = 0;
    static constexpr bool PERM = true, AFTER_DRAIN = false, CHAIN = true;
    bf16* U;
    __device__ __forceinline__ bool chain(pg8::f32x4 (&acc)[2][2][4][2], const pg8::Unit& u, int wr, int wc, int fr, int fq) const {
        const int n = (int)(u.bo / (DM * 256 * 2)); const int row0 = u.pm * 256 + wr * 64 + fr, ct = wc * 32 + fq * 8; bf16* up = U + u.pn * 256 + ct;
        if (n == 3) {
#pragma unroll
            for (int ai = 0; ai < 2; ++ai)
#pragma unroll
                for (int m = 0; m < 4; ++m) { const int row = row0 + ai * 128 + m * 16;
#pragma unroll
                    for (int bj = 0; bj < 2; ++bj) *(v4u*)(up + (size_t)row * DM + bj * 128) = pack8(acc[ai][bj][m][0], acc[ai][bj][m][1]); } }
        return n < 3;
    }
};
namespace att {
constexpr int L_BUF = 20480, L_V = 12288;
constexpr int L_BIAS = 3 * L_BUF;
constexpr int L_MASK = L_BIAS + 4 * 2112 * 4;
constexpr int L_BID = L_MASK + 64 * 65 * 4;
constexpr int L_MISC = L_BID + 2112;
constexpr int L_END = L_MISC + 64;
__device__ __forceinline__ void glds16(const void* gsrc, unsigned lds_dst) { unsigned keep;
    asm volatile("s_mov_b32 %0, m0\n\ts_mov_b32 m0, %2\n\ts_nop 0\n\tglobal_load_lds_dwordx4 %1, off\n\ts_mov_b32 m0, %0" : "=&s"(keep) : "v"(gsrc), "s"(lds_dst) : "memory"); }
__device__ __forceinline__ int crow(int r, int hi) { return (r & 3) + 8 * (r >> 2) + 4 * hi; }
__device__ __forceinline__ float max3f(float a, float b, float c) { float r; asm("v_max3_f32 %0, %1, %2, %3" : "=v"(r) : "v"(a), "v"(b), "v"(c)); return r; }
__device__ __forceinline__ unsigned cvtpk(float lo, float hi) { f32x2_t v = {lo, hi}; bf16x2_t b = __builtin_convertvector(v, bf16x2_t); return __builtin_bit_cast(unsigned, b); }
typedef short v4i16_t __attribute__((ext_vector_type(4)));
__device__ __forceinline__ s16x4 vtr(const LAS unsigned char* p) { return __builtin_bit_cast(s16x4, __builtin_amdgcn_ds_read_tr16_b64_v4i16((LAS v4i16_t*)p)); }
#define ATT_WAIT_BAR() asm volatile("s_waitcnt vmcnt(0) lgkmcnt(0)\n\ts_barrier" ::: "memory")
#define ATT_WAIT_BAR_N(N) asm volatile("s_waitcnt vmcnt(" #N ") lgkmcnt(0)\n\ts_barrier" ::: "memory")

struct Unit { int kind, b, h, qt, g, r; };
constexpr int NU_BIG = 768, NU_D0 = 256, NU_D1 = 256, NU_D2 = 512, NU_TOTAL = NU_BIG + NU_D0 + NU_D1 + NU_D2;
__device__ __forceinline__ Unit decode(int idx) {
    Unit u{};
    if (idx < NU_BIG) { const int level = 7 - idx / 96, k = idx % 96;
        if (k < 32) { u.kind = 2; u.b = k >> 2; u.h = k & 3; u.qt = level; }
        else if (k < 64) { u.kind = 1; u.b = (k - 32) >> 2; u.h = k & 3; u.qt = level; }
        else { u.kind = 0; u.b = (k - 64) >> 2; u.qt = 4 * level + 3 - (k & 3); }
        return u; }
    idx -= NU_BIG; u.kind = 3;
    if (idx < NU_D0) { u.g = 0; u.r = 0; u.b = idx >> 5; u.h = (idx >> 3) & 3; u.qt = 7 - (idx & 7); return u; }
    idx -= NU_D0;
    if (idx < NU_D1) { u.g = 1; u.b = idx >> 5; u.h = (idx >> 3) & 3; u.r = (idx >> 1) & 3; u.qt = 1 - (idx & 1); return u; }
    idx -= NU_D1; u.g = 2; u.b = idx >> 6; u.h = (idx >> 4) & 3; u.r = idx & 15; u.qt = 0; return u;
}

template <int KIND> __device__ __forceinline__ void run_unit(unsigned char* ws, LAS unsigned char* lds, const Unit u, const bool dry, unsigned* queue, const bool ahead) {
    constexpr int DQK = (KIND == 2) ? 96 : 64, ND0 = DQK / 16, NCH = DQK / 8;
    int tid_ = threadIdx.x; asm volatile("" : "+v"(tid_));
    const int tid = tid_, lane = tid & 63, r32 = lane & 31, hi = lane >> 5, w = __builtin_amdgcn_readfirstlane(tid >> 6);
    const bf16* const tiles = (const bf16*)(ws + WS_R);
    unsigned pre = 0u; if (ahead && tid == 0) pre = __hip_atomic_fetch_add(queue, 1u, __ATOMIC_RELAXED, __HIP_MEMORY_SCOPE_AGENT);
    const int brow = u.b * SEQ;
    const bf16 *Qp, *Kb, *Vb; bf16* Op; int ldq, ldk, ldv, ldo;
    int tq;
    int kt0, kt1;
    int dil = 1, rr = 0, jb = 0;
    const int head = (KIND == 0) ? (w >> 1) : u.h;
    if constexpr (KIND == 0) { tq = 64 * u.qt + 32 * (w & 1) + r32; ldq = ldk = ldv = ldo = 256;
        Qp = tiles + (size_t)(brow + tq) * 256 + head * 64; Op = (bf16*)Qp; Kb = tiles + (size_t)1 * MH * 256 + (size_t)brow * 256; Vb = Kb + 64; kt0 = 0; kt1 = u.qt; }
    if constexpr (KIND == 1) { tq = 256 * u.qt + 32 * w + r32; ldq = ldk = ldv = ldo = 256;
        Qp = tiles + (size_t)5 * MH * 256 + (size_t)(brow + tq) * 256 + head * 64; Op = (bf16*)Qp; Kb = tiles + (size_t)6 * MH * 256 + (size_t)brow * 256 + head * 64; Vb = tiles + (size_t)7 * MH * 256 + (size_t)brow * 256 + head * 64; kt0 = 0; kt1 = 4 * u.qt + 3; }
    if constexpr (KIND == 2) { tq = 256 * u.qt + 32 * w + r32; ldq = ldk = 384; ldv = ldo = 256;
        Qp = (const bf16*)(ws + WS_QN) + (size_t)(brow + tq) * 384 + head * 96; Op = (bf16*)(ws + WS_OC) + (size_t)(brow + tq) * 256 + head * 64; Kb = (const bf16*)(ws + WS_KN) + (size_t)brow * 384 + head * 96; Vb = (const bf16*)(ws + WS_VC) + (size_t)brow * 256 + head * 64; kt0 = 0; kt1 = 4 * u.qt + 3; }
    if constexpr (KIND == 3) { dil = u.g == 0 ? 1 : u.g == 1 ? 4 : 16; rr = u.r; tq = 256 * u.qt + 32 * w + r32; ldq = ldk = ldv = ldo = 256; jb = 256 * u.qt - 128;
        const int tok = (tq < SEQ / dil ? tq : 0) * dil + rr;
        Qp = tiles + (size_t)(8 + u.g) * MH * 256 + (size_t)(brow + tok) * 256 + head * 64; Op = (bf16*)Qp; Kb = tiles + (size_t)(11 + u.g) * MH * 256 + (size_t)brow * 256 + head * 64; Vb = tiles + (size_t)(14 + u.g) * MH * 256 + (size_t)brow * 256 + head * 64;
        kt0 = (u.qt == 0) ? 2 : 0; kt1 = (u.g == 2) ? 3 : 5; }
    const bool wave_on = (KIND != 3) || (256 * u.qt + 32 * w < SEQ / dil);
    bf16x8 qr[ND0];
#pragma unroll
    for (int d0 = 0; d0 < ND0; ++d0) qr[d0] = *(const bf16x8*)(Qp + 16 * d0 + 8 * hi);
    LAS float* btab = (LAS float*)(lds + L_BIAS);
    if constexpr (KIND == 0) { const float* src = (const float*)(ws + WS_BIAS); for (int i = tid; i < 4 * 2112; i += NTHR) btab[i] = src[i]; }
    if constexpr (KIND == 1) { const float* src = (const float*)(ws + WS_BIAS) + (4 + head) * 2112; for (int i = tid; i < 2112; i += NTHR) btab[i] = src[i]; }
    if constexpr (KIND == 3) { const float* src = (const float*)(ws + WS_BIASD) + (u.g * 4 + head) * 192; if (tid < 256) btab[tid] = tid >= 64 ? src[tid - 64] : 0.f; }
    if constexpr (KIND == 0 || KIND == 1) { if (tid < 132) *(LAS v4u*)(lds + L_BID + 16 * tid) = *(const v4u*)(ws + WS_BID + 16 * tid); }
    unsigned selmask = 0u;
    if constexpr (KIND == 1) {
        const int own = u.qt; const float* km = (const float*)(ws + WS_KMEAN) + (size_t)(u.b * 8) * 256 + head * 64;
        float gate[8];
#pragma unroll
        for (int n = 0; n < 8; ++n) { float a = 0.f;
            if (n < own) {
#pragma unroll
                for (int d0 = 0; d0 < 4; ++d0)
#pragma unroll
                    for (int j = 0; j < 8; ++j) a += bf2f((bf16)qr[d0][j]) * km[n * 256 + 16 * d0 + 8 * hi + j];
                a = xsum32(a); } else a = -INFINITY;
            gate[n] = a; }
#pragma unroll
        for (int rnd = 0; rnd < 3; ++rnd) { int best = -1; float bv = 0.f;
#pragma unroll
            for (int n = 0; n < 8; ++n) { const bool ok = !((selmask >> n) & 1u) && (best < 0 || gate[n] > bv); if (ok) { best = n; bv = gate[n]; } }
            selmask |= 1u << best; }
        selmask &= (1u << own) - 1u;
        if (tid == 0) ((volatile LAS unsigned*)(lds + L_MISC))[1] = 0u;
    }
    const unsigned lds0 = (unsigned)(uintptr_t)lds;
    constexpr int L_VR = 3 * L_V;
    auto tokof = [&](int kt, int j) -> int { if constexpr (KIND == 3) { int jj = jb + 64 * kt + j; jj = jj < 0 ? 0 : jj; return jj * dil + rr; } else return 64 * kt + j; };
    auto dmaK = [&](int kt, int slot) {
        const int tk = tokof(kt, lane);
        glds16(Kb + (size_t)tk * ldk + w * 8, (unsigned)__builtin_amdgcn_readfirstlane(lds0 + slot * L_V + w * 1024));
        if (DQK == 96) glds16(Kb + (size_t)tk * ldk + (8 + (w & 3)) * 8, (unsigned)__builtin_amdgcn_readfirstlane(lds0 + slot * L_V + (8 + (w & 3)) * 1024));
    };
    auto dmaV = [&](int kt, int slot) {
        const int tv = tokof(kt, 16 * (w & 3) + (lane >> 2));
        glds16(Vb + (size_t)tv * ldv + (w >> 2) * 32 + (lane & 3) * 8, (unsigned)__builtin_amdgcn_readfirstlane(lds0 + L_VR + slot * 8192 + w * 1024));
    };
    if constexpr (KIND == 0) {
        const unsigned long long* msrc = (const unsigned long long*)(ws + WS_MASK) + (size_t)((brow + 64 * u.qt) >> 2) * 128; LAS unsigned* mdst = (LAS unsigned*)(lds + L_MASK); const int nw = 2 * (u.qt + 1);
        for (int i = tid; i < 64 * 64; i += NTHR) { const int q = i >> 6, wi = i & 63; if (wi < nw) { const unsigned long long b0 = msrc[(size_t)(q >> 2) * 128 + 2 * wi], b1 = msrc[(size_t)(q >> 2) * 128 + 2 * wi + 1]; const int sh = 16 * (q & 3);
                mdst[q * 65 + wi] = ((unsigned)(b0 >> sh) & 0xffffu) | (((unsigned)(b1 >> sh) & 0xffffu) << 16); } } }
    if constexpr (KIND == 1) { __syncthreads(); if (selmask) (void)__hip_atomic_fetch_or((LAS unsigned*)(lds + L_MISC) + 1, selmask, __ATOMIC_RELAXED, __HIP_MEMORY_SCOPE_WORKGROUP); }
    __syncthreads();
    unsigned umask = 0xffffffffu; if constexpr (KIND == 1) umask = ((volatile LAS unsigned*)(lds + L_MISC))[1];
    asm volatile("s_waitcnt vmcnt(0)" ::: "memory");
#pragma unroll
    for (int d0 = 0; d0 < ND0; ++d0) asm volatile("" : "+v"(qr[d0]));
    asm volatile("" : "+v"(pre)); if (ahead && tid == 0) ((volatile LAS unsigned*)(lds + L_MISC))[2] = pre;
    float mrun = -1e30f; f32x16 o[2], lacc;
#pragma unroll
    for (int i = 0; i < 16; ++i) { o[0][i] = 0.f; o[1][i] = 0.f; lacc[i] = 0.f; }
    const bf16x8 ones = (bf16x8){0x3f80, 0x3f80, 0x3f80, 0x3f80, 0x3f80, 0x3f80, 0x3f80, 0x3f80};
    const LAS unsigned* mrow = (const LAS unsigned*)(lds + L_MASK) + (32 * (w & 1) + r32) * 65;
    auto tile_needed = [&](int kt) -> bool { if constexpr (KIND == 1) { const int blk = kt >> 2; return blk == u.qt || ((umask >> blk) & 1u); } else return true; };
    auto next_tile = [&](int t) -> int { ++t; while (t <= kt1 && !tile_needed(t)) ++t; return t; };
    auto blk_code = [&](int kt, int b) -> int {
        if (!wave_on) return 3;
        if constexpr (KIND == 0) { const int d = 2 * (kt - u.qt) + b - (w & 1); return d < 0 ? 0 : d == 0 ? 1 : 3; }
        if constexpr (KIND == 1) { const int blk = kt >> 2; if (blk == u.qt) { const int d = 2 * (kt & 3) + b - w; return d < 0 ? 0 : d == 0 ? 1 : 3; } return __any((selmask >> blk) & 1u) ? 0 : 3; }
        if constexpr (KIND == 2) { const int d = 2 * kt + b - (8 * u.qt + w); return d < 0 ? 0 : d == 0 ? 1 : 3; }
        if constexpr (KIND == 3) { const int d = 2 * kt + b - w; if (d < 0 || d > 4 || (jb + 64 * kt + 32 * b < 0)) return 3; return d == 4 ? 1 : d == 0 ? 2 : 0; }
        return 0; };
    auto qk = [&](int kslot, f32x16& p0, f32x16& p1) {
        const LAS unsigned char* Ks = lds + kslot * L_V;
        bf16x8 kf[ND0][2];
#pragma unroll
        for (int d0 = 0; d0 < ND0; ++d0) { kf[d0][0] = *(const LAS bf16x8*)(Ks + (2 * d0 + hi) * 1024 + r32 * 16); kf[d0][1] = *(const LAS bf16x8*)(Ks + (2 * d0 + hi) * 1024 + 512 + r32 * 16); }
        __builtin_amdgcn_sched_barrier(0);
#pragma unroll
        for (int i = 0; i < 16; ++i) { p0[i] = 0.f; p1[i] = 0.f; }
#pragma unroll
        for (int d0 = 0; d0 < ND0; ++d0) { p0 = __builtin_amdgcn_mfma_f32_32x32x16_bf16(kf[d0][0], qr[d0], p0, 0, 0, 0); p1 = __builtin_amdgcn_mfma_f32_32x32x16_bf16(kf[d0][1], qr[d0], p1, 0, 0, 0); }
        __builtin_amdgcn_sched_barrier(0); };
    auto sm_pv = [&](int kt, int vslot, int c0, int c1, f32x16& p0, f32x16& p1) {
        const LAS unsigned char* Vs = lds + L_VR + vslot * 8192;
        float cadd = 0.f;
        if constexpr (KIND == 0 || KIND == 1) { const int tqw = tq - r32; int dmin = tqw - 64 * kt - 63, dmax = tqw + 31 - 64 * kt; dmin = dmin < 0 ? 0 : dmin; dmax = dmax < 0 ? 0 : dmax;
            const LAS unsigned char* bid = lds + L_BID + 64; const LAS float* bth = btab + (KIND == 0 ? head * 2112 : 0) + 64;
            if (bid[dmin] == bid[dmax]) cadd = bth[dmin];
            else { const LAS float* bt = bth + (tq - 64 * kt - 4 * hi);
#pragma unroll
                for (int i = 0; i < 16; ++i) { p0[i] += bt[-((i & 3) + 8 * (i >> 2))]; p1[i] += bt[-32 - ((i & 3) + 8 * (i >> 2))]; } }
            if constexpr (KIND == 1) { const int blk = kt >> 2; if (blk != u.qt && !((selmask >> blk) & 1u)) cadd = -INFINITY; } }
        if constexpr (KIND == 3) { const LAS float* bt = btab + 64 + (tq - (jb + 64 * kt + 4 * hi));
#pragma unroll
            for (int i = 0; i < 16; ++i) { p0[i] += bt[-((i & 3) + 8 * (i >> 2))]; p1[i] += bt[-32 - ((i & 3) + 8 * (i >> 2))]; } }
        if (c0 | c1) {
            const int lo0 = (c0 == 2 ? r32 : c0 == 3 ? 64 : 0) - 4 * hi, hi0 = (c0 == 1 ? r32 : c0 == 3 ? -1 : 63) - 4 * hi;
            const int lo1 = (c1 == 2 ? r32 : c1 == 3 ? 64 : 0) - 4 * hi, hi1 = (c1 == 1 ? r32 : c1 == 3 ? -1 : 63) - 4 * hi;
#pragma unroll
            for (int i = 0; i < 16; ++i) { const int c = (i & 3) + 8 * (i >> 2);
                p0[i] = (c < lo0 || c > hi0) ? -INFINITY : p0[i];
                p1[i] = (c < lo1 || c > hi1) ? -INFINITY : p1[i]; } }
        float mxa = max3f(p0[0], p0[1], p1[0]), mxb = max3f(p0[2], p0[3], p1[1]); mxa = max3f(mxa, p1[2], p1[3]);
#pragma unroll
        for (int i = 4; i < 16; i += 4) { mxa = max3f(mxa, p0[i], p0[i + 1]); mxb = max3f(mxb, p0[i + 2], p0[i + 3]); mxa = max3f(mxa, p1[i], p1[i + 1]); mxb = max3f(mxb, p1[i + 2], p1[i + 3]); }
        float mx = xmax32(max3f(mxa, mxb, mxb)) + cadd;
        const float mnew = (mx > mrun + 6.0f) ? mx : mrun;
        if (__any(mnew > mrun)) { const float al = __builtin_amdgcn_exp2f(mrun - mnew);
#pragma unroll
            for (int i = 0; i < 16; ++i) { o[0][i] *= al; o[1][i] *= al; lacc[i] *= al; } }
        mrun = mnew; const float sub = cadd - mnew;
#pragma unroll
        for (int i = 0; i < 16; ++i) { p0[i] = __builtin_amdgcn_exp2f(p0[i] + sub); p1[i] = __builtin_amdgcn_exp2f(p1[i] + sub); }
        if constexpr (KIND == 0) { const int w0 = (int)(mrow[2 * kt] >> (4 * hi)), w1 = (int)(mrow[2 * kt + 1] >> (4 * hi));
#pragma unroll
            for (int i = 0; i < 16; ++i) { const int bp = (i & 3) + 8 * (i >> 2); p0[i] = __int_as_float(__float_as_int(p0[i]) & __builtin_amdgcn_sbfe(w0, bp, 1)); p1[i] = __int_as_float(__float_as_int(p1[i]) & __builtin_amdgcn_sbfe(w1, bp, 1)); } }
        s16x4 vlo[4][2], vhh[4][2];
#pragma unroll
        for (int s = 0; s < 4; ++s)
#pragma unroll
            for (int db = 0; db < 2; ++db) { const LAS unsigned char* vp = Vs + db * 4096 + s * 1024 + ((lane >> 4) & 1) * 32 + (lane & 3) * 8 + (4 * hi + ((lane & 15) >> 2)) * 64; vlo[s][db] = vtr(vp); vhh[s][db] = vtr(vp + 512); }
        bf16x8 pf[4];
#pragma unroll
        for (int s = 0; s < 4; ++s) { v4u pw;
            if (s < 2) { pw.x = cvtpk(p0[8 * s], p0[8 * s + 1]); pw.y = cvtpk(p0[8 * s + 2], p0[8 * s + 3]); pw.z = cvtpk(p0[8 * s + 4], p0[8 * s + 5]); pw.w = cvtpk(p0[8 * s + 6], p0[8 * s + 7]); }
            else { pw.x = cvtpk(p1[8 * s - 16], p1[8 * s - 15]); pw.y = cvtpk(p1[8 * s - 14], p1[8 * s - 13]); pw.z = cvtpk(p1[8 * s - 12], p1[8 * s - 11]); pw.w = cvtpk(p1[8 * s - 10], p1[8 * s - 9]); }
            pf[s] = __builtin_bit_cast(bf16x8, pw); }
        __builtin_amdgcn_sched_barrier(0);
#pragma unroll
        for (int s = 0; s < 4; ++s) {
            lacc = __builtin_amdgcn_mfma_f32_32x32x16_bf16(ones, pf[s], lacc, 0, 0, 0);
#pragma unroll
            for (int db = 0; db < 2; ++db) { const bf16x8 vf = (bf16x8){vlo[s][db][0], vlo[s][db][1], vlo[s][db][2], vlo[s][db][3], vhh[s][db][0], vhh[s][db][1], vhh[s][db][2], vhh[s][db][3]};
                o[db] = __builtin_amdgcn_mfma_f32_32x32x16_bf16(vf, pf[s], o[db], 0, 0, 0); } }
        __builtin_amdgcn_sched_barrier(0); };
#if defined(PROBE_MODE) && PROBE_MODE == 3
    const bool PM_QK = true, PM_SM = !dry;
#elif defined(PROBE_MODE) && PROBE_MODE == 4
    const bool PM_QK = !dry, PM_SM = true;
#elif defined(PROBE_MODE) && PROBE_MODE == 5
    const bool PM_QK = !dry, PM_SM = !dry;
#else
    const bool PM_QK = true, PM_SM = true;
#endif
    constexpr int NOPS = (DQK == 96) ? 3 : 2;
    int cur = next_tile(kt0 - 1), n1 = cur <= kt1 ? next_tile(cur) : cur, n2 = n1 <= kt1 ? next_tile(n1) : n1;
    dmaK(cur, 0);
    if (n1 <= kt1) dmaK(n1, 1);
    dmaV(cur, 0);
    if (n2 <= kt1) { dmaK(n2, 2); dmaV(n1, 1); if (NOPS == 3) ATT_WAIT_BAR_N(3); else ATT_WAIT_BAR_N(2); }
    else { if (n1 <= kt1) dmaV(n1, 1); ATT_WAIT_BAR(); }
    int ks_cur = 0, vs_cur = 0;
    f32x16 sa0, sa1, sb0, sb1;
    { const int c0 = blk_code(cur, 0), c1 = blk_code(cur, 1); if (c0 != 3 || c1 != 3) qk(0, sa0, sa1); }
#define ATT_STEP(x0, x1, y0, y1) { \
        const int n3 = n2 <= kt1 ? next_tile(n2) : n2; \
        const int ks_n1 = ks_cur == 2 ? 0 : ks_cur + 1, vs_n2 = vs_cur == 0 ? 2 : vs_cur - 1; \
        if (n3 <= kt1) { dmaK(n3, ks_cur); dmaV(n2, vs_n2); } else if (n2 <= kt1) dmaV(n2, vs_n2); \
        const int c0 = blk_code(cur, 0), c1 = blk_code(cur, 1); \
        if (n1 <= kt1 && PM_QK) { const int e0 = blk_code(n1, 0), e1 = blk_code(n1, 1); if (e0 != 3 || e1 != 3) qk(ks_n1, y0, y1); } \
        if ((c0 != 3 || c1 != 3) && PM_SM) sm_pv(cur, vs_cur, c0, c1, x0, x1); \
        if (n3 <= kt1) { if (NOPS == 3) ATT_WAIT_BAR_N(3); else ATT_WAIT_BAR_N(2); } else ATT_WAIT_BAR(); \
        cur = n1; n1 = n2; n2 = n3; ks_cur = ks_n1; vs_cur = vs_cur == 2 ? 0 : vs_cur + 1; }
#if defined(PROBE_MODE) && PROBE_MODE == 6
    if (dry) cur = kt1 + 1;
#endif
    while (cur <= kt1) { ATT_STEP(sa0, sa1, sb0, sb1); if (cur > kt1) break; ATT_STEP(sb0, sb1, sa0, sa1); }
#undef ATT_STEP
    if (dry) Op = (bf16*)(ws + WS_END) + (size_t)(tq & 2047) * 256 + head * 64;
    const float lt = lacc[0]; const float inv = 1.0f / lt;
    if (wave_on) {
#pragma unroll
        for (int db = 0; db < 2; ++db)
#pragma unroll
            for (int g4 = 0; g4 < 4; ++g4) { v2u pk; pk.x = cvtpk(o[db][4 * g4] * inv, o[db][4 * g4 + 1] * inv); pk.y = cvtpk(o[db][4 * g4 + 2] * inv, o[db][4 * g4 + 3] * inv);
                *(v2u*)(Op + 32 * db + 8 * g4 + 4 * hi) = pk; }
        if constexpr (KIND == 3) { if (hi == 0 && !dry) { const int tok = tq * dil + rr; ((float*)(ws + WS_LSED))[(size_t)(brow + tok) * 16 + u.g * 4 + head] = mrun + log2f(lt); } }
    }
    __syncthreads();
}

__device__ __forceinline__ void phase(unsigned char* ws, LAS unsigned char* lds, unsigned* queue, const bool dry = false, const unsigned kmask = 15u) {
    if (threadIdx.x == 0) ((volatile LAS unsigned*)(lds + L_MISC))[2] = __hip_atomic_fetch_add(queue, 1u, __ATOMIC_RELAXED, __HIP_MEMORY_SCOPE_AGENT);
    for (;;) {
        __syncthreads();
        const int idx = (int)((volatile LAS unsigned*)(lds + L_MISC))[2];
        __syncthreads();
        if (idx >= NU_TOTAL) break;
        const bool ahead = idx < NU_TOTAL - 512;
        const Unit u = decode(idx);
        if ((kmask >> u.kind) & 1u) {
            if (u.kind == 0) run_unit<0>(ws, lds, u, dry, queue, ahead); else if (u.kind == 1) run_unit<1>(ws, lds, u, dry, queue, ahead); else if (u.kind == 2) run_unit<2>(ws, lds, u, dry, queue, ahead); else run_unit<3>(ws, lds, u, dry, queue, ahead);
            if (!ahead && threadIdx.x == 0) ((volatile LAS unsigned*)(lds + L_MISC))[2] = __hip_atomic_fetch_add(queue, 1u, __ATOMIC_RELAXED, __HIP_MEMORY_SCOPE_AGENT);
        } else if (threadIdx.x == 0) ((volatile LAS unsigned*)(lds + L_MISC))[2] = __hip_atomic_fetch_add(queue, 1u, __ATOMIC_RELAXED, __HIP_MEMORY_SCOPE_AGENT);
    }
}
}
#ifndef SEL_NPASS
#define SEL_NPASS 4
#endif
namespace prep {
constexpr int LQ = 392, LKV = 264;
constexpr int L_CQ = 0, L_CKV = 64 * LQ * 2;
constexpr int L_MISC = 131072 - 64;
constexpr int NU_SEL = HBAT * 64, NU_MLA = MH / 64, NU_KM = HBAT * 8, NU_GEMM = MH / 256, NU_TOTAL = NU_GEMM + NU_SEL + NU_MLA + NU_KM;
__device__ __forceinline__ unsigned fkeyu(float f) { const unsigned u = __float_as_uint(f); return (u & 0x80000000u) ? ~u : (u | 0x80000000u); }

__device__ __forceinline__ void mla_unit(unsigned char* ws, LAS unsigned char* lds, int l, int unit, const float* qk_c, const unsigned pv = 0u) {
    int tid_ = threadIdx.x; asm volatile("" : "+v"(tid_));
    const int tid = tid_, lane = tid & 63, r32 = lane & 31, hi = lane >> 5, w = __builtin_amdgcn_readfirstlane(tid >> 6), row0 = unit * 64;
    { const bf16* cql = (const bf16*)(ws + WS_CQL) + (size_t)row0 * 384; const bf16* ckvl = (const bf16*)(ws + WS_CKVL) + (size_t)row0 * 256;
#pragma unroll
      for (int i = 0; i < 6; ++i) { const int c = tid + 512 * i, r = c / 48, ch = c % 48; *(LAS v4u*)(lds + L_CQ + (r * LQ + ch * 8) * 2) = *(const v4u*)(cql + (size_t)r * 384 + ch * 8); }
#pragma unroll
      for (int i = 0; i < 4; ++i) { const int c = tid + 512 * i, r = c >> 5, ch = c & 31; *(LAS v4u*)(lds + L_CKV + (r * LKV + ch * 8) * 2) = *(const v4u*)(ckvl + (size_t)r * 256 + ch * 8); } }
    __syncthreads();
    const float* ssl = (const float*)(ws + WS_SSL); const float* rope = (const float*)(ws + WS_ROPE); const bf16* xs = (const bf16*)(ws + WS_XS);
    if (w < 4) {
        const int h = w; const bf16* wt = (const bf16*)(ws + WS_WUQ) + (size_t)l * 384 * 384 + (size_t)(h * 96) * 384;
        f32x16 acc[3][2];
#pragma unroll
        for (int a = 0; a < 3; ++a)
#pragma unroll
            for (int b = 0; b < 2; ++b)
#pragma unroll
                for (int i = 0; i < 16; ++i) acc[a][b][i] = 0.f;
        bf16x8 wf[3][6];
        const bf16* wl = wt + (size_t)r32 * 384 + 8 * hi;
#define MLQ_ISSUE(st, pr) { _Pragma("unroll") for (int nb = 0; nb < 3; ++nb) { \
            asm volatile("global_load_dwordx4 %0, %1, off" : "=v"(wf[st][nb]) : "v"(wl + (size_t)(32 * nb) * 384 + 32 * (pr)) : "memory"); \
            asm volatile("global_load_dwordx4 %0, %1, off" : "=v"(wf[st][3 + nb]) : "v"(wl + (size_t)(32 * nb) * 384 + 32 * (pr) + 16) : "memory"); } }
#define MLQ_COMPUTE(st, pr) { bf16x8 bfr[2], bgr[2]; \
            _Pragma("unroll") for (int tb = 0; tb < 2; ++tb) { bfr[tb] = *(const LAS bf16x8*)(lds + L_CQ + ((32 * tb + r32) * LQ + 32 * (pr) + 8 * hi) * 2); bgr[tb] = *(const LAS bf16x8*)(lds + L_CQ + ((32 * tb + r32) * LQ + 32 * (pr) + 16 + 8 * hi) * 2); } \
            _Pragma("unroll") for (int nb = 0; nb < 3; ++nb) _Pragma("unroll") for (int tb = 0; tb < 2; ++tb) acc[nb][tb] = __builtin_amdgcn_mfma_f32_32x32x16_bf16(wf[st][nb], bfr[tb], acc[nb][tb], 0, 0, 0); \
            _Pragma("unroll") for (int nb = 0; nb < 3; ++nb) _Pragma("unroll") for (int tb = 0; tb < 2; ++tb) acc[nb][tb] = __builtin_amdgcn_mfma_f32_32x32x16_bf16(wf[st][3 + nb], bgr[tb], acc[nb][tb], 0, 0, 0); }
        asm volatile("s_waitcnt vmcnt(0)" ::: "memory");
        if (!(pv & 2u)) {
        MLQ_ISSUE(0, 0); MLQ_ISSUE(1, 1);
#pragma unroll
        for (int pr = 0; pr < 12; ++pr) {
            if (pr + 2 < 12) { MLQ_ISSUE((pr + 2) % 3, pr + 2); asm volatile("s_waitcnt vmcnt(12)" ::: "memory"); }
            else if (pr + 1 < 12) asm volatile("s_waitcnt vmcnt(6)" ::: "memory"); else asm volatile("s_waitcnt vmcnt(0)" ::: "memory");
#pragma unroll
            for (int k = 0; k < 6; ++k) asm volatile("" : "+v"(wf[pr % 3][k]));
            MLQ_COMPUTE(pr % 3, pr);
        }
        }
#undef MLQ_ISSUE
#undef MLQ_COMPUTE
        bf16* QN = (bf16*)(ws + WS_QN);
        if (!(pv & 1u))
#pragma unroll
        for (int tb = 0; tb < 2; ++tb) { const int row = row0 + 32 * tb + r32, t = row % SEQ; const float* sp = ssl + (size_t)row * 16;
            const float slat = rsqrtf(((sp[0] + sp[1]) + (sp[2] + sp[3]) + (sp[4] + sp[5])) * (1.0f / 384.0f) + EPS);
            float ss = 0.f;
#pragma unroll
            for (int nb = 0; nb < 3; ++nb)
#pragma unroll
                for (int i = 0; i < 16; ++i) { const float v = acc[nb][tb][i] * slat; acc[nb][tb][i] = v; ss += v * v; }
            ss = xsum32(ss); const float hs = rsqrtf(ss * (1.0f / 96.0f) + EPS) * C2C;
#pragma unroll
            for (int nb = 0; nb < 3; ++nb)
#pragma unroll
                for (int i = 0; i < 16; ++i) acc[nb][tb][i] *= hs * qk_c[32 * nb + att::crow(i, hi)];
#pragma unroll
            for (int i = 0; i < 8; ++i) { const int j = att::crow(i, hi); const float c = rope[t * 16 + j], s = rope[SEQ * 16 + t * 16 + j]; const float x1 = acc[2][tb][i], x2 = acc[2][tb][i + 8]; acc[2][tb][i] = x1 * c - x2 * s; acc[2][tb][i + 8] = x1 * s + x2 * c; }
#pragma unroll
            for (int nb = 0; nb < 3; ++nb)
#pragma unroll
                for (int g4 = 0; g4 < 4; ++g4) { v2u pk; pk.x = pk2(acc[nb][tb][4 * g4], acc[nb][tb][4 * g4 + 1]); pk.y = pk2(acc[nb][tb][4 * g4 + 2], acc[nb][tb][4 * g4 + 3]); *(v2u*)(QN + (size_t)row * 384 + h * 96 + 32 * nb + 8 * g4 + 4 * hi) = pk; } }
    } else {
        const int h = w - 4; const bf16* wt = (const bf16*)(ws + WS_WUKV) + (size_t)l * 512 * 256 + (size_t)(h * 128) * 256;
        f32x16 acc[4][2];
#pragma unroll
        for (int a = 0; a < 4; ++a)
#pragma unroll
            for (int b = 0; b < 2; ++b)
#pragma unroll
                for (int i = 0; i < 16; ++i) acc[a][b][i] = 0.f;
        bf16x8 wf[4][4];
        const bf16* wl = wt + (size_t)r32 * 256 + 8 * hi;
#define MLK_ISSUE(st, ks) { _Pragma("unroll") for (int nb = 0; nb < 4; ++nb) asm volatile("global_load_dwordx4 %0, %1, off" : "=v"(wf[st][nb]) : "v"(wl + (size_t)(32 * nb) * 256 + 16 * (ks)) : "memory"); }
        asm volatile("s_waitcnt vmcnt(0)" ::: "memory");
        if (!(pv & 2u)) {
        MLK_ISSUE(0, 0); MLK_ISSUE(1, 1); MLK_ISSUE(2, 2);
#pragma unroll
        for (int ks = 0; ks < 16; ++ks) {
            if (ks + 3 < 16) { MLK_ISSUE((ks + 3) % 4, ks + 3); asm volatile("s_waitcnt vmcnt(12)" ::: "memory"); }
            else if (ks + 2 < 16) asm volatile("s_waitcnt vmcnt(8)" ::: "memory"); else if (ks + 1 < 16) asm volatile("s_waitcnt vmcnt(4)" ::: "memory"); else asm volatile("s_waitcnt vmcnt(0)" ::: "memory");
#pragma unroll
            for (int k = 0; k < 4; ++k) asm volatile("" : "+v"(wf[ks % 4][k]));
            bf16x8 bfr[2];
#pragma unroll
            for (int tb = 0; tb < 2; ++tb) bfr[tb] = *(const LAS bf16x8*)(lds + L_CKV + ((32 * tb + r32) * LKV + 16 * ks + 8 * hi) * 2);
#pragma unroll
            for (int nb = 0; nb < 4; ++nb)
#pragma unroll
                for (int tb = 0; tb < 2; ++tb) acc[nb][tb] = __builtin_amdgcn_mfma_f32_32x32x16_bf16(wf[ks % 4][nb], bfr[tb], acc[nb][tb], 0, 0, 0);
        }
        }
#undef MLK_ISSUE
        bf16* KN = (bf16*)(ws + WS_KN); bf16* VC = (bf16*)(ws + WS_VC);
        if (!(pv & 1u))
#pragma unroll
        for (int tb = 0; tb < 2; ++tb) { const int row = row0 + 32 * tb + r32, t = row % SEQ; const float* sp = ssl + (size_t)row * 16;
            const float slat = rsqrtf(((sp[6] + sp[7]) + (sp[8] + sp[9])) * (1.0f / 256.0f) + EPS);
            float kr[16]; float ss = 0.f;
#pragma unroll
            for (int g4 = 0; g4 < 4; ++g4) { const v2u v = *(const v2u*)(xs + (size_t)row * 128 + 32 + 8 * g4 + 4 * hi); kr[4 * g4] = __uint_as_float(v.x << 16); kr[4 * g4 + 1] = __uint_as_float(v.x & 0xffff0000u); kr[4 * g4 + 2] = __uint_as_float(v.y << 16); kr[4 * g4 + 3] = __uint_as_float(v.y & 0xffff0000u); }
#pragma unroll
            for (int i = 0; i < 16; ++i) ss += kr[i] * kr[i];
#pragma unroll
            for (int nb = 0; nb < 2; ++nb)
#pragma unroll
                for (int i = 0; i < 16; ++i) { const float v = acc[nb][tb][i] * slat; acc[nb][tb][i] = v; ss += v * v; }
            ss = xsum32(ss); const float hs = rsqrtf(ss * (1.0f / 96.0f) + EPS);
#pragma unroll
            for (int nb = 0; nb < 2; ++nb)
#pragma unroll
                for (int i = 0; i < 16; ++i) acc[nb][tb][i] *= hs * qk_c[96 + 32 * nb + att::crow(i, hi)];
#pragma unroll
            for (int i = 0; i < 16; ++i) kr[i] *= hs * qk_c[96 + 64 + att::crow(i, hi)];
#pragma unroll
            for (int i = 0; i < 8; ++i) { const int j = att::crow(i, hi); const float c = rope[t * 16 + j], s = rope[SEQ * 16 + t * 16 + j]; const float x1 = kr[i], x2 = kr[i + 8]; kr[i] = x1 * c - x2 * s; kr[i + 8] = x1 * s + x2 * c; }
#pragma unroll
            for (int g4 = 0; g4 < 4; ++g4) {
#pragma unroll
                for (int nb = 0; nb < 2; ++nb) { v2u pk; pk.x = pk2(acc[nb][tb][4 * g4], acc[nb][tb][4 * g4 + 1]); pk.y = pk2(acc[nb][tb][4 * g4 + 2], acc[nb][tb][4 * g4 + 3]); *(v2u*)(KN + (size_t)row * 384 + h * 96 + 32 * nb + 8 * g4 + 4 * hi) = pk; }
                { v2u pk; pk.x = pk2(kr[4 * g4], kr[4 * g4 + 1]); pk.y = pk2(kr[4 * g4 + 2], kr[4 * g4 + 3]); *(v2u*)(KN + (size_t)row * 384 + h * 96 + 64 + 8 * g4 + 4 * hi) = pk; }
#pragma unroll
                for (int nb = 2; nb < 4; ++nb) { v2u pk; pk.x = pk2(acc[nb][tb][4 * g4] * slat, acc[nb][tb][4 * g4 + 1] * slat); pk.y = pk2(acc[nb][tb][4 * g4 + 2] * slat, acc[nb][tb][4 * g4 + 3] * slat); *(v2u*)(VC + (size_t)row * 256 + h * 64 + 32 * (nb - 2) + 8 * g4 + 4 * hi) = pk; } } }
    }
    __syncthreads();
}

__device__ __forceinline__ void sel_unit(unsigned char* ws, LAS unsigned char* lds, int unit, const int npass = 4, const bool ties = true, const bool force_simple = false) {
    int tid_ = threadIdx.x; asm volatile("" : "+v"(tid_));
    const int tid = tid_, lane = tid & 63, c16 = lane & 15, g = lane >> 4, w = __builtin_amdgcn_readfirstlane(tid >> 6);
    const int b = unit & 7, qblk = 63 - (unit >> 3), t0 = 32 * qblk + 4 * w, brow = b * SEQ;
    const bf16* t1 = (const bf16*)(ws + WS_R) + (size_t)1 * MH * 256; const bf16* xs = (const bf16*)(ws + WS_XS) + (size_t)brow * 128; const float* iwf = (const float*)(ws + WS_IWF);
    const int tq = t0 + g;
    const int nkt = (t0 + 3) / 16 + 1;
    const bf16x8 af = *(const bf16x8*)(t1 + (size_t)(brow + t0 + (c16 >> 2)) * 256 + 128 + (c16 & 3) * 32 + 8 * g);
    const f32x4 wv = *(const f32x4*)(iwf + (size_t)(brow + tq) * 4);
    constexpr float WS_ = 0.5f * 0.17677669529663687f;
    const float w0 = wv[0] * WS_, w1 = wv[1] * WS_, w2 = wv[2] * WS_, w3 = wv[3] * WS_;
    unsigned key[128];
    const int nblk = (nkt + 15) >> 4;
    const bf16* xsl = xs + (size_t)c16 * 128 + 8 * g;
#pragma unroll
    for (int blk = 0; blk < 8; ++blk) {
        if (blk < nblk) {
            bf16x8 bc[16];
#pragma unroll
            for (int rr = 0; rr < 16; ++rr) bc[rr] = *(const bf16x8*)(xsl + (size_t)(16 * (16 * blk + rr)) * 128);
            __builtin_amdgcn_sched_barrier(0);
#pragma unroll
            for (int rr = 0; rr < 16; ++rr) { const int r = 16 * blk + rr;
                pg8::f32x4 cz = {0.f, 0.f, 0.f, 0.f}; const pg8::f32x4 d = __builtin_amdgcn_mfma_f32_16x16x32_bf16(af, bc[rr], cz, 0, 0, 0);
                const float sc = __builtin_fmaf(fmaxf(d[3], 0.f), w3, __builtin_fmaf(fmaxf(d[2], 0.f), w2, __builtin_fmaf(fmaxf(d[1], 0.f), w1, fmaxf(d[0], 0.f) * w0)));
                key[r] = (16 * r + c16 <= tq) ? fkeyu(sc) : 0u; }
            __builtin_amdgcn_sched_barrier(0);
        } else {
#pragma unroll
            for (int rr = 0; rr < 16; ++rr) key[16 * blk + rr] = 0u;
        }
    }
    LAS unsigned* H = (LAS unsigned*)(lds + w * 4608) + g * 272;
    unsigned prefix = 0u; int rank = 256;
#pragma unroll 1
    for (int pass = 0; pass < npass; ++pass) { const int shift = 24 - 8 * pass;
#pragma unroll
        for (int j = 0; j < 4; ++j) *(LAS v4u*)(H + 16 * c16 + 4 * j) = (v4u){0u, 0u, 0u, 0u};
        H[256 + c16] = 0u;
        const unsigned hp = pass == 0 ? 0u : (prefix >> ((shift + 8) & 31)); const unsigned hmask = pass == 0 ? 0u : 0xffffffffu;
#pragma unroll
        for (int blk = 0; blk < 8; ++blk) if (blk < nblk) {
#pragma unroll
            for (int rr = 0; rr < 16; ++rr) { const unsigned k = key[16 * blk + rr]; const bool mt = (((k >> ((shift + 8) & 31)) & hmask) == hp); const unsigned bin = mt ? ((k >> shift) & 255u) : (unsigned)(256 + c16);
                (void)__hip_atomic_fetch_add(H + bin, 1u, __ATOMIC_RELAXED, __HIP_MEMORY_SCOPE_WORKGROUP); } }
        unsigned hv[16];
#pragma unroll
        for (int j = 0; j < 4; ++j) { const v4u t = *(const LAS v4u*)(H + 16 * c16 + 4 * j); hv[4 * j] = t[0]; hv[4 * j + 1] = t[1]; hv[4 * j + 2] = t[2]; hv[4 * j + 3] = t[3]; }
        int sc = 0;
#pragma unroll
        for (int j = 0; j < 16; ++j) sc += (int)hv[j];
        int suf = sc;
#pragma unroll
        for (int d = 1; d < 16; d <<= 1) { const int o = bperm_i(lane + d, suf); if (c16 + d < 16) suf += o; }
        const int above_lane = suf - sc;
        const bool cross = (above_lane < rank) && (rank <= suf);
        int B = 0, above = 0;
        if (cross) { int run2 = above_lane; bool found = false;
#pragma unroll
            for (int j = 15; j >= 0; --j) { if (!found) { if (run2 + (int)hv[j] >= rank) { B = 16 * c16 + j; above = run2; found = true; } else run2 += (int)hv[j]; } } }
        const unsigned m16 = (unsigned)(__ballot(cross) >> (16 * g)) & 0xffffu;
        const int src = m16 ? (__ffs(m16) - 1) : 0;
        B = bperm_i((lane & 48) + src, B); above = bperm_i((lane & 48) + src, above);
        if (!m16) { B = 0; above = 0; }
        prefix |= (unsigned)B << shift; rank -= above;
    }
    const unsigned T = prefix; const int need = rank;
    unsigned long long mw0 = 0ull, mw1 = 0ull;
    const int cnt_eq = npass > 0 ? (int)H[T & 255u] : 0;
    const bool simple = (__all(cnt_eq == need && T != 0u) && ties) || force_simple;
    if (simple) {
#pragma unroll
        for (int blk = 0; blk < 8; ++blk) if (blk < nblk) {
#pragma unroll
            for (int rr = 0; rr < 16; ++rr) { const int r = 16 * blk + rr; const unsigned long long bs = __ballot(key[r] >= T);
                if (r < 64) mw0 = (lane == r) ? bs : mw0; else mw1 = (lane == r - 64) ? bs : mw1; } }
    } else {
        int run = 0;
#pragma unroll
        for (int blk = 0; blk < 8; ++blk) if (blk < nblk) {
#pragma unroll
            for (int rr = 0; rr < 16; ++rr) { const int r = 16 * blk + rr;
                const bool eq = key[r] == T; const unsigned long long bal = __ballot(eq); const unsigned m16 = (unsigned)(bal >> (16 * g)) & 0xffffu;
                const int rk = run + __popc(m16 & ((1u << c16) - 1u)); run += __popc(m16);
                const unsigned long long bs = __ballot((key[r] > T || (eq && rk < need)) && (16 * r + c16 <= tq));
                if (r < 64) mw0 = (lane == r) ? bs : mw0; else mw1 = (lane == r - 64) ? bs : mw1; } }
    }
    unsigned long long* mq = (unsigned long long*)(ws + WS_MASK) + (size_t)((brow + t0) >> 2) * 128;
    mq[lane] = mw0; mq[64 + lane] = mw1;
}
__device__ __forceinline__ void km_unit(unsigned char* ws, LAS unsigned char* lds, int unit) {
    int tid_ = threadIdx.x; asm volatile("" : "+v"(tid_)); const int tid = tid_, lane = tid & 63, w = tid >> 6; const int b = unit >> 3, n = unit & 7;
    const bf16* bk = (const bf16*)(ws + WS_R) + (size_t)6 * MH * 256 + (size_t)(b * SEQ + n * 256 + 32 * w) * 256 + 4 * lane;
    v2u v[32];
#pragma unroll
    for (int i = 0; i < 32; ++i) v[i] = *(const v2u*)(bk + (size_t)i * 256);
    float s0 = 0.f, s1 = 0.f, s2 = 0.f, s3 = 0.f;
#pragma unroll
    for (int i = 0; i < 32; ++i) { s0 += __uint_as_float(v[i].x << 16); s1 += __uint_as_float(v[i].x & 0xffff0000u); s2 += __uint_as_float(v[i].y << 16); s3 += __uint_as_float(v[i].y & 0xffff0000u); }
    LAS f32x4* red = (LAS f32x4*)lds; red[w * 64 + lane] = (f32x4){s0, s1, s2, s3};
    __syncthreads();
    if (w == 0) { f32x4 t = red[lane];
#pragma unroll
        for (int k = 1; k < 8; ++k) t += red[k * 64 + lane];
        *(f32x4*)((float*)(ws + WS_KMEAN) + (size_t)unit * 256 + 4 * lane) = t * (1.0f / 256.0f); }
    __syncthreads();
}
struct OneUnit { int pm, pn;
    __device__ __forceinline__ bool next(int i, pg8::Unit& u) const { if (i > 0) return false; u.pm = pm; u.pn = pn; u.ao = 0; u.bo = 0; return true; }
    __device__ __forceinline__ void a_ready(const pg8::Unit&) const {}
    __device__ __forceinline__ void done(const pg8::Unit&) const {} };
__device__ __forceinline__ void phase(unsigned char* ws, LAS unsigned char* lds, int l, const float* qk_c, unsigned* queue, const pg8::Gemm& gg, const EpiInProj& ge, const unsigned kmask = 15u) {
    for (;;) {
        if (threadIdx.x == 0) ((volatile LAS unsigned*)(lds + L_MISC))[0] = __hip_atomic_fetch_add(queue, 1u, __ATOMIC_RELAXED, __HIP_MEMORY_SCOPE_AGENT);
        __syncthreads();
        const int idx = (int)((volatile LAS unsigned*)(lds + L_MISC))[0];
        __syncthreads();
        if (idx >= NU_TOTAL) break;
        if (idx < NU_GEMM) { if (kmask & 8u) { OneUnit S1{idx, NT_IN - 1}; pg8::gemm_phase<EpiInProj, OneUnit, true, true>(lds, gg, S1, ge); __syncthreads(); } }
        else if (idx < NU_GEMM + NU_KM) { if (kmask & 1u) km_unit(ws, lds, idx - NU_GEMM); }
        else if (idx < NU_GEMM + NU_KM + NU_SEL / 2) { if (kmask & 2u) sel_unit(ws, lds, idx - NU_GEMM - NU_KM, (kmask & 16u) ? 0 : 4, !(kmask & 32u), (kmask & 64u) != 0u); }
        else if (idx < NU_GEMM + NU_KM + NU_SEL / 2 + NU_MLA) { if (kmask & 4u) mla_unit(ws, lds, l, idx - NU_GEMM - NU_KM - NU_SEL / 2, qk_c, kmask >> 7); }
        else { if (kmask & 2u) sel_unit(ws, lds, idx - NU_GEMM - NU_KM - NU_MLA, (kmask & 16u) ? 0 : 4, !(kmask & 32u), (kmask & 64u) != 0u); }
    }
}
}
constexpr int RING_BYTES = 131072, MISC_OFF = RING_BYTES + 320, LDS_BYTES = 147456;
#define LDS_WAIT() asm volatile("s_waitcnt lgkmcnt(0)" ::: "memory")
#define VM_WAIT() asm volatile("s_waitcnt vmcnt(0)" ::: "memory")

template <class CM> __device__ __forceinline__ void tr_item(const float* W, int ldw, int K, const float* rowgain, bf16* WT, int nblk, int item, LAS float* scr, int lane, CM cm) {
    const int kb = item / nblk, nb = item % nblk, k0 = 64 * kb, n0 = 32 * nb;
    const int sc = cm(n0 + (lane & 31));
    float tv[32];
#pragma unroll
    for (int i = 0; i < 32; ++i) { const int kk = 2 * i + (lane >> 5); tv[i] = sc >= 0 ? W[(size_t)(k0 + kk) * ldw + sc] : 0.f; }
#pragma unroll
    for (int i = 0; i < 32; ++i) { const int kk = 2 * i + (lane >> 5); float v = tv[i]; if (rowgain) v *= rowgain[k0 + kk]; scr[kk * 33 + (lane & 31)] = v; }
    LDS_WAIT(); asm volatile("" ::: "memory");
    const int c = lane & 7;
#pragma unroll
    for (int j = 0; j < 4; ++j) { const int n = (lane >> 3) + 8 * j; const LAS float* s = scr + (8 * c) * 33 + n;
        v4u o; o.x = pk2(s[0 * 33], s[1 * 33]); o.y = pk2(s[2 * 33], s[3 * 33]); o.z = pk2(s[4 * 33], s[5 * 33]); o.w = pk2(s[6 * 33], s[7 * 33]);
        *(v4u*)(WT + (size_t)(n0 + n) * K + k0 + 8 * c) = o; }
    LDS_WAIT(); asm volatile("" ::: "memory");
}
struct CmId { __device__ __forceinline__ int operator()(int n) const { return n; } };
struct CmFfnIn { __device__ __forceinline__ int operator()(int n) const { const int pn = n >> 8, c = n & 255; return c < 128 ? pn * 128 + c : DFF + pn * 128 + (c - 128); } };
struct CmInProj { __device__ __forceinline__ int operator()(int n) const { return inproj_srccol(n); } };
__device__ __forceinline__ int rel_bucket_dev(int n) { if (n < 16) return n; const int lb = 16 + (int)(logf((float)n / 16.f) / logf(128.f) * 16.f); return lb < 31 ? lb : 31; }

__device__ __forceinline__ void prologue(const Args& a, LAS unsigned char* lds, int vcu, int G, int wave, int lane) {
    unsigned char* ws = a.ws;
    LAS float* scr = (LAS float*)(lds + wave * 16384);
    const int gw = vcu * NWAVES + wave, NGW = G * NWAVES;
    const float* norm_gain = a.in[1]; const float* w_in = a.in[2]; const float* mla_nq = a.in[8]; const float* w_uq = a.in[9]; const float* mla_nkv = a.in[10]; const float* w_ukv = a.in[11];
    const float* w_branch = a.in[12]; const float* w_out = a.in[13]; const float* rel_bias = a.in[14]; const float* w_ffn_in = a.in[15]; const float* w_ffn_out = a.in[16];
    constexpr int I_FI = 16 * (5632 / 32), I_FO = 44 * 32, I_IN = 16 * (N_INP / 32), I_O = 16 * 32, I_B = 4 * 32, I_UQ = 6 * 12, I_UKV = 4 * 16;
    constexpr int NITEMS = 4 * I_FI + 4 * I_FO + 2 * I_IN + 2 * I_O + 8 * I_B + 2 * I_UQ + 2 * I_UKV;
    for (int it = gw; it < NITEMS; it += NGW) {
        int r = it;
        if (r < 4 * I_FI) { const int w = r / I_FI, l = w >> 1, f = w & 1; tr_item(w_ffn_in + (size_t)w * DM * 2 * DFF, 2 * DFF, DM, norm_gain + (l * 3 + (f ? 2 : 0)) * DM, (bf16*)(ws + WS_WFI) + (size_t)w * 5632 * DM, 5632 / 32, r % I_FI, scr, lane, CmFfnIn()); continue; } r -= 4 * I_FI;
        if (r < 4 * I_FO) { const int w = r / I_FO; tr_item(w_ffn_out + (size_t)w * DFF * DM, DM, DFF, nullptr, (bf16*)(ws + WS_WFO) + (size_t)w * DM * DFF, 32, r % I_FO, scr, lane, CmId()); continue; } r -= 4 * I_FO;
        if (r < 2 * I_IN) { const int l = r / I_IN; tr_item(w_in + (size_t)l * DM * INW, INW, DM, norm_gain + (l * 3 + 1) * DM, (bf16*)(ws + WS_WIN) + (size_t)l * N_INP * DM, N_INP / 32, r % I_IN, scr, lane, CmInProj()); continue; } r -= 2 * I_IN;
        if (r < 2 * I_O) { const int l = r / I_O; tr_item(w_out + (size_t)l * DM * DM, DM, DM, nullptr, (bf16*)(ws + WS_WO) + (size_t)l * DM * DM, 32, r % I_O, scr, lane, CmId()); continue; } r -= 2 * I_O;
        if (r < 8 * I_B) { const int w = r / I_B; tr_item(w_branch + (size_t)w * 256 * DM, DM, 256, nullptr, (bf16*)(ws + WS_WB) + (size_t)w * DM * 256, 32, r % I_B, scr, lane, CmId()); continue; } r -= 8 * I_B;
        if (r < 2 * I_UQ) { const int l = r / I_UQ; tr_item(w_uq + (size_t)l * 384 * 384, 384, 384, mla_nq + l * 384, (bf16*)(ws + WS_WUQ) + (size_t)l * 384 * 384, 12, r % I_UQ, scr, lane, CmId()); continue; } r -= 2 * I_UQ;
        { const int l = r / I_UKV; tr_item(w_ukv + (size_t)l * 256 * 512, 512, 256, mla_nkv + l * 256, (bf16*)(ws + WS_WUKV) + (size_t)l * 512 * 256, 16, r % I_UKV, scr, lane, CmId()); }
    }
    const float* x = a.in[0]; bf16* xb = (bf16*)(ws + WS_XB); float* ssq = (float*)(ws + WS_SSQ);
    for (int m0 = gw; m0 < M; m0 += 2 * NGW) {
        f32x4 v[2][4]; float sacc[2] = {0.f, 0.f};
#pragma unroll
        for (int r = 0; r < 2; ++r) { const int m = m0 + r * NGW; if (m < M) { const f32x4* xr = (const f32x4*)(x + (size_t)m * DM) + lane;
#pragma unroll
                for (int j = 0; j < 4; ++j) v[r][j] = xr[64 * j]; } }
#pragma unroll
        for (int r = 0; r < 2; ++r) { const int m = m0 + r * NGW; if (m < M) { unsigned long long* o8 = (unsigned long long*)(xb + (size_t)m * DM) + lane;
#pragma unroll
                for (int j = 0; j < 4; ++j) { const f32x4 t = v[r][j]; o8[64 * j] = (unsigned long long)pk2(t[0], t[1]) | ((unsigned long long)pk2(t[2], t[3]) << 32);
                    sacc[r] += (t[0] * t[0] + t[1] * t[1]) + (t[2] * t[2] + t[3] * t[3]); } } }
#pragma unroll
        for (int r = 0; r < 2; ++r) { const int m = m0 + r * NGW; float s = sacc[r];
            s += bperm_f(lane ^ 1, s); s += bperm_f(lane ^ 2, s); s += bperm_f(lane ^ 4, s); s += bperm_f(lane ^ 8, s); s += bperm_f(lane ^ 16, s); s = xsum32(s);
            if (m < M && lane < 16) ssq[(size_t)m * 16 + lane] = lane == 0 ? s : 0.f; }
    }
    const int gt = gw * 64 + lane, NGT = NGW * 64;
    float* bias = (float*)(ws + WS_BIAS); float* biasd = (float*)(ws + WS_BIASD); float* rope = (float*)(ws + WS_ROPE);
    for (int i = gt; i < 20 * 2112; i += NGT) { const int h = i / 2112, d = i % 2112 - 64; bias[i] = d >= 0 ? rel_bias[h * 32 + rel_bucket_dev(d)] * LOG2E : 0.f; }
    for (int i = gt; i < 12 * 192; i += NGT) { const int gh = i / 192, sd = i % 192, g = gh >> 2, dil = g == 0 ? 1 : g == 1 ? 4 : 16; const int d = sd * dil; biasd[i] = (sd <= 128) ? rel_bias[(8 + gh) * 32 + rel_bucket_dev(d)] * LOG2E : 0.f; }
    { unsigned char* bid = ws + WS_BID; for (int i = gt; i < 2112; i += NGT) { const int d = i - 64; bid[i] = (unsigned char)(d >= 0 ? rel_bucket_dev(d) : 0); } }
    for (int i = gt; i < SEQ * 16; i += NGT) { const int t = i >> 4, j = i & 15; const float fr = powf(10000.f, -(float)j / 16.f), ang = (float)t * fr; rope[i] = cosf(ang); rope[SEQ * 16 + i] = sinf(ang); }
}

typedef __attribute__((address_space(4))) const Args KArgs;
__global__ void __launch_bounds__(NTHR, 2) mega(Args args) {
    extern __shared__ __attribute__((aligned(16))) unsigned char lds_raw[];
    LAS unsigned char* lds0 = (LAS unsigned char*)lds_raw; LAS unsigned char* lds = lds0;
    volatile LAS unsigned* MISC = (volatile LAS unsigned*)(lds + MISC_OFF);
    const int tid = threadIdx.x, lane = tid & 63, wave = __builtin_amdgcn_readfirstlane(tid >> 6);
    const int G = gridDim.x; const int bx = blockIdx.x; const int vcu = (G % 8 == 0) ? (bx % 8) * (G / 8) + bx / 8 : bx;
    unsigned char* const ws0 = args.ws; unsigned char* ws = ws0; unsigned* ctl = (unsigned*)(ws + WS_CTL);
    for (int u = tid; u < (LDS_BYTES - RING_BYTES) / 4; u += NTHR) ((LAS unsigned*)(lds + RING_BYTES))[u] = 0u;
    __syncthreads();
    XcdBarrier bar = xcd_barrier_post(ctl + CW_BAR, MISC + 8);
    const int lo = args.ph_lo, hi = args.ph_hi;
#ifdef PROBE_T
    if (threadIdx.x == 0) { volatile LAS unsigned long long* pt_ = (volatile LAS unsigned long long*)(lds0 + 131072 + 2048); pt_[0] = 0ull; pt_[1] = __builtin_amdgcn_s_memrealtime(); }
#endif
#define IN(k) (lo <= (k) && (k) < hi)
#define PHASE_LOCALS LAS unsigned char* lds = lds0; const KArgs* ap = (const KArgs*)__builtin_amdgcn_kernarg_segment_ptr(); asm volatile("" : "+s"(lds), "+s"(ap)); unsigned char* ws = ap->ws;
#ifdef PROBE_BAR
#define SEAM(k) do { if (IN(k) && IN((k) + 1)) { xcd_barrier(bar); xcd_barrier(bar); } } while (0)
#else
#ifdef PROBE_T
#define PTICK(k) do { if (threadIdx.x == 0) { volatile LAS unsigned long long* pt_ = (volatile LAS unsigned long long*)(lds0 + 131072 + 2048); const unsigned long long n_ = __builtin_amdgcn_s_memrealtime(); \
        int c_ = 8; if ((k) == PH_PRO) c_ = 0; else { int r_ = ((k) - PH_L0) % PH_PER_LAYER; if (r_ == 0 || r_ == 14) c_ = 1; else if (r_ == 1 || r_ == 15) c_ = 2; else { r_ = (r_ - 2) % 6; c_ = r_ == 0 ? 3 : r_ == 1 ? 4 : r_ == 2 ? 5 : r_ == 4 ? 6 : r_ == 5 ? 7 : 8; } } \
        if (c_ == PROBE_T || PROBE_T == 99) pt_[0] += n_ - pt_[1]; pt_[1] = n_; } } while (0)
#else
#define PTICK(k) do {} while (0)
#endif
#define SEAM(k) do { if (IN(k) && IN((k) + 1)) xcd_barrier(bar); PTICK(k); } while (0)
#endif
    #ifndef NOPRO
    if (IN(PH_PRO)) { PHASE_LOCALS; (void)ws; (void)ap; prologue(args, lds, vcu, G, wave, lane); }
#ifdef PROBE_PRO2
    if (IN(PH_PRO)) { xcd_barrier(bar); PHASE_LOCALS; (void)ws; prologue(args, lds, vcu, G, wave, lane); xcd_barrier(bar); prologue(args, lds, vcu, G, wave, lane); xcd_barrier(bar); prologue(args, lds, vcu, G, wave, lane); }
#endif
#endif
    SEAM(PH_PRO);
    for (int l = 0; l < DEPTH; ++l) {
        const int pb = PH_L0 + l * PH_PER_LAYER;
#pragma unroll 1
        for (int f = 0; f < 2; ++f) {
            if (f == 1) {
#pragma unroll 1
                for (int hf = 0; hf < 2; ++hf) {
                    const int ph = pb + PO_INP + 6 * hf;
#ifndef NOINP
                    if (IN(ph)) {
                        PHASE_LOCALS; bf16* const xb = (bf16*)(ws + WS_XB); float* const ssq = (float*)(ws + WS_SSQ);
                        pg8::Gemm g{xb + (size_t)hf * MH * DM, (const bf16*)(ws + WS_WIN) + (size_t)l * N_INP * DM, MH, N_INP - 256, DM}; pg8::StaticOrder S; S.init(MH, N_INP - 256, G, bx, WGM_INP);
                        EpiInProj E{ssq + (size_t)hf * MH * 16, ws, ap->in[4] + l * 128, ap->in[5] + l * 128, ap->in[7] + l * 128, ap->in[3] + (size_t)l * 4 * DM};
                        pg8::gemm_phase<EpiInProj, pg8::StaticOrder, true, true>(lds, g, S, E);
#ifdef PROBE_INP2
                        xcd_barrier(bar); pg8::gemm_phase<EpiInProj, pg8::StaticOrder, true, true>(lds, g, S, E);
#endif
                    }
#endif
                    SEAM(ph);
#ifndef NOPREP
                    if (IN(ph + 1)) { PHASE_LOCALS; bf16* const xb = (bf16*)(ws + WS_XB); float* const ssq = (float*)(ws + WS_SSQ); int kq = DM; asm volatile("" : "+s"(kq));
                        pg8::Gemm gg{xb + (size_t)hf * MH * DM, (const bf16*)(ws + WS_WIN) + (size_t)l * N_INP * DM, MH, N_INP, kq};
                        EpiInProj ge{ssq + (size_t)hf * MH * 16, ws, ap->in[4] + l * 128, ap->in[5] + l * 128, ap->in[7] + l * 128, ap->in[3] + (size_t)l * 4 * DM};
#ifdef PROBE_PREP3
                        { unsigned pk_ = PROBE_PREP3; asm volatile("" : "+s"(pk_)); prep::phase(ws, lds, l, ap->in[6] + l * 192, (unsigned*)(ws + WS_CTL) + CW_QUEUE + 64 * (16 + l * 2 + hf), gg, ge, pk_); xcd_barrier(bar); }
#endif
                        prep::phase(ws, lds, l, ap->in[6] + l * 192, (unsigned*)(ws + WS_CTL) + CW_QUEUE + 64 * (8 + l * 2 + hf), gg, ge);
                    }
#ifdef PROBE_PREP2_OLD
                    if (IN(ph + 1)) { xcd_barrier(bar); PHASE_LOCALS; prep::phase(ws, lds, l, ap->in[6] + l * 192, (unsigned*)(ws + WS_CTL) + CW_QUEUE + 64 * (16 + l * 2 + hf), gg, ge, PROBE_PREP2); }
#endif
#endif
                    SEAM(ph + 1);
#ifdef PROBE_ATT2
                    if (IN(ph + 2)) { PHASE_LOCALS; att::phase(ws, lds, (unsigned*)(ws + WS_CTL) + CW_QUEUE + 64 * (24 + l * 2 + hf), true, PROBE_ATT2); xcd_barrier(bar); }
#endif
                    if (IN(ph + 2)) { PHASE_LOCALS; att::phase(ws, lds, (unsigned*)(ws + WS_CTL) + CW_QUEUE + 64 * (l * 2 + hf)); }
                    SEAM(ph + 2);
                    if (IN(ph + 4)) {
                        PHASE_LOCALS;
                        int kq = 256; asm volatile("" : "+s"(kq));
                        pg8::Gemm g{(const bf16*)(ws + WS_R), (const bf16*)(ws + WS_WB) + (size_t)l * 4 * DM * 256, MH, DM, kq};
                        MergeOrder S; S.S.init(MH, DM, G, bx); S.a1 = (int)(5 * TILE_B); S.a2 = (int)(WS_OC - WS_R); S.a3 = (int)(WS_DC - WS_R);
                        unsigned* cnt = (unsigned*)(ws + WS_CTL) + CW_SEAM + (l * 2 + hf) * 64 * 64; S.ready = cnt; S.tmo = (unsigned*)(ws + WS_CTL) + 2;
                        {
                            const bf16* tiles = (const bf16*)(ws + WS_R); const float* lse = (const float*)(ws + WS_LSED); bf16* dc = (bf16*)(ws + WS_DC);
                            int tid_ = threadIdx.x; asm volatile("" : "+v"(tid_)); const int ln = tid_ & 63, wv = tid_ >> 6, h = ln >> 4;
                            pg8::Unit tu;
                            for (int i = 0; S.S.next(i, tu); ++i) {
#pragma unroll 1
                                for (int half = 0; half < 2; ++half) { const int rbase = tu.pm * 256 + tu.pn * 64 + wv * 8 + half * 4;
                                    v2u va[4], vb[4], vc[4]; float la[4], lb[4], lc[4];
#pragma unroll
                                    for (int r = 0; r < 4; ++r) { const int row = rbase + r; const size_t o = (size_t)row * 256 + 4 * ln;
                                        la[r] = lse[(size_t)row * 16 + h]; lb[r] = lse[(size_t)row * 16 + 4 + h]; lc[r] = lse[(size_t)row * 16 + 8 + h];
                                        va[r] = *(const v2u*)(tiles + (size_t)8 * MH * 256 + o); vb[r] = *(const v2u*)(tiles + (size_t)9 * MH * 256 + o); vc[r] = *(const v2u*)(tiles + (size_t)10 * MH * 256 + o); }
#pragma unroll
                                    for (int r = 0; r < 4; ++r) { const int row = rbase + r;
                                        const float l0 = la[r], l1 = lb[r], l2 = lc[r], mx = fmaxf(l0, fmaxf(l1, l2));
                                        const float e0 = __builtin_amdgcn_exp2f(l0 - mx), e1 = __builtin_amdgcn_exp2f(l1 - mx), e2 = __builtin_amdgcn_exp2f(l2 - mx), inv = 1.0f / (e0 + e1 + e2);
                                        const v2u a = va[r], b = vb[r], c = vc[r];
                                        const unsigned lo = pk2((e0 * __uint_as_float(a.x << 16) + e1 * __uint_as_float(b.x << 16) + e2 * __uint_as_float(c.x << 16)) * inv, (e0 * __uint_as_float(a.x & 0xffff0000u) + e1 * __uint_as_float(b.x & 0xffff0000u) + e2 * __uint_as_float(c.x & 0xffff0000u)) * inv);
                                        const unsigned hi2 = pk2((e0 * __uint_as_float(a.y << 16) + e1 * __uint_as_float(b.y << 16) + e2 * __uint_as_float(c.y << 16)) * inv, (e0 * __uint_as_float(a.y & 0xffff0000u) + e1 * __uint_as_float(b.y & 0xffff0000u) + e2 * __uint_as_float(c.y & 0xffff0000u)) * inv);
                                        __hip_atomic_store((unsigned long long*)(dc + (size_t)row * 256 + 4 * ln), ((unsigned long long)hi2 << 32) | lo, __ATOMIC_RELAXED, __HIP_MEMORY_SCOPE_AGENT); } }
                                asm volatile("s_waitcnt vmcnt(0)" ::: "memory");
                                if (ln == 0) (void)__hip_atomic_fetch_add(cnt + 64 * tu.pm, 1u, __ATOMIC_RELAXED, __HIP_MEMORY_SCOPE_AGENT);
                            }
                        }
                        EpiMerge E{(const bf16*)(ws + WS_R) + (size_t)17 * MH * 256, (bf16*)(ws + WS_U)};
                        pg8::gemm_phase<EpiMerge, MergeOrder, true, true>(lds, g, S, E);
#ifdef PROBE_MRG4
                        { EpiMergeCheap Ec{(bf16*)(ws + WS_U)}; xcd_barrier(bar); pg8::gemm_phase<EpiMergeCheap, MergeOrder, true, true>(lds, g, S, Ec); xcd_barrier(bar); pg8::gemm_phase<EpiMerge, MergeOrder, true, true>(lds, g, S, E); }
#endif
#ifdef PROBE_MRG3
                        xcd_barrier(bar); pg8::gemm_phase<EpiMerge, MergeOrder, true, true>(lds, g, S, E);
#endif
                    }
                    SEAM(ph + 4);
#ifndef NORES
                    if (IN(ph + 5)) {
                        PHASE_LOCALS; bf16* const xb = (bf16*)(ws + WS_XB); float* const ssq = (float*)(ws + WS_SSQ);
                        pg8::Gemm g{(const bf16*)(ws + WS_U), (const bf16*)(ws + WS_WO) + (size_t)l * DM * DM, MH, DM, DM}; pg8::StaticOrder S; S.init(MH, DM, G, bx);
                        EpiResid E{nullptr, xb + (size_t)hf * MH * DM, ssq + (size_t)hf * MH * 16, 1.0f};
                        pg8::gemm_phase<EpiResid, pg8::StaticOrder, true, true>(lds, g, S, E);
                    }
#endif
                    SEAM(ph + 5);
                }
            }
            const int p1 = pb + (f ? PO_F2I : PO_F1I);
#ifdef PROBE_K
            if (IN(p1) && l == 1 && f == 1) {
                PHASE_LOCALS;
#if PROBE_K != 2
                pg8::Gemm g2{(const bf16*)(ws + WS_XB), (const bf16*)(ws + WS_WFI) + (size_t)(l * 2 + f) * 5632 * DM, M, 5632, DM};
#else
                pg8::Gemm g2{(const bf16*)(ws + WS_R), (const bf16*)(ws + WS_WFI), M, 5632, 2048};
#endif
                pg8::StaticOrder S; S.init(M, 5632, G, bx, WGM_FFI);
#if PROBE_K == 5
                EpiFfnIn Ef{(const float*)(ws + WS_SSQ), (bf16*)(ws + WS_R)};
#pragma unroll 1
                for (int rep = 0; rep < 3; ++rep) { pg8::gemm_phase<EpiFfnIn, pg8::StaticOrder, true, true>(lds, g2, S, Ef); xcd_barrier(bar); }
#elif PROBE_K >= 3
                EpiFfnInCheap Ec{(const float*)(ws + WS_SSQ), (bf16*)(ws + WS_R)}; pg8::gemm_phase<EpiFfnInCheap, pg8::StaticOrder, true, true>(lds, g2, S, Ec); xcd_barrier(bar);
#else
                EpiNull En{(float*)(ws + WS_CTL) + 8};
                pg8::gemm_phase<EpiNull, pg8::StaticOrder, true, true>(lds, g2, S, En); xcd_barrier(bar);
#endif
            }
#endif
#ifndef NOFFNI
            if (IN(p1)) {
                PHASE_LOCALS; bf16* const xb = (bf16*)(ws + WS_XB); float* const ssq = (float*)(ws + WS_SSQ); bf16* const h2 = (bf16*)(ws + WS_R);
                pg8::Gemm g{xb, (const bf16*)(ws + WS_WFI) + (size_t)(l * 2 + f) * 5632 * DM, M, 5632, DM}; pg8::StaticOrder S; S.init(M, 5632, G, bx, WGM_FFI);
                EpiFfnIn E{ssq, h2};
#ifdef PROBE_FFI3
                { EpiFfnInCheap Ec{ssq, h2}; pg8::gemm_phase<EpiFfnInCheap, pg8::StaticOrder, true, true>(lds, g, S, Ec); xcd_barrier(bar); }
#endif
                pg8::gemm_phase<EpiFfnIn, pg8::StaticOrder, true, true>(lds, g, S, E);
#ifdef PROBE_FFI2
                xcd_barrier(bar); pg8::gemm_phase<EpiFfnIn, pg8::StaticOrder, true, true>(lds, g, S, E);
#endif
            }
#endif
            SEAM(p1);
#ifndef NORES2
            if (IN(p1 + 1)) {
                PHASE_LOCALS; bf16* const xb = (bf16*)(ws + WS_XB); float* const ssq = (float*)(ws + WS_SSQ); bf16* const h2 = (bf16*)(ws + WS_R);
                float* const xout = (l == DEPTH - 1 && f == 1) ? ap->out : nullptr;
                pg8::Gemm g{h2, (const bf16*)(ws + WS_WFO) + (size_t)(l * 2 + f) * DM * DFF, M, DM, DFF}; pg8::StaticOrder S; S.init(M, DM, G, bx, WGM_FFO);
                EpiResid E{xout, xb, ssq, 0.5f};
                pg8::gemm_phase<EpiResid, pg8::StaticOrder, true, true>(lds, g, S, E);
            }
#endif
            SEAM(p1 + 1);
        }
    }
#ifdef PROBE_T
    if (blockIdx.x == 0 && threadIdx.x == 0) { volatile LAS unsigned long long* pt_ = (volatile LAS unsigned long long*)(lds0 + 131072 + 2048); const unsigned long long t0_ = __builtin_amdgcn_s_memrealtime(), w_ = 8ull * pt_[0];
        while (__builtin_amdgcn_s_memrealtime() - t0_ < w_) __builtin_amdgcn_s_sleep(8); }
#endif
#undef IN
#undef SEAM
}
static void launch_mega(const Args& a0, int lo, int hi, int grid, hipStream_t st) {
    Args a = a0; a.ph_lo = lo; a.ph_hi = hi;
    hipMemsetAsync(a.ws + WS_CTL, 0, CTL_BYTES, st);
    hipLaunchKernelGGL(mega, dim3(grid), dim3(NTHR), LDS_BYTES, st, a);
}
extern "C" void kernel_launch(void* const* d_in, const int* in_sizes, int n_in, void* d_out, int out_size, void* d_ws, size_t ws_size, hipStream_t stream) {
    static int grid = 0;
    if (grid == 0) {
        if (n_in != 17 || ws_size < WS_END) { fprintf(stderr, "kernel_launch: unexpected n_in %d / ws %zu\n", n_in, ws_size); grid = -1; return; }
        int dev = 0, cus = 0; hipGetDevice(&dev); hipDeviceGetAttribute(&cus, hipDeviceAttributeMultiprocessorCount, dev);
        if (hipFuncSetAttribute((const void*)mega, hipFuncAttributeMaxDynamicSharedMemorySize, LDS_BYTES) != hipSuccess) { fprintf(stderr, "hipFuncSetAttribute failed\n"); grid = -1; return; }
        int per_cu = 0; hipOccupancyMaxActiveBlocksPerMultiprocessor(&per_cu, (const void*)mega, NTHR, LDS_BYTES); (void)hipGetLastError();
        if (per_cu < 1) fprintf(stderr, "note: occupancy query says %d\n", per_cu);
        grid = cus;
    }
    if (grid < 0) return;
    Args a{}; for (int i = 0; i < 17; ++i) a.in[i] = (const float*)d_in[i]; a.out = (float*)d_out; a.ws = (unsigned char*)d_ws; a.ph_lo = 0; a.ph_hi = 0;
    int cur = 0;
    launch_mega(a, cur, N_PHASES, grid, stream);
}
```

```cpp
#include <hip/hip_runtime.h>
#include <cstdio>
#include <cstdint>
#include <cmath>
namespace pg8 {
#define PG8_LAS __attribute__((address_space(3)))
typedef unsigned short bf16_t;
typedef short bf16x8 __attribute__((ext_vector_type(8)));
typedef float f32x4 __attribute__((ext_vector_type(4)));
typedef unsigned u32x4 __attribute__((ext_vector_type(4)));
constexpr int BM = 256, BK = 64, HALF = 128, HTB = HALF * BK * 2  , STAGE_BYTES = 8 * HTB, NXCD = 8, WGM = 4;

__host__ __device__ __forceinline__ int lds_byte(int r, int c) { const int st = (r >> 4) * 2 + (c >> 5), rr = r & 15, cc = c & 31, ob = rr * 64 + cc * 2; return st * 1024 + (ob ^ (((ob >> 9) & 1) << 5)); }
__host__ __device__ __forceinline__ void stage_rc(int b, int& R, int& C) { const int st = b / 1024, sb = b % 1024, swz = sb ^ (((sb >> 9) & 1) << 5); R = (st >> 1) * 16 + swz / 64; C = (st & 1) * 32 + (swz % 64) / 2; }
__host__ __device__ __forceinline__ int perm32(int rho) { const int n = rho >> 4, i = rho & 15; return 8 * (i >> 2) + 4 * n + (i & 3); }

struct Unit { int pm, pn; int ao, bo; };
struct Gemm { const bf16_t* A; const bf16_t* Bt; int M, N, K; };

struct StaticOrder {
    int nM, nN, nwg, G, c, wgm;
    __host__ __device__ void init(int M, int N, int G_, int c_, int wgm_ = WGM) { nM = M / BM; nN = N / BM; nwg = nM * nN; G = G_; c = c_; wgm = wgm_; }
    __host__ __device__ __forceinline__ bool next(int i, Unit& u) const {
        const long L = (long)i * G + c; if (L >= nwg) return false;
        int wgid = (int)L; { const int q = nwg / NXCD, r = nwg % NXCD, xcd = wgid % NXCD, off = wgid / NXCD; wgid = (xcd < r ? xcd * (q + 1) : r * (q + 1) + (xcd - r) * q) + off; }
        const int nig = wgm * nN, gid = wgid / nig, fm = gid * wgm, gsz = (nM - fm) < wgm ? (nM - fm) : wgm;
        u.pm = fm + ((wgid % nig) % gsz); u.pn = (wgid % nig) / gsz; u.ao = 0; u.bo = 0; return true;
    }
    __device__ __forceinline__ void a_ready(const Unit&) const {}
    __device__ __forceinline__ void done(const Unit&) const {}
};

__device__ __forceinline__ unsigned cvt_pk_bf16(float lo, float hi) { unsigned r; asm volatile("v_cvt_pk_bf16_f32 %0, %1, %2" : "=v"(r) : "v"(lo), "v"(hi)); return r; }
typedef float f32x2 __attribute__((ext_vector_type(2)));
__device__ __forceinline__ const char* uni_ptr(const char* p) { const unsigned long long v = (unsigned long long)p; return (const char*)(((unsigned long long)(unsigned)__builtin_amdgcn_readfirstlane((int)(v >> 32)) << 32) | (unsigned)__builtin_amdgcn_readfirstlane((int)v)); }
template <class Epi, class Sched, bool ALIGN_EPI = false, bool SP2 = false>
__device__ __forceinline__ void gemm_phase(PG8_LAS unsigned char* lds, const Gemm g, const Sched& S, const Epi& E) {
    int tid_ = threadIdx.x; asm volatile("" : "+v"(tid_));
    const int tid = tid_, wid = __builtin_amdgcn_readfirstlane(tid >> 6), lane = tid & 63, wr = wid >> 2, wc = wid & 3, fr = lane & 15, fq = lane >> 4;
    const int K = g.K, nt = K / BK;
    unsigned voffA[2], voffB[2];
#pragma unroll
    for (int i = 0; i < 2; ++i) { int R, C; stage_rc(tid * 16 + i * 8192, R, C); const int Rb = Epi::PERM ? ((R & ~31) + perm32(R & 31)) : R;
        voffA[i] = (unsigned)(R * K + C) * 2u; voffB[i] = (unsigned)(Rb * K + C) * 2u; }
    const size_t kstep = (size_t)(BK * 2);
    const size_t hstep = (size_t)HALF * K * 2;
    const size_t tstep = 2 * hstep;
    const unsigned ldsw = (unsigned)wid * 1024u;
    const int aoff = lds_byte(wr * 64 + fr, fq * 8), boff = lds_byte(wc * 32 + fr, fq * 8);
#define PG8_SA(b, h) (((b) * 2 + (h)) * HTB)
#define PG8_SB(b, h) ((4 + (b) * 2 + (h)) * HTB)
#define PG8_STAGE(bufoff, gbase, voff) do { _Pragma("unroll") for (int _i = 0; _i < 2; ++_i) \
        __builtin_amdgcn_global_load_lds((const unsigned*)((const char*)(gbase) + (voff)[_i]), (PG8_LAS unsigned*)(lds + (bufoff) + ldsw + _i * 8192), 16, 0, 0); } while (0)
#define PG8_LDA(dst, b, h) do { _Pragma("unroll") for (int m = 0; m < 4; ++m) _Pragma("unroll") for (int k = 0; k < 2; ++k) dst[m][k] = *(const PG8_LAS bf16x8*)(lds + PG8_SA(b, h) + aoff + m * 2048 + k * 1024); } while (0)
#define PG8_LDB(dst, b, h) do { _Pragma("unroll") for (int n = 0; n < 2; ++n) _Pragma("unroll") for (int k = 0; k < 2; ++k) dst[n][k] = *(const PG8_LAS bf16x8*)(lds + PG8_SB(b, h) + boff + n * 2048 + k * 1024); } while (0)
#define PG8_MMA(ai, bj, At, Bt) do { __builtin_amdgcn_s_setprio(1); _Pragma("unroll") for (int m = 0; m < 4; ++m) _Pragma("unroll") for (int n = 0; n < 2; ++n) _Pragma("unroll") for (int k = 0; k < 2; ++k) \
        acc[ai][bj][m][n] = __builtin_amdgcn_mfma_f32_16x16x32_bf16(Bt[n][k], At[m][k], acc[ai][bj][m][n], 0, 0, 0); __builtin_amdgcn_s_setprio(0); } while (0)
#define PG8_WAIT_V(n) asm volatile("s_waitcnt vmcnt(" #n ")" ::: "memory")
#define PG8_WAIT_L(n) asm volatile("s_waitcnt lgkmcnt(" #n ")" ::: "memory")
#define PG8_WAIT_VE asm volatile("s_waitcnt vmcnt(%0)" :: "n"(8 + Epi::VM_OPS) : "memory")
#define PG8_BAR __builtin_amdgcn_s_barrier()
#define PG8_SCHED __builtin_amdgcn_sched_barrier(0)
    Unit cur, nxt; int ui = 0;
    if (!S.next(0, cur)) return;
    f32x4 acc[2][2][4][2];
#pragma unroll
    for (int a = 0; a < 2; ++a)
#pragma unroll
        for (int b = 0; b < 2; ++b)
#pragma unroll
            for (int m = 0; m < 4; ++m)
#pragma unroll
                for (int n = 0; n < 2; ++n) acc[a][b][m][n] = (f32x4){0.f, 0.f, 0.f, 0.f};
    bf16x8 At[4][2], B0[2][2], B1[2][2];
    const char* cA = uni_ptr((const char*)g.A + (size_t)cur.pm * tstep + cur.ao); const char* cB = uni_ptr((const char*)g.Bt + (size_t)cur.pn * tstep + cur.bo);
    S.a_ready(cur);
    if constexpr (SP2) {
        PG8_STAGE(PG8_SB(0, 0), cB, voffB); PG8_STAGE(PG8_SB(0, 1), cB + hstep, voffB); PG8_STAGE(PG8_SA(0, 0), cA, voffA); PG8_STAGE(PG8_SA(0, 1), cA + hstep, voffA);
        if (wr == 1) PG8_BAR;
        PG8_WAIT_V(2); PG8_BAR;
        PG8_STAGE(PG8_SB(1, 0), cB + kstep, voffB); PG8_STAGE(PG8_SA(1, 0), cA + kstep, voffA); PG8_STAGE(PG8_SB(1, 1), cB + hstep + kstep, voffB); PG8_STAGE(PG8_SA(1, 1), cA + hstep + kstep, voffA);
        PG8_WAIT_V(8); PG8_BAR;
    } else {
        PG8_STAGE(PG8_SB(0, 0), cB, voffB); PG8_STAGE(PG8_SA(0, 0), cA, voffA); PG8_STAGE(PG8_SB(0, 1), cB + hstep, voffB); PG8_STAGE(PG8_SA(0, 1), cA + hstep, voffA);
        if (wr == 1) PG8_BAR;
        PG8_WAIT_V(4); PG8_BAR;
        PG8_STAGE(PG8_SB(1, 0), cB + kstep, voffB); PG8_STAGE(PG8_SA(1, 0), cA + kstep, voffA); PG8_STAGE(PG8_SB(1, 1), cB + hstep + kstep, voffB);
        PG8_WAIT_V(6); PG8_BAR;
    }
    for (;;) {
        const bool has_next = S.next(ui + 1, nxt);
        const char* nA = uni_ptr(has_next ? (const char*)g.A + (size_t)nxt.pm * tstep + nxt.ao : cA); const char* nB = uni_ptr(has_next ? (const char*)g.Bt + (size_t)nxt.pn * tstep + nxt.bo : cB);
        for (int t = 0; t < nt; t += 2) {
            const bool last = (t == nt - 2);
            const char* a1 = cA + (size_t)(t + 1) * kstep;
            const char* a2 = last ? nA : cA + (size_t)(t + 2) * kstep; const char* b2 = last ? nB : cB + (size_t)(t + 2) * kstep;
            const char* a3 = a2 + kstep; const char* b3 = b2 + kstep;
            if (last && has_next) S.a_ready(nxt);
            if constexpr (SP2) {
            const int fresh = __builtin_amdgcn_readfirstlane((t == 0 && ui > 0) ? 1 : 0);
#define PG8_WAIT_V8F asm volatile("s_waitcnt vmcnt(%1)\n\ts_cmp_lg_u32 %0, 0\n\ts_cbranch_scc1 .Lpg8f%=\n\ts_waitcnt vmcnt(8)\n.Lpg8f%=:" :: "s"(fresh), "n"(8 + Epi::VM_OPS) : "memory", "scc")
            PG8_LDB(B0, 0, 0); PG8_LDB(B1, 0, 1); PG8_SCHED; PG8_LDA(At, 0, 0);
            PG8_WAIT_V8F; PG8_WAIT_L(0); PG8_BAR; PG8_MMA(0, 0, At, B0); PG8_MMA(0, 1, At, B1); PG8_BAR; PG8_SCHED;
            PG8_LDA(At, 0, 1); PG8_STAGE(PG8_SB(0, 0), b2, voffB); PG8_STAGE(PG8_SB(0, 1), b2 + hstep, voffB); PG8_STAGE(PG8_SA(0, 0), a2, voffA);
            PG8_WAIT_V8F; PG8_WAIT_L(0); PG8_BAR; PG8_MMA(1, 0, At, B0); PG8_MMA(1, 1, At, B1); PG8_BAR; PG8_SCHED;
            PG8_LDB(B0, 1, 0); PG8_LDB(B1, 1, 1); PG8_SCHED; PG8_LDA(At, 1, 0); PG8_STAGE(PG8_SA(0, 1), a2 + hstep, voffA);
            PG8_WAIT_V8F; PG8_WAIT_L(0); PG8_BAR; PG8_MMA(0, 0, At, B0); PG8_MMA(0, 1, At, B1); PG8_BAR; PG8_SCHED;
#undef PG8_WAIT_V8F
            PG8_LDA(At, 1, 1); PG8_STAGE(PG8_SB(1, 0), b3, voffB); PG8_STAGE(PG8_SB(1, 1), b3 + hstep, voffB); PG8_STAGE(PG8_SA(1, 0), a3, voffA);
            PG8_WAIT_V(8); PG8_WAIT_L(0); PG8_BAR; PG8_MMA(1, 0, At, B0); PG8_MMA(1, 1, At, B1); PG8_BAR; PG8_SCHED;
            PG8_STAGE(PG8_SA(1, 1), a3 + hstep, voffA); PG8_SCHED;
            } else {
            PG8_LDB(B0, 0, 0); PG8_SCHED; PG8_LDA(At, 0, 0); PG8_STAGE(PG8_SA(1, 1), a1 + hstep, voffA);
            PG8_WAIT_L(8); PG8_BAR; PG8_WAIT_L(0); PG8_MMA(0, 0, At, B0); PG8_BAR; PG8_SCHED;
            PG8_LDB(B1, 0, 1); PG8_STAGE(PG8_SB(0, 0), b2, voffB);
            PG8_BAR; PG8_WAIT_L(0); PG8_MMA(0, 1, At, B1); PG8_BAR;
            PG8_LDA(At, 0, 1); PG8_STAGE(PG8_SA(0, 0), a2, voffA);
            PG8_BAR; PG8_WAIT_L(0); PG8_MMA(1, 0, At, B0); PG8_BAR; PG8_SCHED;
            PG8_STAGE(PG8_SB(0, 1), b2 + hstep, voffB);
            PG8_WAIT_V(6); PG8_BAR; PG8_MMA(1, 1, At, B1); PG8_BAR;
            PG8_LDB(B0, 1, 0); PG8_SCHED; PG8_LDA(At, 1, 0); PG8_STAGE(PG8_SA(0, 1), a2 + hstep, voffA);
            PG8_WAIT_L(8); PG8_BAR; PG8_WAIT_L(0); PG8_MMA(0, 0, At, B0); PG8_BAR; PG8_SCHED;
            PG8_LDB(B1, 1, 1); PG8_STAGE(PG8_SB(1, 0), b3, voffB);
            PG8_BAR; PG8_WAIT_L(0); PG8_MMA(0, 1, At, B1); PG8_BAR;
            PG8_LDA(At, 1, 1); PG8_STAGE(PG8_SA(1, 0), a3, voffA);
            PG8_BAR; PG8_WAIT_L(0); PG8_MMA(1, 0, At, B0); PG8_BAR; PG8_SCHED;
            PG8_STAGE(PG8_SB(1, 1), b3 + hstep, voffB);
            PG8_WAIT_V(6); PG8_BAR; PG8_MMA(1, 1, At, B1); PG8_BAR;
            }
        }
        if constexpr (ALIGN_EPI) { if (wr == 0) PG8_BAR; }
        bool keep_acc = false;
        if constexpr (Epi::CHAIN) { keep_acc = E.chain(acc, cur, wr, wc, fr, fq); S.done(cur); }
        else if constexpr (!Epi::AFTER_DRAIN) { E(acc, cur, wr, wc, fr, fq); S.done(cur); }
        if (!has_next) break;
        if (!keep_acc) {
#pragma unroll
        for (int a = 0; a < 2; ++a)
#pragma unroll
            for (int b = 0; b < 2; ++b)
#pragma unroll
                for (int m = 0; m < 4; ++m)
#pragma unroll
                    for (int n = 0; n < 2; ++n) acc[a][b][m][n] = (f32x4){0.f, 0.f, 0.f, 0.f};
        }
        cur = nxt; cA = nA; cB = nB; ++ui;
        if constexpr (ALIGN_EPI) { if (wr == 1) PG8_BAR; }
    }
    PG8_WAIT_V(0);
    if constexpr (!ALIGN_EPI) { if (wr == 0) PG8_BAR; }
    PG8_BAR;
    if constexpr (Epi::AFTER_DRAIN) { E.fused(acc, cur, wr, wc, fr, fq, lds, wid, lane); S.done(cur); }
#undef PG8_SA
#undef PG8_SB
#undef PG8_STAGE
#undef PG8_LDA
#undef PG8_LDB
#undef PG8_MMA
#undef PG8_WAIT_V
#undef PG8_WAIT_L
#undef PG8_WAIT_VE
#undef PG8_BAR
#undef PG8_SCHED
}
}
#define LAS __attribute__((address_space(3)))
#define XB_TMO      128
#define XB_XCNT(j)  (256  + 64 * (j))
#define XB_XSUB(j)  (1280 + 64 * (j))
#define XB_XGEN(j)  (2304 + 64 * (j))
#define XB_TOP      3328
#define XB_TOPGEN   3392
#define XCD_BAR_WORDS 3456
#define XB_SPIN_CAP (1u << 18)

__device__ __forceinline__ unsigned xb_ld(unsigned* p)              { return __hip_atomic_load(p, __ATOMIC_RELAXED, __HIP_MEMORY_SCOPE_AGENT); }
__device__ __forceinline__ unsigned xb_add(unsigned* p, unsigned v) { return __hip_atomic_fetch_add(p, v, __ATOMIC_RELAXED, __HIP_MEMORY_SCOPE_AGENT); }
__device__ __forceinline__ unsigned xb_xcc_id() { return (unsigned)__builtin_amdgcn_s_getreg((3 << 11) | 20) & 0xFu; }
#define XB_SPIN(cond, bar) do { unsigned _sp = 0; while (cond) { __builtin_amdgcn_s_sleep(1); \
    if ((++_sp & 255u) == 0u) { if (xb_ld(&(bar)[XB_TMO])) break; if (_sp > XB_SPIN_CAP) { atomicAdd(&(bar)[XB_TMO], 1u); break; } } } } while (0)

struct XcdBarrier {
    unsigned* bar; unsigned x;
    volatile LAS unsigned* st;
};

__device__ __forceinline__ XcdBarrier xcd_barrier_post(unsigned* bar, volatile LAS unsigned* st) {
    XcdBarrier b; b.bar = bar; b.x = xb_xcc_id(); b.st = st;
    if (threadIdx.x == 0) (void)xb_add(&bar[XB_XCNT(b.x)], 1u);
    return b;
}
__device__ __forceinline__ void xcd_barrier_complete(unsigned* bar, unsigned x, unsigned& nloc, unsigned& nx) {
    const unsigned G = gridDim.x * gridDim.y * gridDim.z;
    unsigned sum, cnt, mine, sp = 0u;
    for (;;) {
        sum = 0u; cnt = 0u; mine = 0u;
#pragma unroll
        for (unsigned j = 0; j < 16; ++j) { const unsigned c = xb_ld(&bar[XB_XCNT(j)]); sum += c; cnt += (c > 0u) ? 1u : 0u; mine = (j == x) ? c : mine; }
        if (sum == G) break;
        __builtin_amdgcn_s_sleep(1);
        if ((++sp & 255u) == 0u) { if (xb_ld(&bar[XB_TMO])) break; if (sp > XB_SPIN_CAP) { atomicAdd(&bar[XB_TMO], 1u); break; } }
    }
    nloc = mine > 0u ? mine : 1u; nx = cnt > 0u ? cnt : 1u;
}

__device__ __forceinline__ void xcd_barrier(const XcdBarrier& b) {
    asm volatile("s_waitcnt vmcnt(0)" ::: "memory");
    __syncthreads();
    if (threadIdx.x == 0) {
        unsigned* bar = b.bar; unsigned bx = b.x; asm volatile("" : "+s"(bar), "+s"(bx));
        __builtin_amdgcn_s_waitcnt(0);
        unsigned nloc = b.st[0], nx = b.st[1];
        if (nloc == 0u) { xcd_barrier_complete(bar, bx, nloc, nx); b.st[0] = nloc; b.st[1] = nx; }
        const unsigned old = xb_add(&bar[XB_XSUB(bx)], 1u);
        const unsigned gen = old / nloc;
        if (old + 1u == (gen + 1u) * nloc) {
            __builtin_amdgcn_fence(__ATOMIC_RELEASE, "agent");
            asm volatile("s_waitcnt vmcnt(0)" ::: "memory");
            const unsigned og = xb_add(&bar[XB_TOP], 1u);
            const unsigned tg = og / nx;
            if (og + 1u == (tg + 1u) * nx) xb_add(&bar[XB_TOPGEN], 1u);
            else XB_SPIN(xb_ld(&bar[XB_TOPGEN]) == tg, bar);
            __builtin_amdgcn_fence(__ATOMIC_ACQUIRE, "agent");
            xb_add(&bar[XB_XGEN(bx)], 1u);
            asm volatile("s_waitcnt vmcnt(0)" ::: "memory");
        } else {
            XB_SPIN(xb_ld(&bar[XB_XGEN(bx)]) == gen, bar);
            __builtin_amdgcn_fence(__ATOMIC_ACQUIRE, "agent");
            asm volatile("s_waitcnt vmcnt(0)" ::: "memory");
        }
    }
    __syncthreads();
}
typedef unsigned short bf16;
typedef unsigned v4u __attribute__((ext_vector_type(4)));
typedef unsigned v2u __attribute__((ext_vector_type(2)));
typedef float f32x4 __attribute__((ext_vector_type(4)));
typedef float f32x16 __attribute__((ext_vector_type(16)));
typedef short bf16x8 __attribute__((ext_vector_type(8)));
typedef short s16x4 __attribute__((ext_vector_type(4)));
constexpr int DM = 1024, NB = 16, SEQ = 2048, DEPTH = 2, DFF = 2816, INW = 8388;
constexpr int M = NB * SEQ, MH = M / 2, HBAT = NB / 2;
constexpr int O_AQ = 0, O_AK = 256, O_AV = 320, O_IQ = 384, O_IK = 512, O_IW = 544, O_B = 548, O_CQ = 1316, O_CKV = 1700, O_CKR = 1956, O_D = 1988, O_G = 4292;
constexpr int NT_IN = 33, N_INP = NT_IN * 256;
constexpr float EPS = 1e-6f, LOG2E = 1.4426950408889634f;
constexpr float C2A = 0.125f * LOG2E;
constexpr float C2C = 0.10206207261596577f * LOG2E;
constexpr int NWAVES = 8, NTHR = 512;
#ifndef WGM_FFO
#define WGM_FFO 4
#endif
#ifndef WGM_FFI
#define WGM_FFI 4
#endif
#ifndef WGM_INP
#define WGM_INP 4
#endif
constexpr size_t MiB = (size_t)1 << 20;
constexpr size_t WS_CTL = 0, CTL_BYTES = 1 * MiB;
constexpr size_t WS_BIAS = 1 * MiB;
constexpr size_t WS_BIASD = WS_BIAS + 20 * 2112 * 4;
constexpr size_t WS_BID = WS_BIASD + 12 * 192 * 4;
constexpr size_t WS_ROPE = 2 * MiB;
constexpr size_t WS_KMEAN = 3 * MiB;
constexpr size_t WS_WFI = 4 * MiB;
constexpr size_t WS_WFO = 48 * MiB;
constexpr size_t WS_WIN = 70 * MiB;
constexpr size_t WS_WO = 103 * MiB;
constexpr size_t WS_WB = 107 * MiB;
constexpr size_t WS_WUQ = 111 * MiB;
constexpr size_t WS_WUKV = 112 * MiB;
constexpr size_t WS_XB = 113 * MiB;
constexpr size_t WS_SSQ = 177 * MiB;
constexpr size_t WS_R = 180 * MiB;
constexpr size_t TILE_B = (size_t)MH * 256 * 2;
constexpr size_t WS_CQL = WS_R + 2 * TILE_B;
constexpr size_t WS_XS = WS_CQL + (size_t)MH * 384 * 2;
constexpr size_t WS_CKVL = WS_R + 4 * TILE_B;
constexpr size_t WS_DC = WS_R + 2 * TILE_B;
constexpr size_t WS_U = WS_R + 11 * TILE_B;
constexpr size_t WS_QN = 444 * MiB, WS_KN = 456 * MiB, WS_VC = 468 * MiB, WS_OC = 476 * MiB;
constexpr size_t WS_IWF = 484 * MiB;
constexpr size_t WS_SSL = 485 * MiB;
constexpr size_t WS_MASK = 486 * MiB;
constexpr size_t WS_LSED = 490 * MiB;
constexpr size_t WS_END = 492 * MiB;
constexpr int CW_BAR = 4096, CW_QUEUE = 16384, CW_SEAM = 32768;
constexpr int PH_PRO = 0, PH_L0 = 1, PH_PER_LAYER = 16, N_PHASES = 1 + 2 * PH_PER_LAYER;
enum { PO_F1I = 0, PO_F1O = 1, PO_INP = 2, PO_PREP = 3, PO_ATT = 4, PO_CMB = 5, PO_MRG = 6, PO_OUT = 7,   PO_F2I = 14, PO_F2O = 15 };

struct Args { const float* in[17]; float* out; unsigned char* ws; int ph_lo, ph_hi; };

__device__ __forceinline__ float bf2f(bf16 b) { return __uint_as_float(((unsigned)b) << 16); }
__device__ __forceinline__ unsigned f2bf(float f) { unsigned u = __float_as_uint(f); return (u + 0x7fffu + ((u >> 16) & 1u)) >> 16; }
typedef float f32x2_t __attribute__((ext_vector_type(2))); typedef __bf16 bf16x2_t __attribute__((ext_vector_type(2)));
__device__ __forceinline__ unsigned pk2(float lo, float hi) { f32x2_t v = {lo, hi}; bf16x2_t b = __builtin_convertvector(v, bf16x2_t); return __builtin_bit_cast(unsigned, b); }
#define CAS __attribute__((address_space(4)))
__device__ __forceinline__ float bperm_f(int srclane, float v) { return __int_as_float(__builtin_amdgcn_ds_bpermute(srclane << 2, __float_as_int(v))); }
__device__ __forceinline__ int bperm_i(int srclane, int v) { return __builtin_amdgcn_ds_bpermute(srclane << 2, v); }
__device__ __forceinline__ float xsum32(float v) { auto rr = __builtin_amdgcn_permlane32_swap(__float_as_uint(v), __float_as_uint(v), false, false); return __uint_as_float(rr[0]) + __uint_as_float(rr[1]); }
__device__ __forceinline__ v4u pair16(v2u X, v2u Y) { auto a = __builtin_amdgcn_permlane32_swap(X.x, Y.x, false, false); auto b = __builtin_amdgcn_permlane32_swap(X.y, Y.y, false, false); v4u o; o.x = a[0]; o.y = b[0]; o.z = a[1]; o.w = b[1]; return o; }
__device__ __forceinline__ float xmax32(float v) { auto rr = __builtin_amdgcn_permlane32_swap(__float_as_uint(v), __float_as_uint(v), false, false); return fmaxf(__uint_as_float(rr[0]), __uint_as_float(rr[1])); }
__host__ __device__ __forceinline__ int inproj_srccol(int n) {
    const int pn = n >> 8, c = n & 255;
    if (pn >= 17) { const int g = pn - 17; return O_G + (g >> 2) * 1024 + (g & 3) * 256 + c; }
    const int slot = (c >> 5) & 3, e = 32 * (c >> 7) + (c & 31);
    switch (pn) {
        case 0: return O_AQ + slot * 64 + e;
        case 1: return slot == 0 ? O_AK + e : slot == 1 ? O_AV + e : O_IQ + (slot - 2) * 64 + e;
        case 2: return O_CQ + slot * 64 + e;
        case 3: if (slot < 2) return O_CQ + 256 + slot * 64 + e; if (slot == 2) return e < 32 ? O_IK + e : O_CKR + (e - 32); return e < 4 ? O_IW + e : -1;
        case 4: return O_CKV + slot * 64 + e;
        default: if (pn <= 7) return O_B + (pn - 5) * 256 + slot * 64 + e; return O_D + (pn - 8) * 256 + slot * 64 + e;
    }
}
__device__ __forceinline__ float row_scale(const float* ssq, int row, int fr, int fq) {
    const f32x4 a = *(const f32x4*)(ssq + (size_t)row * 16 + 4 * fq); float s = (a[0] + a[1]) + (a[2] + a[3]);
    s += bperm_f(((fq ^ 1) << 4) | fr, s); s = xsum32(s);
    return rsqrtf(s * (1.0f / 1024.0f) + EPS);
}
__device__ __forceinline__ void row_scales8(const float* ssq, int row0, int fr, int fq, float (&rs)[2][4]) {
    f32x4 a[2][4];
#pragma unroll
    for (int ai = 0; ai < 2; ++ai)
#pragma unroll
        for (int m = 0; m < 4; ++m) a[ai][m] = *(const f32x4*)(ssq + (size_t)(row0 + ai * 128 + m * 16) * 16 + 4 * fq);
    __builtin_amdgcn_sched_barrier(0);
    float s[2][4], o[2][4];
#pragma unroll
    for (int ai = 0; ai < 2; ++ai)
#pragma unroll
        for (int m = 0; m < 4; ++m) { s[ai][m] = (a[ai][m][0] + a[ai][m][1]) + (a[ai][m][2] + a[ai][m][3]); o[ai][m] = bperm_f(((fq ^ 1) << 4) | fr, s[ai][m]); }
#pragma unroll
    for (int ai = 0; ai < 2; ++ai)
#pragma unroll
        for (int m = 0; m < 4; ++m) rs[ai][m] = rsqrtf(xsum32(s[ai][m] + o[ai][m]) * (1.0f / 1024.0f) + EPS);
}
__device__ __forceinline__ float fast_sigmoid(float x) { return __builtin_amdgcn_rcpf(1.0f + __builtin_amdgcn_exp2f(-x * LOG2E)); }
__device__ __forceinline__ v4u pack8(const f32x4 a, const f32x4 b) { v4u w; w.x = pk2(a[0], a[1]); w.y = pk2(a[2], a[3]); w.z = pk2(b[0], b[1]); w.w = pk2(b[2], b[3]); return w; }

struct EpiFfnIn {
    static constexpr int VM_OPS = 16;
    static constexpr bool CHAIN = false;
    static constexpr bool PERM = true, AFTER_DRAIN = false;
    const float* ssq; bf16* h2;
    __device__ __forceinline__ void operator()(const pg8::f32x4 (&acc)[2][2][4][2], const pg8::Unit& u, int wr, int wc, int fr, int fq) const {
        const int row0 = u.pm * 256 + wr * 64 + fr, colh = u.pn * 128 + wc * 32 + fq * 8;
        float rs[2][4]; row_scales8(ssq, row0, fr, fq, rs);
#pragma unroll
        for (int ai = 0; ai < 2; ++ai)
#pragma unroll
            for (int m = 0; m < 4; ++m) { const int row = row0 + ai * 128 + m * 16; const float s = rs[ai][m], sm = -s * LOG2E, ss = s * s;
                unsigned w[4];
#pragma unroll
                for (int n = 0; n < 2; ++n)
#pragma unroll
                    for (int jp = 0; jp < 2; ++jp) { const f32x2_t a = {acc[ai][0][m][n][2 * jp], acc[ai][0][m][n][2 * jp + 1]}, b = {acc[ai][1][m][n][2 * jp], acc[ai][1][m][n][2 * jp + 1]};
                        const f32x2_t t = a * sm; f32x2_t d = {__builtin_amdgcn_exp2f(t.x), __builtin_amdgcn_exp2f(t.y)}; d = d + 1.0f;
                        const f32x2_t r = {__builtin_amdgcn_rcpf(d.x), __builtin_amdgcn_rcpf(d.y)}, h = ((a * b) * ss) * r; w[2 * n + jp] = pk2(h.x, h.y); }
                v4u wv; wv.x = w[0]; wv.y = w[1]; wv.z = w[2]; wv.w = w[3];
                __builtin_nontemporal_store(wv, (v4u*)(h2 + (size_t)row * DFF + colh)); }
    }
};
struct EpiResid {
    static constexpr int VM_OPS = 32;
    static constexpr bool CHAIN = false;
    static constexpr bool PERM = true, AFTER_DRAIN = false;
    float* out; bf16* xb; float* ssq; float alpha;
    __device__ __forceinline__ void operator()(const pg8::f32x4 (&acc)[2][2][4][2], const pg8::Unit& u, int wr, int wc, int fr, int fq) const {
        const int row0 = u.pm * 256 + wr * 64 + fr, col0 = u.pn * 256 + wc * 32 + fq * 8;
        const bool fin = out != nullptr;
#pragma unroll
        for (int ai = 0; ai < 2; ++ai) {
            v4u bv[4][2];
#pragma unroll
            for (int m = 0; m < 4; ++m)
#pragma unroll
                for (int bj = 0; bj < 2; ++bj) bv[m][bj] = *(const v4u*)(xb + (size_t)(row0 + ai * 128 + m * 16) * DM + col0 + bj * 128);
            __builtin_amdgcn_sched_barrier(0);
#pragma unroll
            for (int m = 0; m < 4; ++m) { const int row = row0 + ai * 128 + m * 16; float ss = 0.f;
#pragma unroll
                for (int bj = 0; bj < 2; ++bj) { const size_t o = (size_t)row * DM + col0 + bj * 128; const v4u b = bv[m][bj];
                    f32x4 x0, x1;
                    x0[0] = __uint_as_float(b.x << 16); x0[1] = __uint_as_float(b.x & 0xffff0000u); x0[2] = __uint_as_float(b.y << 16); x0[3] = __uint_as_float(b.y & 0xffff0000u);
                    x1[0] = __uint_as_float(b.z << 16); x1[1] = __uint_as_float(b.z & 0xffff0000u); x1[2] = __uint_as_float(b.w << 16); x1[3] = __uint_as_float(b.w & 0xffff0000u);
#pragma unroll
                    for (int j = 0; j < 4; ++j) { x0[j] += alpha * acc[ai][bj][m][0][j]; x1[j] += alpha * acc[ai][bj][m][1][j]; ss += x0[j] * x0[j] + x1[j] * x1[j]; }
                    if (fin) { *(f32x4*)(out + o) = x0; *(f32x4*)(out + o + 4) = x1; }
                    *(v4u*)(xb + o) = pack8(x0, x1); }
                ss += bperm_f(((fq ^ 1) << 4) | fr, ss); ss = xsum32(ss);
                if (fq == 0) ssq[(size_t)row * 16 + u.pn * 4 + wc] = ss; }
            __builtin_amdgcn_sched_barrier(0);
        }
    }
};
struct EpiInProj {
    static constexpr int VM_OPS = 24;
    static constexpr bool CHAIN = false;
    static constexpr bool PERM = true, AFTER_DRAIN = false;
    const float* ssq;
    unsigned char* ws;
    const float* g_a; const float* g_b; const float* g_d;
    const float* bgate;
    __device__ __forceinline__ void operator()(const pg8::f32x4 (&acc)[2][2][4][2], const pg8::Unit& u, int wr, int wc, int fr, int fq) const {
        const int pn = u.pn, row0 = u.pm * 256 + wr * 64 + fr;
        bf16* const tiles = (bf16*)(ws + WS_R);
        float rs[2][4]; row_scales8(ssq, row0, fr, fq, rs);
        if (pn >= 17) {
            const int g = pn - 17, nb = g >> 2, ch = g & 3; const float* bg = bgate + nb * 1024 + ch * 256 + wc * 32 + fq * 8;
            f32x4 bv[2][2];
#pragma unroll
            for (int bj = 0; bj < 2; ++bj) { bv[bj][0] = *(const f32x4*)(bg + bj * 128); bv[bj][1] = *(const f32x4*)(bg + bj * 128 + 4); }
            unsigned char* dst = (unsigned char*)(tiles + (size_t)pn * MH * 256) + wc * 32 + fq * 8;
#pragma unroll
            for (int ai = 0; ai < 2; ++ai)
#pragma unroll
                for (int m = 0; m < 4; ++m) { const int row = row0 + ai * 128 + m * 16; const float s = rs[ai][m];
#pragma unroll
                    for (int bj = 0; bj < 2; ++bj) { unsigned q[8];
#pragma unroll
                        for (int j = 0; j < 4; ++j) { q[j] = (unsigned)fmaxf(fast_sigmoid(acc[ai][bj][m][0][j] * s + bv[bj][0][j]) * 255.0f + 0.5f, 1.0f); q[4 + j] = (unsigned)fmaxf(fast_sigmoid(acc[ai][bj][m][1][j] * s + bv[bj][1][j]) * 255.0f + 0.5f, 1.0f); }
                        v2u w; w.x = q[0] | (q[1] << 8) | (q[2] << 16) | (q[3] << 24); w.y = q[4] | (q[5] << 8) | (q[6] << 16) | (q[7] << 24);
                        *(v2u*)(dst + (size_t)row * 256 + bj * 128) = w; } }
            return;
        }
        bf16* dst; int ld; int mode = 0  ; const float* gain = nullptr; float scale = 1.f; float* ssl = nullptr; bool iw = false;
        switch (pn) {
            case 0: dst = tiles + wc * 64; ld = 256; mode = 1; gain = g_a; scale = C2A; break;
            case 1: dst = tiles + (size_t)1 * MH * 256 + wc * 64; ld = 256; if (wc == 0) { mode = 1; gain = g_a + 64; } break;
            case 2: dst = (bf16*)(ws + WS_CQL) + wc * 64; ld = 384; ssl = (float*)(ws + WS_SSL) + wc; break;
            case 3: if (wc < 2) { dst = (bf16*)(ws + WS_CQL) + 256 + wc * 64; ld = 384; ssl = (float*)(ws + WS_SSL) + 4 + wc; } else { dst = (bf16*)(ws + WS_XS) + (wc - 2) * 64; ld = 128; iw = (wc == 3); } break;
            case 4: dst = (bf16*)(ws + WS_CKVL) + wc * 64; ld = 256; ssl = (float*)(ws + WS_SSL) + 6 + wc; break;
            default: dst = tiles + (size_t)pn * MH * 256 + wc * 64; ld = 256;
                if (pn == 5) { mode = 1; gain = g_b; scale = C2A; } else if (pn == 6) { mode = 1; gain = g_b + 64; }
                else if (pn >= 8 && pn <= 10) { mode = 1; gain = g_d; scale = C2A; } else if (pn >= 11 && pn <= 13) { mode = 1; gain = g_d + 64; }
                break;
        }
        f32x4 gv[2][2];
#pragma unroll
        for (int bj = 0; bj < 2; ++bj)
#pragma unroll
            for (int n = 0; n < 2; ++n) gv[bj][n] = mode ? *(const f32x4*)(gain + 32 * bj + 8 * fq + 4 * n) : (f32x4){1.f, 1.f, 1.f, 1.f};
#pragma unroll
        for (int ai = 0; ai < 2; ++ai)
#pragma unroll
            for (int m = 0; m < 4; ++m) { const int row = row0 + ai * 128 + m * 16; const float s = rs[ai][m];
                f32x4 v[2][2]; float ss = 0.f;
#pragma unroll
                for (int bj = 0; bj < 2; ++bj)
#pragma unroll
                    for (int n = 0; n < 2; ++n)
#pragma unroll
                        for (int j = 0; j < 4; ++j) { const float t = acc[ai][bj][m][n][j] * s; v[bj][n][j] = t; ss += t * t; }
                if (mode || ssl) { ss += bperm_f(((fq ^ 1) << 4) | fr, ss); ss = xsum32(ss); }
                if (ssl && fq == 0) ssl[(size_t)row * 16] = ss;
                if (iw && fq == 0) *(f32x4*)((float*)(ws + WS_IWF) + (size_t)row * 4) = v[0][0];
                const float r = mode ? rsqrtf(ss * (1.0f / 64.0f) + EPS) * scale : 1.f;
#pragma unroll
                for (int bj = 0; bj < 2; ++bj) { f32x4 a, b;
#pragma unroll
                    for (int j = 0; j < 4; ++j) { a[j] = v[bj][0][j] * r * gv[bj][0][j]; b[j] = v[bj][1][j] * r * gv[bj][1][j]; }
                    *(v4u*)(dst + (size_t)row * ld + 32 * bj + 8 * fq) = pack8(a, b); } }
    }
};

struct MergeOrder {
    pg8::StaticOrder S; int a1, a2, a3;
    const unsigned* ready; unsigned* tmo;
    __device__ __forceinline__ bool next(int i, pg8::Unit& u) const { pg8::Unit t; if (!S.next(i >> 2, t)) return false; const int n = i & 3; u.pm = t.pm; u.pn = t.pn; u.ao = __builtin_amdgcn_readfirstlane(n == 0 ? 0 : n == 1 ? a1 : n == 2 ? a2 : a3); u.bo = __builtin_amdgcn_readfirstlane(n * (DM * 256 * 2)); return true; }
    __device__ __forceinline__ void a_ready(const pg8::Unit& u) const {
        if (u.bo != 3 * (DM * 256 * 2)) return;
        if (threadIdx.x < 64) { unsigned spins = 0;
            while ((unsigned)__builtin_amdgcn_readfirstlane(__hip_atomic_load(ready + 64 * u.pm, __ATOMIC_RELAXED, __HIP_MEMORY_SCOPE_AGENT)) < 32u) {
                __builtin_amdgcn_s_sleep(2);
                if (++spins > (1u << 22)) { if (threadIdx.x == 0) __hip_atomic_store(tmo, 1u, __ATOMIC_RELAXED, __HIP_MEMORY_SCOPE_AGENT); break; } }
            __builtin_amdgcn_fence(__ATOMIC_ACQUIRE, "agent");
            asm volatile("s_waitcnt vmcnt(0)" ::: "memory"); }
        asm volatile("" ::: "memory"); __builtin_amdgcn_s_barrier(); asm volatile("" ::: "memory");
    }
    __device__ __forceinline__ void done(const pg8::Unit&) const {}
};
struct EpiMerge {
    static constexpr int VM_OPS = 0;
    static constexpr bool PERM = true, AFTER_DRAIN = false, CHAIN = true;
    const bf16* gates;
    bf16* U;
    __device__ __forceinline__ bool chain(pg8::f32x4 (&acc)[2][2][4][2], const pg8::Unit& u, int wr, int wc, int fr, int fq) const {
        const int n = (int)(u.bo / (DM * 256 * 2)); const int row0 = u.pm * 256 + wr * 64 + fr, ct = wc * 32 + fq * 8;
        const unsigned char* gt = (const unsigned char*)(gates + (size_t)(n * 4 + u.pn) * MH * 256) + (size_t)row0 * 256 + ct; bf16* up = U + u.pn * 256 + ct;
        const size_t gnext = (n < 3) ? (size_t)4 * MH * 256 * 2 : 0;
        v2u gv[16], gw[16];
#pragma unroll
        for (int i = 0; i < 16; ++i) { const unsigned char* gp = gt + (size_t)((i >> 3) * 128 + ((i >> 1) & 3) * 16) * 256 + (i & 1) * 128; gv[i] = *(const v2u*)gp; gw[i] = *(const v2u*)(gp + gnext); }
        __builtin_amdgcn_sched_barrier(0);
#pragma unroll
        for (int ai = 0; ai < 2; ++ai)
#pragma unroll
            for (int m = 0; m < 4; ++m) { const int row = row0 + ai * 128 + m * 16;
#pragma unroll
                for (int bj = 0; bj < 2; ++bj) { const v2u a = gv[ai * 8 + m * 2 + bj], b = gw[ai * 8 + m * 2 + bj];
                    if (n < 3) {
#pragma unroll
                        for (int k = 0; k < 4; ++k) { acc[ai][bj][m][0][k] *= (float)((a.x >> (8 * k)) & 0xffu) * __builtin_amdgcn_rcpf((float)((b.x >> (8 * k)) & 0xffu));
                            acc[ai][bj][m][1][k] *= (float)((a.y >> (8 * k)) & 0xffu) * __builtin_amdgcn_rcpf((float)((b.y >> (8 * k)) & 0xffu)); }
                    } else { f32x4 x0, x1; constexpr float Q = 1.0f / 255.0f;
#pragma unroll
                        for (int k = 0; k < 4; ++k) { x0[k] = (float)((a.x >> (8 * k)) & 0xffu) * Q * acc[ai][bj][m][0][k]; x1[k] = (float)((a.y >> (8 * k)) & 0xffu) * Q * acc[ai][bj][m][1][k]; }
                        *(v4u*)(up + (size_t)row * DM + bj * 128) = pack8(x0, x1); } } }
        return n < 3;
    }
};
struct EpiNull {
    static constexpr int VM_OPS = 0;
    static constexpr bool CHAIN = false, PERM = true, AFTER_DRAIN = false;
    float* dummy;
    __device__ __forceinline__ void operator()(const pg8::f32x4 (&acc)[2][2][4][2], const pg8::Unit& u, int wr, int wc, int fr, int fq) const {
        float s = 0.f;
#pragma unroll
        for (int ai = 0; ai < 2; ++ai)
#pragma unroll
            for (int bj = 0; bj < 2; ++bj)
#pragma unroll
                for (int m = 0; m < 4; ++m)
#pragma unroll
                    for (int n = 0; n < 2; ++n) s += acc[ai][bj][m][n][0] + acc[ai][bj][m][n][1] + acc[ai][bj][m][n][2] + acc[ai][bj][m][n][3];
        if (s == 1.2345e-30f) dummy[0] = s;
    }
};
struct EpiFfnInCheap {
    static constexpr int VM_OPS = 0;
    static constexpr bool CHAIN = false;
    static constexpr bool PERM = true, AFTER_DRAIN = false;
    const float* ssq; bf16* h2;
    __device__ __forceinline__ void operator()(const pg8::f32x4 (&acc)[2][2][4][2], const pg8::Unit& u, int wr, int wc, int fr, int fq) const {
        const int row0 = u.pm * 256 + wr * 64 + fr, colh = u.pn * 128 + wc * 32 + fq * 8;
#pragma unroll
        for (int ai = 0; ai < 2; ++ai)
#pragma unroll
            for (int m = 0; m < 4; ++m) { const int row = row0 + ai * 128 + m * 16; f32x4 a = acc[ai][0][m][0] + acc[ai][1][m][0], b = acc[ai][0][m][1] + acc[ai][1][m][1];
#if defined(PROBE_K) && PROBE_K == 4
                __builtin_nontemporal_store(pack8(a, b), (v4u*)(h2 + (size_t)row * DFF + colh)); }
#else
                *(v4u*)(h2 + (size_t)row * DFF + colh) = pack8(a, b); }
#endif
    }
};

struct EpiMergeCheap {
    static constexpr int VM_OPS = 0;
    static constexpr bool PERM = true, AFTER_DRAIN = false, CHAIN = true;
    bf16* U;
    __device__ __forceinline__ bool chain(pg8::f32x4 (&acc)[2][2][4][2], const pg8::Unit& u, int wr, int wc, int fr, int fq) const {
        const int n = (int)(u.bo / (DM * 256 * 2)); const int row0 = u.pm * 256 + wr * 64 + fr, ct = wc * 32 + fq * 8; bf16* up = U + u.pn * 256 + ct;
        if (n == 3) {
#pragma unroll
            for (int ai = 0; ai < 2; ++ai)
#pragma unroll
                for (int m = 0; m < 4; ++m) { const int row = row0 + ai * 128 + m * 16;
#pragma unroll
                    for (int bj = 0; bj < 2; ++bj) *(v4u*)(up + (size_t)row * DM + bj * 128) = pack8(acc[ai][bj][m][0], acc[ai][bj][m][1]); } }
        return n < 3;
    }
};
namespace att {
constexpr int L_BUF = 20480, L_V = 12288;
constexpr int L_BIAS = 3 * L_BUF;
constexpr int L_MASK = L_BIAS + 4 * 2112 * 4;
constexpr int L_BID = L_MASK + 64 * 65 * 4;
constexpr int L_MISC = L_BID + 2112;
constexpr int L_END = L_MISC + 64;
__device__ __forceinline__ void glds16(const void* gsrc, unsigned lds_dst) { unsigned keep;
    asm volatile("s_mov_b32 %0, m0\n\ts_mov_b32 m0, %2\n\ts_nop 0\n\tglobal_load_lds_dwordx4 %1, off\n\ts_mov_b32 m0, %0" : "=&s"(keep) : "v"(gsrc), "s"(lds_dst) : "memory"); }
__device__ __forceinline__ int crow(int r, int hi) { return (r & 3) + 8 * (r >> 2) + 4 * hi; }
__device__ __forceinline__ float max3f(float a, float b, float c) { float r; asm("v_max3_f32 %0, %1, %2, %3" : "=v"(r) : "v"(a), "v"(b), "v"(c)); return r; }
__device__ __forceinline__ unsigned cvtpk(float lo, float hi) { f32x2_t v = {lo, hi}; bf16x2_t b = __builtin_convertvector(v, bf16x2_t); return __builtin_bit_cast(unsigned, b); }
typedef short v4i16_t __attribute__((ext_vector_type(4)));
__device__ __forceinline__ s16x4 vtr(const LAS unsigned char* p) { return __builtin_bit_cast(s16x4, __builtin_amdgcn_ds_read_tr16_b64_v4i16((LAS v4i16_t*)p)); }
#define ATT_WAIT_BAR() asm volatile("s_waitcnt vmcnt(0) lgkmcnt(0)\n\ts_barrier" ::: "memory")
#define ATT_WAIT_BAR_N(N) asm volatile("s_waitcnt vmcnt(" #N ") lgkmcnt(0)\n\ts_barrier" ::: "memory")

struct Unit { int kind, b, h, qt, g, r; };
constexpr int NU_BIG = 768, NU_D0 = 256, NU_D1 = 256, NU_D2 = 512, NU_TOTAL = NU_BIG + NU_D0 + NU_D1 + NU_D2;
__device__ __forceinline__ Unit decode(int idx) {
    Unit u{};
    if (idx < NU_BIG) { const int level = 7 - idx / 96, k = idx % 96;
        if (k < 32) { u.kind = 2; u.b = k >> 2; u.h = k & 3; u.qt = level; }
        else if (k < 64) { u.kind = 1; u.b = (k - 32) >> 2; u.h = k & 3; u.qt = level; }
        else { u.kind = 0; u.b = (k - 64) >> 2; u.qt = 4 * level + 3 - (k & 3); }
        return u; }
    idx -= NU_BIG; u.kind = 3;
    if (idx < NU_D0) { u.g = 0; u.r = 0; u.b = idx >> 5; u.h = (idx >> 3) & 3; u.qt = 7 - (idx & 7); return u; }
    idx -= NU_D0;
    if (idx < NU_D1) { u.g = 1; u.b = idx >> 5; u.h = (idx >> 3) & 3; u.r = (idx >> 1) & 3; u.qt = 1 - (idx & 1); return u; }
    idx -= NU_D1; u.g = 2; u.b = idx >> 6; u.h = (idx >> 4) & 3; u.r = idx & 15; u.qt = 0; return u;
}

template <int KIND> __device__ __forceinline__ void run_unit(unsigned char* ws, LAS unsigned char* lds, const Unit u, const bool dry, unsigned* queue, const bool ahead) {
    constexpr int DQK = (KIND == 2) ? 96 : 64, ND0 = DQK / 16, NCH = DQK / 8;
    int tid_ = threadIdx.x; asm volatile("" : "+v"(tid_));
    const int tid = tid_, lane = tid & 63, r32 = lane & 31, hi = lane >> 5, w = __builtin_amdgcn_readfirstlane(tid >> 6);
    const bf16* const tiles = (const bf16*)(ws + WS_R);
    unsigned pre = 0u; if (ahead && tid == 0) pre = __hip_atomic_fetch_add(queue, 1u, __ATOMIC_RELAXED, __HIP_MEMORY_SCOPE_AGENT);
    const int brow = u.b * SEQ;
    const bf16 *Qp, *Kb, *Vb; bf16* Op; int ldq, ldk, ldv, ldo;
    int tq;
    int kt0, kt1;
    int dil = 1, rr = 0, jb = 0;
    const int head = (KIND == 0) ? (w >> 1) : u.h;
    if constexpr (KIND == 0) { tq = 64 * u.qt + 32 * (w & 1) + r32; ldq = ldk = ldv = ldo = 256;
        Qp = tiles + (size_t)(brow + tq) * 256 + head * 64; Op = (bf16*)Qp; Kb = tiles + (size_t)1 * MH * 256 + (size_t)brow * 256; Vb = Kb + 64; kt0 = 0; kt1 = u.qt; }
    if constexpr (KIND == 1) { tq = 256 * u.qt + 32 * w + r32; ldq = ldk = ldv = ldo = 256;
        Qp = tiles + (size_t)5 * MH * 256 + (size_t)(brow + tq) * 256 + head * 64; Op = (bf16*)Qp; Kb = tiles + (size_t)6 * MH * 256 + (size_t)brow * 256 + head * 64; Vb = tiles + (size_t)7 * MH * 256 + (size_t)brow * 256 + head * 64; kt0 = 0; kt1 = 4 * u.qt + 3; }
    if constexpr (KIND == 2) { tq = 256 * u.qt + 32 * w + r32; ldq = ldk = 384; ldv = ldo = 256;
        Qp = (const bf16*)(ws + WS_QN) + (size_t)(brow + tq) * 384 + head * 96; Op = (bf16*)(ws + WS_OC) + (size_t)(brow + tq) * 256 + head * 64; Kb = (const bf16*)(ws + WS_KN) + (size_t)brow * 384 + head * 96; Vb = (const bf16*)(ws + WS_VC) + (size_t)brow * 256 + head * 64; kt0 = 0; kt1 = 4 * u.qt + 3; }
    if constexpr (KIND == 3) { dil = u.g == 0 ? 1 : u.g == 1 ? 4 : 16; rr = u.r; tq = 256 * u.qt + 32 * w + r32; ldq = ldk = ldv = ldo = 256; jb = 256 * u.qt - 128;
        const int tok = (tq < SEQ / dil ? tq : 0) * dil + rr;
        Qp = tiles + (size_t)(8 + u.g) * MH * 256 + (size_t)(brow + tok) * 256 + head * 64; Op = (bf16*)Qp; Kb = tiles + (size_t)(11 + u.g) * MH * 256 + (size_t)brow * 256 + head * 64; Vb = tiles + (size_t)(14 + u.g) * MH * 256 + (size_t)brow * 256 + head * 64;
        kt0 = (u.qt == 0) ? 2 : 0; kt1 = (u.g == 2) ? 3 : 5; }
    const bool wave_on = (KIND != 3) || (256 * u.qt + 32 * w < SEQ / dil);
    bf16x8 qr[ND0];
#pragma unroll
    for (int d0 = 0; d0 < ND0; ++d0) qr[d0] = *(const bf16x8*)(Qp + 16 * d0 + 8 * hi);
    LAS float* btab = (LAS float*)(lds + L_BIAS);
    if constexpr (KIND == 0) { const float* src = (const float*)(ws + WS_BIAS); for (int i = tid; i < 4 * 2112; i += NTHR) btab[i] = src[i]; }
    if constexpr (KIND == 1) { const float* src = (const float*)(ws + WS_BIAS) + (4 + head) * 2112; for (int i = tid; i < 2112; i += NTHR) btab[i] = src[i]; }
    if constexpr (KIND == 3) { const float* src = (const float*)(ws + WS_BIASD) + (u.g * 4 + head) * 192; if (tid < 256) btab[tid] = tid >= 64 ? src[tid - 64] : 0.f; }
    if constexpr (KIND == 0 || KIND == 1) { if (tid < 132) *(LAS v4u*)(lds + L_BID + 16 * tid) = *(const v4u*)(ws + WS_BID + 16 * tid); }
    unsigned selmask = 0u;
    if constexpr (KIND == 1) {
        const int own = u.qt; const float* km = (const float*)(ws + WS_KMEAN) + (size_t)(u.b * 8) * 256 + head * 64;
        float gate[8];
#pragma unroll
        for (int n = 0; n < 8; ++n) { float a = 0.f;
            if (n < own) {
#pragma unroll
                for (int d0 = 0; d0 < 4; ++d0)
#pragma unroll
                    for (int j = 0; j < 8; ++j) a += bf2f((bf16)qr[d0][j]) * km[n * 256 + 16 * d0 + 8 * hi + j];
                a = xsum32(a); } else a = -INFINITY;
            gate[n] = a; }
#pragma unroll
        for (int rnd = 0; rnd < 3; ++rnd) { int best = -1; float bv = 0.f;
#pragma unroll
            for (int n = 0; n < 8; ++n) { const bool ok = !((selmask >> n) & 1u) && (best < 0 || gate[n] > bv); if (ok) { best = n; bv = gate[n]; } }
            selmask |= 1u << best; }
        selmask &= (1u << own) - 1u;
        if (tid == 0) ((volatile LAS unsigned*)(lds + L_MISC))[1] = 0u;
    }
    const unsigned lds0 = (unsigned)(uintptr_t)lds;
    constexpr int L_VR = 3 * L_V;
    auto tokof = [&](int kt, int j) -> int { if constexpr (KIND == 3) { int jj = jb + 64 * kt + j; jj = jj < 0 ? 0 : jj; return jj * dil + rr; } else return 64 * kt + j; };
    auto dmaK = [&](int kt, int slot) {
        const int tk = tokof(kt, lane);
        glds16(Kb + (size_t)tk * ldk + w * 8, (unsigned)__builtin_amdgcn_readfirstlane(lds0 + slot * L_V + w * 1024));
        if (DQK == 96) glds16(Kb + (size_t)tk * ldk + (8 + (w & 3)) * 8, (unsigned)__builtin_amdgcn_readfirstlane(lds0 + slot * L_V + (8 + (w & 3)) * 1024));
    };
    auto dmaV = [&](int kt, int slot) {
        const int tv = tokof(kt, 16 * (w & 3) + (lane >> 2));
        glds16(Vb + (size_t)tv * ldv + (w >> 2) * 32 + (lane & 3) * 8, (unsigned)__builtin_amdgcn_readfirstlane(lds0 + L_VR + slot * 8192 + w * 1024));
    };
    if constexpr (KIND == 0) {
        const unsigned long long* msrc = (const unsigned long long*)(ws + WS_MASK) + (size_t)((brow + 64 * u.qt) >> 2) * 128; LAS unsigned* mdst = (LAS unsigned*)(lds + L_MASK); const int nw = 2 * (u.qt + 1);
        for (int i = tid; i < 64 * 64; i += NTHR) { const int q = i >> 6, wi = i & 63; if (wi < nw) { const unsigned long long b0 = msrc[(size_t)(q >> 2) * 128 + 2 * wi], b1 = msrc[(size_t)(q >> 2) * 128 + 2 * wi + 1]; const int sh = 16 * (q & 3);
                mdst[q * 65 + wi] = ((unsigned)(b0 >> sh) & 0xffffu) | (((unsigned)(b1 >> sh) & 0xffffu) << 16); } } }
    if constexpr (KIND == 1) { __syncthreads(); if (selmask) (void)__hip_atomic_fetch_or((LAS unsigned*)(lds + L_MISC) + 1, selmask, __ATOMIC_RELAXED, __HIP_MEMORY_SCOPE_WORKGROUP); }
    __syncthreads();
    unsigned umask = 0xffffffffu; if constexpr (KIND == 1) umask = ((volatile LAS unsigned*)(lds + L_MISC))[1];
    asm volatile("s_waitcnt vmcnt(0)" ::: "memory");
#pragma unroll
    for (int d0 = 0; d0 < ND0; ++d0) asm volatile("" : "+v"(qr[d0]));
    asm volatile("" : "+v"(pre)); if (ahead && tid == 0) ((volatile LAS unsigned*)(lds + L_MISC))[2] = pre;
    float mrun = -1e30f; f32x16 o[2], lacc;
#pragma unroll
    for (int i = 0; i < 16; ++i) { o[0][i] = 0.f; o[1][i] = 0.f; lacc[i] = 0.f; }
    const bf16x8 ones = (bf16x8){0x3f80, 0x3f80, 0x3f80, 0x3f80, 0x3f80, 0x3f80, 0x3f80, 0x3f80};
    const LAS unsigned* mrow = (const LAS unsigned*)(lds + L_MASK) + (32 * (w & 1) + r32) * 65;
    auto tile_needed = [&](int kt) -> bool { if constexpr (KIND == 1) { const int blk = kt >> 2; return blk == u.qt || ((umask >> blk) & 1u); } else return true; };
    auto next_tile = [&](int t) -> int { ++t; while (t <= kt1 && !tile_needed(t)) ++t; return t; };
    auto blk_code = [&](int kt, int b) -> int {
        if (!wave_on) return 3;
        if constexpr (KIND == 0) { const int d = 2 * (kt - u.qt) + b - (w & 1); return d < 0 ? 0 : d == 0 ? 1 : 3; }
        if constexpr (KIND == 1) { const int blk = kt >> 2; if (blk == u.qt) { const int d = 2 * (kt & 3) + b - w; return d < 0 ? 0 : d == 0 ? 1 : 3; } return __any((selmask >> blk) & 1u) ? 0 : 3; }
        if constexpr (KIND == 2) { const int d = 2 * kt + b - (8 * u.qt + w); return d < 0 ? 0 : d == 0 ? 1 : 3; }
        if constexpr (KIND == 3) { const int d = 2 * kt + b - w; if (d < 0 || d > 4 || (jb + 64 * kt + 32 * b < 0)) return 3; return d == 4 ? 1 : d == 0 ? 2 : 0; }
        return 0; };
    auto qk = [&](int kslot, f32x16& p0, f32x16& p1) {
        const LAS unsigned char* Ks = lds + kslot * L_V;
        bf16x8 kf[ND0][2];
#pragma unroll
        for (int d0 = 0; d0 < ND0; ++d0) { kf[d0][0] = *(const LAS bf16x8*)(Ks + (2 * d0 + hi) * 1024 + r32 * 16); kf[d0][1] = *(const LAS bf16x8*)(Ks + (2 * d0 + hi) * 1024 + 512 + r32 * 16); }
        __builtin_amdgcn_sched_barrier(0);
#pragma unroll
        for (int i = 0; i < 16; ++i) { p0[i] = 0.f; p1[i] = 0.f; }
#pragma unroll
        for (int d0 = 0; d0 < ND0; ++d0) { p0 = __builtin_amdgcn_mfma_f32_32x32x16_bf16(kf[d0][0], qr[d0], p0, 0, 0, 0); p1 = __builtin_amdgcn_mfma_f32_32x32x16_bf16(kf[d0][1], qr[d0], p1, 0, 0, 0); }
        __builtin_amdgcn_sched_barrier(0); };
    auto sm_pv = [&](int kt, int vslot, int c0, int c1, f32x16& p0, f32x16& p1) {
        const LAS unsigned char* Vs = lds + L_VR + vslot * 8192;
        float cadd = 0.f;
        if constexpr (KIND == 0 || KIND == 1) { const int tqw = tq - r32; int dmin = tqw - 64 * kt - 63, dmax = tqw + 31 - 64 * kt; dmin = dmin < 0 ? 0 : dmin; dmax = dmax < 0 ? 0 : dmax;
            const LAS unsigned char* bid = lds + L_BID + 64; const LAS float* bth = btab + (KIND == 0 ? head * 2112 : 0) + 64;
            if (bid[dmin] == bid[dmax]) cadd = bth[dmin];
            else { const LAS float* bt = bth + (tq - 64 * kt - 4 * hi);
#pragma unroll
                for (int i = 0; i < 16; ++i) { p0[i] += bt[-((i & 3) + 8 * (i >> 2))]; p1[i] += bt[-32 - ((i & 3) + 8 * (i >> 2))]; } }
            if constexpr (KIND == 1) { const int blk = kt >> 2; if (blk != u.qt && !((selmask >> blk) & 1u)) cadd = -INFINITY; } }
        if constexpr (KIND == 3) { const LAS float* bt = btab + 64 + (tq - (jb + 64 * kt + 4 * hi));
#pragma unroll
            for (int i = 0; i < 16; ++i) { p0[i] += bt[-((i & 3) + 8 * (i >> 2))]; p1[i] += bt[-32 - ((i & 3) + 8 * (i >> 2))]; } }
        if (c0 | c1) {
            const int lo0 = (c0 == 2 ? r32 : c0 == 3 ? 64 : 0) - 4 * hi, hi0 = (c0 == 1 ? r32 : c0 == 3 ? -1 : 63) - 4 * hi;
            const int lo1 = (c1 == 2 ? r32 : c1 == 3 ? 64 : 0) - 4 * hi, hi1 = (c1 == 1 ? r32 : c1 == 3 ? -1 : 63) - 4 * hi;
#pragma unroll
            for (int i = 0; i < 16; ++i) { const int c = (i & 3) + 8 * (i >> 2);
                p0[i] = (c < lo0 || c > hi0) ? -INFINITY : p0[i];
                p1[i] = (c < lo1 || c > hi1) ? -INFINITY : p1[i]; } }
        float mxa = max3f(p0[0], p0[1], p1[0]), mxb = max3f(p0[2], p0[3], p1[1]); mxa = max3f(mxa, p1[2], p1[3]);
#pragma unroll
        for (int i = 4; i < 16; i += 4) { mxa = max3f(mxa, p0[i], p0[i + 1]); mxb = max3f(mxb, p0[i + 2], p0[i + 3]); mxa = max3f(mxa, p1[i], p1[i + 1]); mxb = max3f(mxb, p1[i + 2], p1[i + 3]); }
        float mx = xmax32(max3f(mxa, mxb, mxb)) + cadd;
        const float mnew = (mx > mrun + 6.0f) ? mx : mrun;
        if (__any(mnew > mrun)) { const float al = __builtin_amdgcn_exp2f(mrun - mnew);
#pragma unroll
            for (int i = 0; i < 16; ++i) { o[0][i] *= al; o[1][i] *= al; lacc[i] *= al; } }
        mrun = mnew; const float sub = cadd - mnew;
#pragma unroll
        for (int i = 0; i < 16; ++i) { p0[i] = __builtin_amdgcn_exp2f(p0[i] + sub); p1[i] = __builtin_amdgcn_exp2f(p1[i] + sub); }
        if constexpr (KIND == 0) { const int w0 = (int)(mrow[2 * kt] >> (4 * hi)), w1 = (int)(mrow[2 * kt + 1] >> (4 * hi));
#pragma unroll
            for (int i = 0; i < 16; ++i) { const int bp = (i & 3) + 8 * (i >> 2); p0[i] = __int_as_float(__float_as_int(p0[i]) & __builtin_amdgcn_sbfe(w0, bp, 1)); p1[i] = __int_as_float(__float_as_int(p1[i]) & __builtin_amdgcn_sbfe(w1, bp, 1)); } }
        s16x4 vlo[4][2], vhh[4][2];
#pragma unroll
        for (int s = 0; s < 4; ++s)
#pragma unroll
            for (int db = 0; db < 2; ++db) { const LAS unsigned char* vp = Vs + db * 4096 + s * 1024 + ((lane >> 4) & 1) * 32 + (lane & 3) * 8 + (4 * hi + ((lane & 15) >> 2)) * 64; vlo[s][db] = vtr(vp); vhh[s][db] = vtr(vp + 512); }
        bf16x8 pf[4];
#pragma unroll
        for (int s = 0; s < 4; ++s) { v4u pw;
            if (s < 2) { pw.x = cvtpk(p0[8 * s], p0[8 * s + 1]); pw.y = cvtpk(p0[8 * s + 2], p0[8 * s + 3]); pw.z = cvtpk(p0[8 * s + 4], p0[8 * s + 5]); pw.w = cvtpk(p0[8 * s + 6], p0[8 * s + 7]); }
            else { pw.x = cvtpk(p1[8 * s - 16], p1[8 * s - 15]); pw.y = cvtpk(p1[8 * s - 14], p1[8 * s - 13]); pw.z = cvtpk(p1[8 * s - 12], p1[8 * s - 11]); pw.w = cvtpk(p1[8 * s - 10], p1[8 * s - 9]); }
            pf[s] = __builtin_bit_cast(bf16x8, pw); }
        __builtin_amdgcn_sched_barrier(0);
#pragma unroll
        for (int s = 0; s < 4; ++s) {
            lacc = __builtin_amdgcn_mfma_f32_32x32x16_bf16(ones, pf[s], lacc, 0, 0, 0);
#pragma unroll
            for (int db = 0; db < 2; ++db) { const bf16x8 vf = (bf16x8){vlo[s][db][0], vlo[s][db][1], vlo[s][db][2], vlo[s][db][3], vhh[s][db][0], vhh[s][db][1], vhh[s][db][2], vhh[s][db][3]};
                o[db] = __builtin_amdgcn_mfma_f32_32x32x16_bf16(vf, pf[s], o[db], 0, 0, 0); } }
        __builtin_amdgcn_sched_barrier(0); };
#if defined(PROBE_MODE) && PROBE_MODE == 3
    const bool PM_QK = true, PM_SM = !dry;
#elif defined(PROBE_MODE) && PROBE_MODE == 4
    const bool PM_QK = !dry, PM_SM = true;
#elif defined(PROBE_MODE) && PROBE_MODE == 5
    const bool PM_QK = !dry, PM_SM = !dry;
#else
    const bool PM_QK = true, PM_SM = true;
#endif
    constexpr int NOPS = (DQK == 96) ? 3 : 2;
    int cur = next_tile(kt0 - 1), n1 = cur <= kt1 ? next_tile(cur) : cur, n2 = n1 <= kt1 ? next_tile(n1) : n1;
    dmaK(cur, 0);
    if (n1 <= kt1) dmaK(n1, 1);
    dmaV(cur, 0);
    if (n2 <= kt1) { dmaK(n2, 2); dmaV(n1, 1); if (NOPS == 3) ATT_WAIT_BAR_N(3); else ATT_WAIT_BAR_N(2); }
    else { if (n1 <= kt1) dmaV(n1, 1); ATT_WAIT_BAR(); }
    int ks_cur = 0, vs_cur = 0;
    f32x16 sa0, sa1, sb0, sb1;
    { const int c0 = blk_code(cur, 0), c1 = blk_code(cur, 1); if (c0 != 3 || c1 != 3) qk(0, sa0, sa1); }
#define ATT_STEP(x0, x1, y0, y1) { \
        const int n3 = n2 <= kt1 ? next_tile(n2) : n2; \
        const int ks_n1 = ks_cur == 2 ? 0 : ks_cur + 1, vs_n2 = vs_cur == 0 ? 2 : vs_cur - 1; \
        if (n3 <= kt1) { dmaK(n3, ks_cur); dmaV(n2, vs_n2); } else if (n2 <= kt1) dmaV(n2, vs_n2); \
        const int c0 = blk_code(cur, 0), c1 = blk_code(cur, 1); \
        if (n1 <= kt1 && PM_QK) { const int e0 = blk_code(n1, 0), e1 = blk_code(n1, 1); if (e0 != 3 || e1 != 3) qk(ks_n1, y0, y1); } \
        if ((c0 != 3 || c1 != 3) && PM_SM) sm_pv(cur, vs_cur, c0, c1, x0, x1); \
        if (n3 <= kt1) { if (NOPS == 3) ATT_WAIT_BAR_N(3); else ATT_WAIT_BAR_N(2); } else ATT_WAIT_BAR(); \
        cur = n1; n1 = n2; n2 = n3; ks_cur = ks_n1; vs_cur = vs_cur == 2 ? 0 : vs_cur + 1; }
#if defined(PROBE_MODE) && PROBE_MODE == 6
    if (dry) cur = kt1 + 1;
#endif
    while (cur <= kt1) { ATT_STEP(sa0, sa1, sb0, sb1); if (cur > kt1) break; ATT_STEP(sb0, sb1, sa0, sa1); }
#undef ATT_STEP
    if (dry) Op = (bf16*)(ws + WS_END) + (size_t)(tq & 2047) * 256 + head * 64;
    const float lt = lacc[0]; const float inv = 1.0f / lt;
    if (wave_on) {
#pragma unroll
        for (int db = 0; db < 2; ++db)
#pragma unroll
            for (int k2 = 0; k2 < 2; ++k2) { v2u pa, pb; pa.x = cvtpk(o[db][8 * k2] * inv, o[db][8 * k2 + 1] * inv); pa.y = cvtpk(o[db][8 * k2 + 2] * inv, o[db][8 * k2 + 3] * inv); pb.x = cvtpk(o[db][8 * k2 + 4] * inv, o[db][8 * k2 + 5] * inv); pb.y = cvtpk(o[db][8 * k2 + 6] * inv, o[db][8 * k2 + 7] * inv);
                const v4u st = pair16(pa, pb); if (wave_on) *(v4u*)(Op + 32 * db + 16 * k2 + 8 * hi) = st; }
        if constexpr (KIND == 3) { if (hi == 0 && !dry) { const int tok = tq * dil + rr; ((float*)(ws + WS_LSED))[(size_t)(brow + tok) * 16 + u.g * 4 + head] = mrun + log2f(lt); } }
    }
    __syncthreads();
}

__device__ __forceinline__ void phase(unsigned char* ws, LAS unsigned char* lds, unsigned* queue, const bool dry = false, const unsigned kmask = 15u) {
    if (threadIdx.x == 0) ((volatile LAS unsigned*)(lds + L_MISC))[2] = __hip_atomic_fetch_add(queue, 1u, __ATOMIC_RELAXED, __HIP_MEMORY_SCOPE_AGENT);
    for (;;) {
        __syncthreads();
        const int idx = (int)((volatile LAS unsigned*)(lds + L_MISC))[2];
        __syncthreads();
        if (idx >= NU_TOTAL) break;
        const bool ahead = idx < NU_TOTAL - 512;
        const Unit u = decode(idx);
        if ((kmask >> u.kind) & 1u) {
            if (u.kind == 0) run_unit<0>(ws, lds, u, dry, queue, ahead); else if (u.kind == 1) run_unit<1>(ws, lds, u, dry, queue, ahead); else if (u.kind == 2) run_unit<2>(ws, lds, u, dry, queue, ahead); else run_unit<3>(ws, lds, u, dry, queue, ahead);
            if (!ahead && threadIdx.x == 0) ((volatile LAS unsigned*)(lds + L_MISC))[2] = __hip_atomic_fetch_add(queue, 1u, __ATOMIC_RELAXED, __HIP_MEMORY_SCOPE_AGENT);
        } else if (threadIdx.x == 0) ((volatile LAS unsigned*)(lds + L_MISC))[2] = __hip_atomic_fetch_add(queue, 1u, __ATOMIC_RELAXED, __HIP_MEMORY_SCOPE_AGENT);
    }
}
}
#ifndef SEL_NPASS
#define SEL_NPASS 4
#endif
namespace prep {
constexpr int LQ = 392, LKV = 264;
constexpr int L_CQ = 0, L_CKV = 64 * LQ * 2;
constexpr int L_MISC = 131072 - 64;
constexpr int NU_SEL = HBAT * 64, NU_MLA = MH / 64, NU_KM = HBAT * 8, NU_GEMM = MH / 256, NU_TOTAL = NU_GEMM + NU_SEL + NU_MLA + NU_KM;
__device__ __forceinline__ unsigned fkeyu(float f) { const unsigned u = __float_as_uint(f); return (u & 0x80000000u) ? ~u : (u | 0x80000000u); }

__device__ __forceinline__ void mla_unit(unsigned char* ws, LAS unsigned char* lds, int l, int unit, const float* qk_c, const unsigned pv = 0u) {
    int tid_ = threadIdx.x; asm volatile("" : "+v"(tid_));
    const int tid = tid_, lane = tid & 63, r32 = lane & 31, hi = lane >> 5, w = __builtin_amdgcn_readfirstlane(tid >> 6), row0 = unit * 64;
    { const bf16* cql = (const bf16*)(ws + WS_CQL) + (size_t)row0 * 384; const bf16* ckvl = (const bf16*)(ws + WS_CKVL) + (size_t)row0 * 256;
#pragma unroll
      for (int i = 0; i < 6; ++i) { const int c = tid + 512 * i, r = c / 48, ch = c % 48; *(LAS v4u*)(lds + L_CQ + (r * LQ + ch * 8) * 2) = *(const v4u*)(cql + (size_t)r * 384 + ch * 8); }
#pragma unroll
      for (int i = 0; i < 4; ++i) { const int c = tid + 512 * i, r = c >> 5, ch = c & 31; *(LAS v4u*)(lds + L_CKV + (r * LKV + ch * 8) * 2) = *(const v4u*)(ckvl + (size_t)r * 256 + ch * 8); } }
    __syncthreads();
    const float* ssl = (const float*)(ws + WS_SSL); const float* rope = (const float*)(ws + WS_ROPE); const bf16* xs = (const bf16*)(ws + WS_XS);
    if (w < 4) {
        const int h = w; const bf16* wt = (const bf16*)(ws + WS_WUQ) + (size_t)l * 384 * 384 + (size_t)(h * 96) * 384;
        f32x16 acc[3][2];
#pragma unroll
        for (int a = 0; a < 3; ++a)
#pragma unroll
            for (int b = 0; b < 2; ++b)
#pragma unroll
                for (int i = 0; i < 16; ++i) acc[a][b][i] = 0.f;
        bf16x8 wf[3][6];
        const bf16* wl = wt + (size_t)lane * 8;
#define MLQ_ISSUE(st, pr) { _Pragma("unroll") for (int nb = 0; nb < 3; ++nb) { \
            asm volatile("global_load_dwordx4 %0, %1, off" : "=v"(wf[st][nb]) : "v"(wl + (size_t)((2 * (pr)) * 3 + nb) * 512) : "memory"); \
            asm volatile("global_load_dwordx4 %0, %1, off" : "=v"(wf[st][3 + nb]) : "v"(wl + (size_t)((2 * (pr) + 1) * 3 + nb) * 512) : "memory"); } }
#define MLQ_COMPUTE(st, pr) { bf16x8 bfr[2], bgr[2]; \
            _Pragma("unroll") for (int tb = 0; tb < 2; ++tb) { bfr[tb] = *(const LAS bf16x8*)(lds + L_CQ + ((32 * tb + r32) * LQ + 32 * (pr) + 8 * hi) * 2); bgr[tb] = *(const LAS bf16x8*)(lds + L_CQ + ((32 * tb + r32) * LQ + 32 * (pr) + 16 + 8 * hi) * 2); } \
            _Pragma("unroll") for (int nb = 0; nb < 3; ++nb) _Pragma("unroll") for (int tb = 0; tb < 2; ++tb) acc[nb][tb] = __builtin_amdgcn_mfma_f32_32x32x16_bf16(wf[st][nb], bfr[tb], acc[nb][tb], 0, 0, 0); \
            _Pragma("unroll") for (int nb = 0; nb < 3; ++nb) _Pragma("unroll") for (int tb = 0; tb < 2; ++tb) acc[nb][tb] = __builtin_amdgcn_mfma_f32_32x32x16_bf16(wf[st][3 + nb], bgr[tb], acc[nb][tb], 0, 0, 0); }
        asm volatile("s_waitcnt vmcnt(0)" ::: "memory");
        if (!(pv & 2u)) {
        MLQ_ISSUE(0, 0); MLQ_ISSUE(1, 1);
#pragma unroll
        for (int pr = 0; pr < 12; ++pr) {
            if (pr + 2 < 12) { MLQ_ISSUE((pr + 2) % 3, pr + 2); asm volatile("s_waitcnt vmcnt(12)" ::: "memory"); }
            else if (pr + 1 < 12) asm volatile("s_waitcnt vmcnt(6)" ::: "memory"); else asm volatile("s_waitcnt vmcnt(0)" ::: "memory");
#pragma unroll
            for (int k = 0; k < 6; ++k) asm volatile("" : "+v"(wf[pr % 3][k]));
            MLQ_COMPUTE(pr % 3, pr);
        }
        }
#undef MLQ_ISSUE
#undef MLQ_COMPUTE
        bf16* QN = (bf16*)(ws + WS_QN);
        if (!(pv & 1u))
#pragma unroll
        for (int tb = 0; tb < 2; ++tb) { const int row = row0 + 32 * tb + r32, t = row % SEQ; const float* sp = ssl + (size_t)row * 16;
            const float slat = rsqrtf(((sp[0] + sp[1]) + (sp[2] + sp[3]) + (sp[4] + sp[5])) * (1.0f / 384.0f) + EPS);
            float ss = 0.f;
#pragma unroll
            for (int nb = 0; nb < 3; ++nb)
#pragma unroll
                for (int i = 0; i < 16; ++i) { const float v = acc[nb][tb][i] * slat; acc[nb][tb][i] = v; ss += v * v; }
            ss = xsum32(ss); const float hs = rsqrtf(ss * (1.0f / 96.0f) + EPS) * C2C;
#pragma unroll
            for (int nb = 0; nb < 3; ++nb)
#pragma unroll
                for (int i = 0; i < 16; ++i) acc[nb][tb][i] *= hs * qk_c[32 * nb + att::crow(i, hi)];
#pragma unroll
            for (int i = 0; i < 8; ++i) { const int j = att::crow(i, hi); const float c = rope[t * 16 + j], s = rope[SEQ * 16 + t * 16 + j]; const float x1 = acc[2][tb][i], x2 = acc[2][tb][i + 8]; acc[2][tb][i] = x1 * c - x2 * s; acc[2][tb][i + 8] = x1 * s + x2 * c; }
#pragma unroll
            for (int nb = 0; nb < 3; ++nb)
#pragma unroll
                for (int k2 = 0; k2 < 2; ++k2) { v2u pa, pb; pa.x = pk2(acc[nb][tb][8 * k2], acc[nb][tb][8 * k2 + 1]); pa.y = pk2(acc[nb][tb][8 * k2 + 2], acc[nb][tb][8 * k2 + 3]); pb.x = pk2(acc[nb][tb][8 * k2 + 4], acc[nb][tb][8 * k2 + 5]); pb.y = pk2(acc[nb][tb][8 * k2 + 6], acc[nb][tb][8 * k2 + 7]);
                    *(v4u*)(QN + (size_t)row * 384 + h * 96 + 32 * nb + 16 * k2 + 8 * hi) = pair16(pa, pb); } }
    } else {
        const int h = w - 4; const bf16* wt = (const bf16*)(ws + WS_WUKV) + (size_t)l * 512 * 256 + (size_t)(h * 128) * 256;
        f32x16 acc[4][2];
#pragma unroll
        for (int a = 0; a < 4; ++a)
#pragma unroll
            for (int b = 0; b < 2; ++b)
#pragma unroll
                for (int i = 0; i < 16; ++i) acc[a][b][i] = 0.f;
        bf16x8 wf[4][4];
        const bf16* wl = wt + (size_t)lane * 8;
#define MLK_ISSUE(st, ks) { _Pragma("unroll") for (int nb = 0; nb < 4; ++nb) asm volatile("global_load_dwordx4 %0, %1, off" : "=v"(wf[st][nb]) : "v"(wl + (size_t)((ks) * 4 + nb) * 512) : "memory"); }
        asm volatile("s_waitcnt vmcnt(0)" ::: "memory");
        if (!(pv & 2u)) {
        MLK_ISSUE(0, 0); MLK_ISSUE(1, 1); MLK_ISSUE(2, 2);
#pragma unroll
        for (int ks = 0; ks < 16; ++ks) {
            if (ks + 3 < 16) { MLK_ISSUE((ks + 3) % 4, ks + 3); asm volatile("s_waitcnt vmcnt(12)" ::: "memory"); }
            else if (ks + 2 < 16) asm volatile("s_waitcnt vmcnt(8)" ::: "memory"); else if (ks + 1 < 16) asm volatile("s_waitcnt vmcnt(4)" ::: "memory"); else asm volatile("s_waitcnt vmcnt(0)" ::: "memory");
#pragma unroll
            for (int k = 0; k < 4; ++k) asm volatile("" : "+v"(wf[ks % 4][k]));
            bf16x8 bfr[2];
#pragma unroll
            for (int tb = 0; tb < 2; ++tb) bfr[tb] = *(const LAS bf16x8*)(lds + L_CKV + ((32 * tb + r32) * LKV + 16 * ks + 8 * hi) * 2);
#pragma unroll
            for (int nb = 0; nb < 4; ++nb)
#pragma unroll
                for (int tb = 0; tb < 2; ++tb) acc[nb][tb] = __builtin_amdgcn_mfma_f32_32x32x16_bf16(wf[ks % 4][nb], bfr[tb], acc[nb][tb], 0, 0, 0);
        }
        }
#undef MLK_ISSUE
        bf16* KN = (bf16*)(ws + WS_KN); bf16* VC = (bf16*)(ws + WS_VC);
        if (!(pv & 1u))
#pragma unroll
        for (int tb = 0; tb < 2; ++tb) { const int row = row0 + 32 * tb + r32, t = row % SEQ; const float* sp = ssl + (size_t)row * 16;
            const float slat = rsqrtf(((sp[6] + sp[7]) + (sp[8] + sp[9])) * (1.0f / 256.0f) + EPS);
            float kr[16]; float ss = 0.f;
#pragma unroll
            for (int g4 = 0; g4 < 4; ++g4) { const v2u v = *(const v2u*)(xs + (size_t)row * 128 + 32 + 8 * g4 + 4 * hi); kr[4 * g4] = __uint_as_float(v.x << 16); kr[4 * g4 + 1] = __uint_as_float(v.x & 0xffff0000u); kr[4 * g4 + 2] = __uint_as_float(v.y << 16); kr[4 * g4 + 3] = __uint_as_float(v.y & 0xffff0000u); }
#pragma unroll
            for (int i = 0; i < 16; ++i) ss += kr[i] * kr[i];
#pragma unroll
            for (int nb = 0; nb < 2; ++nb)
#pragma unroll
                for (int i = 0; i < 16; ++i) { const float v = acc[nb][tb][i] * slat; acc[nb][tb][i] = v; ss += v * v; }
            ss = xsum32(ss); const float hs = rsqrtf(ss * (1.0f / 96.0f) + EPS);
#pragma unroll
            for (int nb = 0; nb < 2; ++nb)
#pragma unroll
                for (int i = 0; i < 16; ++i) acc[nb][tb][i] *= hs * qk_c[96 + 32 * nb + att::crow(i, hi)];
#pragma unroll
            for (int i = 0; i < 16; ++i) kr[i] *= hs * qk_c[96 + 64 + att::crow(i, hi)];
#pragma unroll
            for (int i = 0; i < 8; ++i) { const int j = att::crow(i, hi); const float c = rope[t * 16 + j], s = rope[SEQ * 16 + t * 16 + j]; const float x1 = kr[i], x2 = kr[i + 8]; kr[i] = x1 * c - x2 * s; kr[i + 8] = x1 * s + x2 * c; }
#pragma unroll
            for (int k2 = 0; k2 < 2; ++k2) {
#pragma unroll
                for (int nb = 0; nb < 2; ++nb) { v2u pa, pb; pa.x = pk2(acc[nb][tb][8 * k2], acc[nb][tb][8 * k2 + 1]); pa.y = pk2(acc[nb][tb][8 * k2 + 2], acc[nb][tb][8 * k2 + 3]); pb.x = pk2(acc[nb][tb][8 * k2 + 4], acc[nb][tb][8 * k2 + 5]); pb.y = pk2(acc[nb][tb][8 * k2 + 6], acc[nb][tb][8 * k2 + 7]);
                    *(v4u*)(KN + (size_t)row * 384 + h * 96 + 32 * nb + 16 * k2 + 8 * hi) = pair16(pa, pb); }
                { v2u pa, pb; pa.x = pk2(kr[8 * k2], kr[8 * k2 + 1]); pa.y = pk2(kr[8 * k2 + 2], kr[8 * k2 + 3]); pb.x = pk2(kr[8 * k2 + 4], kr[8 * k2 + 5]); pb.y = pk2(kr[8 * k2 + 6], kr[8 * k2 + 7]);
                    *(v4u*)(KN + (size_t)row * 384 + h * 96 + 64 + 16 * k2 + 8 * hi) = pair16(pa, pb); }
#pragma unroll
                for (int nb = 2; nb < 4; ++nb) { v2u pa, pb; pa.x = pk2(acc[nb][tb][8 * k2] * slat, acc[nb][tb][8 * k2 + 1] * slat); pa.y = pk2(acc[nb][tb][8 * k2 + 2] * slat, acc[nb][tb][8 * k2 + 3] * slat); pb.x = pk2(acc[nb][tb][8 * k2 + 4] * slat, acc[nb][tb][8 * k2 + 5] * slat); pb.y = pk2(acc[nb][tb][8 * k2 + 6] * slat, acc[nb][tb][8 * k2 + 7] * slat);
                    *(v4u*)(VC + (size_t)row * 256 + h * 64 + 32 * (nb - 2) + 16 * k2 + 8 * hi) = pair16(pa, pb); } } }
    }
    __syncthreads();
}

__device__ __forceinline__ void sel_unit(unsigned char* ws, LAS unsigned char* lds, int unit, const int npass = 4, const bool ties = true, const bool force_simple = false) {
    int tid_ = threadIdx.x; asm volatile("" : "+v"(tid_));
    const int tid = tid_, lane = tid & 63, c16 = lane & 15, g = lane >> 4, w = __builtin_amdgcn_readfirstlane(tid >> 6);
    const int b = unit & 7, qblk = 63 - (unit >> 3), t0 = 32 * qblk + 4 * w, brow = b * SEQ;
    const bf16* t1 = (const bf16*)(ws + WS_R) + (size_t)1 * MH * 256; const bf16* xs = (const bf16*)(ws + WS_XS) + (size_t)brow * 128; const float* iwf = (const float*)(ws + WS_IWF);
    const int tq = t0 + g;
    const int nkt = (t0 + 3) / 16 + 1;
    const bf16x8 af = *(const bf16x8*)(t1 + (size_t)(brow + t0 + (c16 >> 2)) * 256 + 128 + (c16 & 3) * 32 + 8 * g);
    const f32x4 wv = *(const f32x4*)(iwf + (size_t)(brow + tq) * 4);
    constexpr float WS_ = 0.5f * 0.17677669529663687f;
    const float w0 = wv[0] * WS_, w1 = wv[1] * WS_, w2 = wv[2] * WS_, w3 = wv[3] * WS_;
    unsigned key[128];
    const int nblk = (nkt + 15) >> 4;
    const bf16* xsl = xs + (size_t)c16 * 128 + 8 * g;
#pragma unroll
    for (int blk = 0; blk < 8; ++blk) {
        if (blk < nblk) {
            bf16x8 bc[16];
#pragma unroll
            for (int rr = 0; rr < 16; ++rr) bc[rr] = *(const bf16x8*)(xsl + (size_t)(16 * (16 * blk + rr)) * 128);
            __builtin_amdgcn_sched_barrier(0);
#pragma unroll
            for (int rr = 0; rr < 16; ++rr) { const int r = 16 * blk + rr;
                pg8::f32x4 cz = {0.f, 0.f, 0.f, 0.f}; const pg8::f32x4 d = __builtin_amdgcn_mfma_f32_16x16x32_bf16(af, bc[rr], cz, 0, 0, 0);
                const float sc = __builtin_fmaf(fmaxf(d[3], 0.f), w3, __builtin_fmaf(fmaxf(d[2], 0.f), w2, __builtin_fmaf(fmaxf(d[1], 0.f), w1, fmaxf(d[0], 0.f) * w0)));
                key[r] = (16 * r + c16 <= tq) ? fkeyu(sc) : 0u; }
            __builtin_amdgcn_sched_barrier(0);
        } else {
#pragma unroll
            for (int rr = 0; rr < 16; ++rr) key[16 * blk + rr] = 0u;
        }
    }
    LAS unsigned* H = (LAS unsigned*)(lds + w * 4608) + g * 272;
    unsigned prefix = 0u; int rank = 256;
#pragma unroll 1
    for (int pass = 0; pass < npass; ++pass) { const int shift = 24 - 8 * pass;
#pragma unroll
        for (int j = 0; j < 4; ++j) *(LAS v4u*)(H + 16 * c16 + 4 * j) = (v4u){0u, 0u, 0u, 0u};
        H[256 + c16] = 0u;
        const unsigned hp = pass == 0 ? 0u : (prefix >> ((shift + 8) & 31)); const unsigned hmask = pass == 0 ? 0u : 0xffffffffu;
#pragma unroll
        for (int blk = 0; blk < 8; ++blk) if (blk < nblk) {
#pragma unroll
            for (int rr = 0; rr < 16; ++rr) { const unsigned k = key[16 * blk + rr]; const bool mt = (((k >> ((shift + 8) & 31)) & hmask) == hp); const unsigned bin = mt ? ((k >> shift) & 255u) : (unsigned)(256 + c16);
                (void)__hip_atomic_fetch_add(H + bin, 1u, __ATOMIC_RELAXED, __HIP_MEMORY_SCOPE_WORKGROUP); } }
        unsigned hv[16];
#pragma unroll
        for (int j = 0; j < 4; ++j) { const v4u t = *(const LAS v4u*)(H + 16 * c16 + 4 * j); hv[4 * j] = t[0]; hv[4 * j + 1] = t[1]; hv[4 * j + 2] = t[2]; hv[4 * j + 3] = t[3]; }
        int sc = 0;
#pragma unroll
        for (int j = 0; j < 16; ++j) sc += (int)hv[j];
        int suf = sc;
#pragma unroll
        for (int d = 1; d < 16; d <<= 1) { const int o = bperm_i(lane + d, suf); if (c16 + d < 16) suf += o; }
        const int above_lane = suf - sc;
        const bool cross = (above_lane < rank) && (rank <= suf);
        int B = 0, above = 0;
        if (cross) { int run2 = above_lane; bool found = false;
#pragma unroll
            for (int j = 15; j >= 0; --j) { if (!found) { if (run2 + (int)hv[j] >= rank) { B = 16 * c16 + j; above = run2; found = true; } else run2 += (int)hv[j]; } } }
        const unsigned m16 = (unsigned)(__ballot(cross) >> (16 * g)) & 0xffffu;
        const int src = m16 ? (__ffs(m16) - 1) : 0;
        B = bperm_i((lane & 48) + src, B); above = bperm_i((lane & 48) + src, above);
        if (!m16) { B = 0; above = 0; }
        prefix |= (unsigned)B << shift; rank -= above;
    }
    const unsigned T = prefix; const int need = rank;
    unsigned long long mw0 = 0ull, mw1 = 0ull;
    const int cnt_eq = npass > 0 ? (int)H[T & 255u] : 0;
    const bool simple = (__all(cnt_eq == need && T != 0u) && ties) || force_simple;
    if (simple) {
#pragma unroll
        for (int blk = 0; blk < 8; ++blk) if (blk < nblk) {
#pragma unroll
            for (int rr = 0; rr < 16; ++rr) { const int r = 16 * blk + rr; const unsigned long long bs = __ballot(key[r] >= T);
                if (r < 64) mw0 = (lane == r) ? bs : mw0; else mw1 = (lane == r - 64) ? bs : mw1; } }
    } else {
        int run = 0;
#pragma unroll
        for (int blk = 0; blk < 8; ++blk) if (blk < nblk) {
#pragma unroll
            for (int rr = 0; rr < 16; ++rr) { const int r = 16 * blk + rr;
                const bool eq = key[r] == T; const unsigned long long bal = __ballot(eq); const unsigned m16 = (unsigned)(bal >> (16 * g)) & 0xffffu;
                const int rk = run + __popc(m16 & ((1u << c16) - 1u)); run += __popc(m16);
                const unsigned long long bs = __ballot((key[r] > T || (eq && rk < need)) && (16 * r + c16 <= tq));
                if (r < 64) mw0 = (lane == r) ? bs : mw0; else mw1 = (lane == r - 64) ? bs : mw1; } }
    }
    unsigned long long* mq = (unsigned long long*)(ws + WS_MASK) + (size_t)((brow + t0) >> 2) * 128;
    mq[lane] = mw0; mq[64 + lane] = mw1;
}
__device__ __forceinline__ void km_unit(unsigned char* ws, LAS unsigned char* lds, int unit) {
    int tid_ = threadIdx.x; asm volatile("" : "+v"(tid_)); const int tid = tid_, lane = tid & 63, w = tid >> 6; const int b = unit >> 3, n = unit & 7;
    const bf16* bk = (const bf16*)(ws + WS_R) + (size_t)6 * MH * 256 + (size_t)(b * SEQ + n * 256 + 32 * w) * 256 + 4 * lane;
    v2u v[32];
#pragma unroll
    for (int i = 0; i < 32; ++i) v[i] = *(const v2u*)(bk + (size_t)i * 256);
    float s0 = 0.f, s1 = 0.f, s2 = 0.f, s3 = 0.f;
#pragma unroll
    for (int i = 0; i < 32; ++i) { s0 += __uint_as_float(v[i].x << 16); s1 += __uint_as_float(v[i].x & 0xffff0000u); s2 += __uint_as_float(v[i].y << 16); s3 += __uint_as_float(v[i].y & 0xffff0000u); }
    LAS f32x4* red = (LAS f32x4*)lds; red[w * 64 + lane] = (f32x4){s0, s1, s2, s3};
    __syncthreads();
    if (w == 0) { f32x4 t = red[lane];
#pragma unroll
        for (int k = 1; k < 8; ++k) t += red[k * 64 + lane];
        *(f32x4*)((float*)(ws + WS_KMEAN) + (size_t)unit * 256 + 4 * lane) = t * (1.0f / 256.0f); }
    __syncthreads();
}
struct OneUnit { int pm, pn;
    __device__ __forceinline__ bool next(int i, pg8::Unit& u) const { if (i > 0) return false; u.pm = pm; u.pn = pn; u.ao = 0; u.bo = 0; return true; }
    __device__ __forceinline__ void a_ready(const pg8::Unit&) const {}
    __device__ __forceinline__ void done(const pg8::Unit&) const {} };
__device__ __forceinline__ void phase(unsigned char* ws, LAS unsigned char* lds, int l, const float* qk_c, unsigned* queue, const pg8::Gemm& gg, const EpiInProj& ge, const unsigned kmask = 15u) {
    for (;;) {
        if (threadIdx.x == 0) ((volatile LAS unsigned*)(lds + L_MISC))[0] = __hip_atomic_fetch_add(queue, 1u, __ATOMIC_RELAXED, __HIP_MEMORY_SCOPE_AGENT);
        __syncthreads();
        const int idx = (int)((volatile LAS unsigned*)(lds + L_MISC))[0];
        __syncthreads();
        if (idx >= NU_TOTAL) break;
        if (idx < NU_GEMM) { if (kmask & 8u) { OneUnit S1{idx, NT_IN - 1}; pg8::gemm_phase<EpiInProj, OneUnit, true, true>(lds, gg, S1, ge); __syncthreads(); } }
        else if (idx < NU_GEMM + NU_KM) { if (kmask & 1u) km_unit(ws, lds, idx - NU_GEMM); }
        else if (idx < NU_GEMM + NU_KM + NU_SEL / 2) { if (kmask & 2u) sel_unit(ws, lds, idx - NU_GEMM - NU_KM, (kmask & 16u) ? 0 : 4, !(kmask & 32u), (kmask & 64u) != 0u); }
        else if (idx < NU_GEMM + NU_KM + NU_SEL / 2 + NU_MLA) { if (kmask & 4u) mla_unit(ws, lds, l, idx - NU_GEMM - NU_KM - NU_SEL / 2, qk_c, kmask >> 7); }
        else { if (kmask & 2u) sel_unit(ws, lds, idx - NU_GEMM - NU_KM - NU_MLA, (kmask & 16u) ? 0 : 4, !(kmask & 32u), (kmask & 64u) != 0u); }
    }
}
}
constexpr int RING_BYTES = 131072, MISC_OFF = RING_BYTES + 320, LDS_BYTES = 147456;
#define LDS_WAIT() asm volatile("s_waitcnt lgkmcnt(0)" ::: "memory")
#define VM_WAIT() asm volatile("s_waitcnt vmcnt(0)" ::: "memory")

template <class CM> __device__ __forceinline__ void tr_item(const float* W, int ldw, int K, const float* rowgain, bf16* WT, int nblk, int item, LAS float* scr, int lane, CM cm) {
    const int kb = item / nblk, nb = item % nblk, k0 = 64 * kb, n0 = 32 * nb;
    const int sc = cm(n0 + (lane & 31));
    float tv[32];
#pragma unroll
    for (int i = 0; i < 32; ++i) { const int kk = 2 * i + (lane >> 5); tv[i] = sc >= 0 ? W[(size_t)(k0 + kk) * ldw + sc] : 0.f; }
#pragma unroll
    for (int i = 0; i < 32; ++i) { const int kk = 2 * i + (lane >> 5); float v = tv[i]; if (rowgain) v *= rowgain[k0 + kk]; scr[kk * 33 + (lane & 31)] = v; }
    LDS_WAIT(); asm volatile("" ::: "memory");
    const int c = lane & 7;
#pragma unroll
    for (int j = 0; j < 4; ++j) { const int n = (lane >> 3) + 8 * j; const LAS float* s = scr + (8 * c) * 33 + n;
        v4u o; o.x = pk2(s[0 * 33], s[1 * 33]); o.y = pk2(s[2 * 33], s[3 * 33]); o.z = pk2(s[4 * 33], s[5 * 33]); o.w = pk2(s[6 * 33], s[7 * 33]);
        *(v4u*)(WT + (size_t)(n0 + n) * K + k0 + 8 * c) = o; }
    LDS_WAIT(); asm volatile("" ::: "memory");
}
struct CmId { __device__ __forceinline__ int operator()(int n) const { return n; } };
struct CmFfnIn { __device__ __forceinline__ int operator()(int n) const { const int pn = n >> 8, c = n & 255; return c < 128 ? pn * 128 + c : DFF + pn * 128 + (c - 128); } };
struct CmInProj { __device__ __forceinline__ int operator()(int n) const { return inproj_srccol(n); } };
__device__ __forceinline__ int rel_bucket_dev(int n) { if (n < 16) return n; const int lb = 16 + (int)(logf((float)n / 16.f) / logf(128.f) * 16.f); return lb < 31 ? lb : 31; }

__device__ __forceinline__ void prologue(const Args& a, LAS unsigned char* lds, int vcu, int G, int wave, int lane) {
    unsigned char* ws = a.ws;
    LAS float* scr = (LAS float*)(lds + wave * 16384);
    const int gw = vcu * NWAVES + wave, NGW = G * NWAVES;
    const float* norm_gain = a.in[1]; const float* w_in = a.in[2]; const float* mla_nq = a.in[8]; const float* w_uq = a.in[9]; const float* mla_nkv = a.in[10]; const float* w_ukv = a.in[11];
    const float* w_branch = a.in[12]; const float* w_out = a.in[13]; const float* rel_bias = a.in[14]; const float* w_ffn_in = a.in[15]; const float* w_ffn_out = a.in[16];
    constexpr int I_FI = 16 * (5632 / 32), I_FO = 44 * 32, I_IN = 16 * (N_INP / 32), I_O = 16 * 32, I_B = 4 * 32, I_UQ = 6 * 12, I_UKV = 4 * 16;
    constexpr int NITEMS = 4 * I_FI + 4 * I_FO + 2 * I_IN + 2 * I_O + 8 * I_B; (void)I_UQ; (void)I_UKV;
    for (int it = gw; it < NITEMS; it += NGW) {
        int r = it;
        if (r < 4 * I_FI) { const int w = r / I_FI, l = w >> 1, f = w & 1; tr_item(w_ffn_in + (size_t)w * DM * 2 * DFF, 2 * DFF, DM, norm_gain + (l * 3 + (f ? 2 : 0)) * DM, (bf16*)(ws + WS_WFI) + (size_t)w * 5632 * DM, 5632 / 32, r % I_FI, scr, lane, CmFfnIn()); continue; } r -= 4 * I_FI;
        if (r < 4 * I_FO) { const int w = r / I_FO; tr_item(w_ffn_out + (size_t)w * DFF * DM, DM, DFF, nullptr, (bf16*)(ws + WS_WFO) + (size_t)w * DM * DFF, 32, r % I_FO, scr, lane, CmId()); continue; } r -= 4 * I_FO;
        if (r < 2 * I_IN) { const int l = r / I_IN; tr_item(w_in + (size_t)l * DM * INW, INW, DM, norm_gain + (l * 3 + 1) * DM, (bf16*)(ws + WS_WIN) + (size_t)l * N_INP * DM, N_INP / 32, r % I_IN, scr, lane, CmInProj()); continue; } r -= 2 * I_IN;
        if (r < 2 * I_O) { const int l = r / I_O; tr_item(w_out + (size_t)l * DM * DM, DM, DM, nullptr, (bf16*)(ws + WS_WO) + (size_t)l * DM * DM, 32, r % I_O, scr, lane, CmId()); continue; } r -= 2 * I_O;
        if (r < 8 * I_B) { const int w = r / I_B; tr_item(w_branch + (size_t)w * 256 * DM, DM, 256, nullptr, (bf16*)(ws + WS_WB) + (size_t)w * DM * 256, 32, r % I_B, scr, lane, CmId()); continue; } r -= 8 * I_B;
    }
    const float* x = a.in[0]; bf16* xb = (bf16*)(ws + WS_XB); float* ssq = (float*)(ws + WS_SSQ);
    for (int m0 = gw; m0 < M; m0 += 2 * NGW) {
        f32x4 v[2][4]; float sacc[2] = {0.f, 0.f};
#pragma unroll
        for (int r = 0; r < 2; ++r) { const int m = m0 + r * NGW; if (m < M) { const f32x4* xr = (const f32x4*)(x + (size_t)m * DM) + lane;
#pragma unroll
                for (int j = 0; j < 4; ++j) v[r][j] = xr[64 * j]; } }
#pragma unroll
        for (int r = 0; r < 2; ++r) { const int m = m0 + r * NGW; if (m < M) { unsigned long long* o8 = (unsigned long long*)(xb + (size_t)m * DM) + lane;
#pragma unroll
                for (int j = 0; j < 4; ++j) { const f32x4 t = v[r][j]; o8[64 * j] = (unsigned long long)pk2(t[0], t[1]) | ((unsigned long long)pk2(t[2], t[3]) << 32);
                    sacc[r] += (t[0] * t[0] + t[1] * t[1]) + (t[2] * t[2] + t[3] * t[3]); } } }
#pragma unroll
        for (int r = 0; r < 2; ++r) { const int m = m0 + r * NGW; float s = sacc[r];
            s += bperm_f(lane ^ 1, s); s += bperm_f(lane ^ 2, s); s += bperm_f(lane ^ 4, s); s += bperm_f(lane ^ 8, s); s += bperm_f(lane ^ 16, s); s = xsum32(s);
            if (m < M && lane < 16) ssq[(size_t)m * 16 + lane] = lane == 0 ? s : 0.f; }
    }
    const int gt = gw * 64 + lane, NGT = NGW * 64;
    for (int i = gt; i < 2 * 4 * 24 * 3 * 64; i += NGT) { const int ln = i & 63, nb = (i >> 6) % 3, s = ((i >> 6) / 3) % 24, h = ((i >> 6) / 72) & 3, l = (i >> 6) / 288; const int n = 96 * h + 32 * nb + (ln & 31), k0 = 16 * s + 8 * (ln >> 5);
        float v[8];
#pragma unroll
        for (int j = 0; j < 8; ++j) v[j] = w_uq[(size_t)l * 384 * 384 + (size_t)(k0 + j) * 384 + n] * mla_nq[l * 384 + k0 + j];
        v4u o; o.x = pk2(v[0], v[1]); o.y = pk2(v[2], v[3]); o.z = pk2(v[4], v[5]); o.w = pk2(v[6], v[7]); *(v4u*)(ws + WS_WUQ + (size_t)i * 16) = o; }
    for (int i = gt; i < 2 * 4 * 16 * 4 * 64; i += NGT) { const int ln = i & 63, nb = (i >> 6) & 3, s = (i >> 8) & 15, h = (i >> 12) & 3, l = i >> 14; const int n = 128 * h + 32 * nb + (ln & 31), k0 = 16 * s + 8 * (ln >> 5);
        float v[8];
#pragma unroll
        for (int j = 0; j < 8; ++j) v[j] = w_ukv[(size_t)l * 256 * 512 + (size_t)(k0 + j) * 512 + n] * mla_nkv[l * 256 + k0 + j];
        v4u o; o.x = pk2(v[0], v[1]); o.y = pk2(v[2], v[3]); o.z = pk2(v[4], v[5]); o.w = pk2(v[6], v[7]); *(v4u*)(ws + WS_WUKV + (size_t)i * 16) = o; }
    float* bias = (float*)(ws + WS_BIAS); float* biasd = (float*)(ws + WS_BIASD); float* rope = (float*)(ws + WS_ROPE);
    for (int i = gt; i < 20 * 2112; i += NGT) { const int h = i / 2112, d = i % 2112 - 64; bias[i] = d >= 0 ? rel_bias[h * 32 + rel_bucket_dev(d)] * LOG2E : 0.f; }
    for (int i = gt; i < 12 * 192; i += NGT) { const int gh = i / 192, sd = i % 192, g = gh >> 2, dil = g == 0 ? 1 : g == 1 ? 4 : 16; const int d = sd * dil; biasd[i] = (sd <= 128) ? rel_bias[(8 + gh) * 32 + rel_bucket_dev(d)] * LOG2E : 0.f; }
    { unsigned char* bid = ws + WS_BID; for (int i = gt; i < 2112; i += NGT) { const int d = i - 64; bid[i] = (unsigned char)(d >= 0 ? rel_bucket_dev(d) : 0); } }
    for (int i = gt; i < SEQ * 16; i += NGT) { const int t = i >> 4, j = i & 15; const float fr = powf(10000.f, -(float)j / 16.f), ang = (float)t * fr; rope[i] = cosf(ang); rope[SEQ * 16 + i] = sinf(ang); }
}

typedef __attribute__((address_space(4))) const Args KArgs;
__global__ void __launch_bounds__(NTHR, 2) mega(Args args) {
    extern __shared__ __attribute__((aligned(16))) unsigned char lds_raw[];
    LAS unsigned char* lds0 = (LAS unsigned char*)lds_raw; LAS unsigned char* lds = lds0;
    volatile LAS unsigned* MISC = (volatile LAS unsigned*)(lds + MISC_OFF);
    const int tid = threadIdx.x, lane = tid & 63, wave = __builtin_amdgcn_readfirstlane(tid >> 6);
    const int G = gridDim.x; const int bx = blockIdx.x; const int vcu = (G % 8 == 0) ? (bx % 8) * (G / 8) + bx / 8 : bx;
    unsigned char* const ws0 = args.ws; unsigned char* ws = ws0; unsigned* ctl = (unsigned*)(ws + WS_CTL);
    for (int u = tid; u < (LDS_BYTES - RING_BYTES) / 4; u += NTHR) ((LAS unsigned*)(lds + RING_BYTES))[u] = 0u;
    __syncthreads();
    XcdBarrier bar = xcd_barrier_post(ctl + CW_BAR, MISC + 8);
    const int lo = args.ph_lo, hi = args.ph_hi;
#ifdef PROBE_T
    if (threadIdx.x == 0) { volatile LAS unsigned long long* pt_ = (volatile LAS unsigned long long*)(lds0 + 131072 + 2048); pt_[0] = 0ull; pt_[1] = __builtin_amdgcn_s_memrealtime(); }
#endif
#define IN(k) (lo <= (k) && (k) < hi)
#define PHASE_LOCALS LAS unsigned char* lds = lds0; const KArgs* ap = (const KArgs*)__builtin_amdgcn_kernarg_segment_ptr(); asm volatile("" : "+s"(lds), "+s"(ap)); unsigned char* ws = ap->ws;
#ifdef PROBE_BAR
#define SEAM(k) do { if (IN(k) && IN((k) + 1)) { xcd_barrier(bar); xcd_barrier(bar); } } while (0)
#else
#ifdef PROBE_T
#define PTICK(k) do { if (threadIdx.x == 0) { volatile LAS unsigned long long* pt_ = (volatile LAS unsigned long long*)(lds0 + 131072 + 2048); const unsigned long long n_ = __builtin_amdgcn_s_memrealtime(); \
        int c_ = 8; if ((k) == PH_PRO) c_ = 0; else { int r_ = ((k) - PH_L0) % PH_PER_LAYER; if (r_ == 0 || r_ == 14) c_ = 1; else if (r_ == 1 || r_ == 15) c_ = 2; else { r_ = (r_ - 2) % 6; c_ = r_ == 0 ? 3 : r_ == 1 ? 4 : r_ == 2 ? 5 : r_ == 4 ? 6 : r_ == 5 ? 7 : 8; } } \
        if (c_ == PROBE_T || PROBE_T == 99) pt_[0] += n_ - pt_[1]; pt_[1] = n_; } } while (0)
#else
#define PTICK(k) do {} while (0)
#endif
#define SEAM(k) do { if (IN(k) && IN((k) + 1)) xcd_barrier(bar); PTICK(k); } while (0)
#endif
    #ifndef NOPRO
    if (IN(PH_PRO)) { PHASE_LOCALS; (void)ws; (void)ap; prologue(args, lds, vcu, G, wave, lane); }
#ifdef PROBE_PRO2
    if (IN(PH_PRO)) { xcd_barrier(bar); PHASE_LOCALS; (void)ws; prologue(args, lds, vcu, G, wave, lane); xcd_barrier(bar); prologue(args, lds, vcu, G, wave, lane); xcd_barrier(bar); prologue(args, lds, vcu, G, wave, lane); }
#endif
#endif
    SEAM(PH_PRO);
    for (int l = 0; l < DEPTH; ++l) {
        const int pb = PH_L0 + l * PH_PER_LAYER;
#pragma unroll 1
        for (int f = 0; f < 2; ++f) {
            if (f == 1) {
#pragma unroll 1
                for (int hf = 0; hf < 2; ++hf) {
                    const int ph = pb + PO_INP + 6 * hf;
#ifndef NOINP
                    if (IN(ph)) {
                        PHASE_LOCALS; bf16* const xb = (bf16*)(ws + WS_XB); float* const ssq = (float*)(ws + WS_SSQ);
                        pg8::Gemm g{xb + (size_t)hf * MH * DM, (const bf16*)(ws + WS_WIN) + (size_t)l * N_INP * DM, MH, N_INP - 256, DM}; pg8::StaticOrder S; S.init(MH, N_INP - 256, G, bx, WGM_INP);
                        EpiInProj E{ssq + (size_t)hf * MH * 16, ws, ap->in[4] + l * 128, ap->in[5] + l * 128, ap->in[7] + l * 128, ap->in[3] + (size_t)l * 4 * DM};
#ifdef SKEW_TICKS
                        { const unsigned long long t0_ = __builtin_amdgcn_s_memrealtime(), d_ = (unsigned long long)((bx & 7) * SKEW_TICKS); while (__builtin_amdgcn_s_memrealtime() - t0_ < d_) __builtin_amdgcn_s_sleep(1); }
#endif
                        pg8::gemm_phase<EpiInProj, pg8::StaticOrder, true, true>(lds, g, S, E);
#ifdef PROBE_INP2
                        xcd_barrier(bar); pg8::gemm_phase<EpiInProj, pg8::StaticOrder, true, true>(lds, g, S, E);
#endif
                    }
#endif
                    SEAM(ph);
#ifndef NOPREP
                    if (IN(ph + 1)) { PHASE_LOCALS; bf16* const xb = (bf16*)(ws + WS_XB); float* const ssq = (float*)(ws + WS_SSQ); int kq = DM; asm volatile("" : "+s"(kq));
                        pg8::Gemm gg{xb + (size_t)hf * MH * DM, (const bf16*)(ws + WS_WIN) + (size_t)l * N_INP * DM, MH, N_INP, kq};
                        EpiInProj ge{ssq + (size_t)hf * MH * 16, ws, ap->in[4] + l * 128, ap->in[5] + l * 128, ap->in[7] + l * 128, ap->in[3] + (size_t)l * 4 * DM};
#ifdef PROBE_PREP3
                        { unsigned pk_ = PROBE_PREP3; asm volatile("" : "+s"(pk_)); prep::phase(ws, lds, l, ap->in[6] + l * 192, (unsigned*)(ws + WS_CTL) + CW_QUEUE + 64 * (16 + l * 2 + hf), gg, ge, pk_); xcd_barrier(bar); }
#endif
                        prep::phase(ws, lds, l, ap->in[6] + l * 192, (unsigned*)(ws + WS_CTL) + CW_QUEUE + 64 * (8 + l * 2 + hf), gg, ge);
                    }
#ifdef PROBE_PREP2_OLD
                    if (IN(ph + 1)) { xcd_barrier(bar); PHASE_LOCALS; prep::phase(ws, lds, l, ap->in[6] + l * 192, (unsigned*)(ws + WS_CTL) + CW_QUEUE + 64 * (16 + l * 2 + hf), gg, ge, PROBE_PREP2); }
#endif
#endif
                    SEAM(ph + 1);
#ifdef PROBE_ATT2
                    if (IN(ph + 2)) { PHASE_LOCALS; att::phase(ws, lds, (unsigned*)(ws + WS_CTL) + CW_QUEUE + 64 * (24 + l * 2 + hf), true, PROBE_ATT2); xcd_barrier(bar); }
#endif
                    if (IN(ph + 2)) { PHASE_LOCALS; att::phase(ws, lds, (unsigned*)(ws + WS_CTL) + CW_QUEUE + 64 * (l * 2 + hf)); }
                    SEAM(ph + 2);
                    if (IN(ph + 4)) {
                        PHASE_LOCALS;
                        int kq = 256; asm volatile("" : "+s"(kq));
                        pg8::Gemm g{(const bf16*)(ws + WS_R), (const bf16*)(ws + WS_WB) + (size_t)l * 4 * DM * 256, MH, DM, kq};
                        MergeOrder S; S.S.init(MH, DM, G, bx); S.a1 = (int)(5 * TILE_B); S.a2 = (int)(WS_OC - WS_R); S.a3 = (int)(WS_DC - WS_R);
                        unsigned* cnt = (unsigned*)(ws + WS_CTL) + CW_SEAM + (l * 2 + hf) * 64 * 64; S.ready = cnt; S.tmo = (unsigned*)(ws + WS_CTL) + 2;
                        {
                            const bf16* tiles = (const bf16*)(ws + WS_R); const float* lse = (const float*)(ws + WS_LSED); bf16* dc = (bf16*)(ws + WS_DC);
                            int tid_ = threadIdx.x; asm volatile("" : "+v"(tid_)); const int ln = tid_ & 63, wv = tid_ >> 6, h = ln >> 4;
                            pg8::Unit tu;
                            for (int i = 0; S.S.next(i, tu); ++i) {
#pragma unroll 1
                                for (int half = 0; half < 2; ++half) { const int rbase = tu.pm * 256 + tu.pn * 64 + wv * 8 + half * 4;
                                    v2u va[4], vb[4], vc[4]; float la[4], lb[4], lc[4];
#pragma unroll
                                    for (int r = 0; r < 4; ++r) { const int row = rbase + r; const size_t o = (size_t)row * 256 + 4 * ln;
                                        la[r] = lse[(size_t)row * 16 + h]; lb[r] = lse[(size_t)row * 16 + 4 + h]; lc[r] = lse[(size_t)row * 16 + 8 + h];
                                        va[r] = *(const v2u*)(tiles + (size_t)8 * MH * 256 + o); vb[r] = *(const v2u*)(tiles + (size_t)9 * MH * 256 + o); vc[r] = *(const v2u*)(tiles + (size_t)10 * MH * 256 + o); }
#pragma unroll
                                    for (int r = 0; r < 4; ++r) { const int row = rbase + r;
                                        const float l0 = la[r], l1 = lb[r], l2 = lc[r], mx = fmaxf(l0, fmaxf(l1, l2));
                                        const float e0 = __builtin_amdgcn_exp2f(l0 - mx), e1 = __builtin_amdgcn_exp2f(l1 - mx), e2 = __builtin_amdgcn_exp2f(l2 - mx), inv = 1.0f / (e0 + e1 + e2);
                                        const v2u a = va[r], b = vb[r], c = vc[r];
                                        const unsigned lo = pk2((e0 * __uint_as_float(a.x << 16) + e1 * __uint_as_float(b.x << 16) + e2 * __uint_as_float(c.x << 16)) * inv, (e0 * __uint_as_float(a.x & 0xffff0000u) + e1 * __uint_as_float(b.x & 0xffff0000u) + e2 * __uint_as_float(c.x & 0xffff0000u)) * inv);
                                        const unsigned hi2 = pk2((e0 * __uint_as_float(a.y << 16) + e1 * __uint_as_float(b.y << 16) + e2 * __uint_as_float(c.y << 16)) * inv, (e0 * __uint_as_float(a.y & 0xffff0000u) + e1 * __uint_as_float(b.y & 0xffff0000u) + e2 * __uint_as_float(c.y & 0xffff0000u)) * inv);
                                        __hip_atomic_store((unsigned long long*)(dc + (size_t)row * 256 + 4 * ln), ((unsigned long long)hi2 << 32) | lo, __ATOMIC_RELAXED, __HIP_MEMORY_SCOPE_AGENT); } }
                                asm volatile("s_waitcnt vmcnt(0)" ::: "memory");
                                if (ln == 0) (void)__hip_atomic_fetch_add(cnt + 64 * tu.pm, 1u, __ATOMIC_RELAXED, __HIP_MEMORY_SCOPE_AGENT);
                            }
                        }
                        EpiMerge E{(const bf16*)(ws + WS_R) + (size_t)17 * MH * 256, (bf16*)(ws + WS_U)};
                        pg8::gemm_phase<EpiMerge, MergeOrder, true, true>(lds, g, S, E);
#ifdef PROBE_MRG4
                        { EpiMergeCheap Ec{(bf16*)(ws + WS_U)}; xcd_barrier(bar); pg8::gemm_phase<EpiMergeCheap, MergeOrder, true, true>(lds, g, S, Ec); xcd_barrier(bar); pg8::gemm_phase<EpiMerge, MergeOrder, true, true>(lds, g, S, E); }
#endif
#ifdef PROBE_MRG3
                        xcd_barrier(bar); pg8::gemm_phase<EpiMerge, MergeOrder, true, true>(lds, g, S, E);
#endif
                    }
                    SEAM(ph + 4);
#ifndef NORES
                    if (IN(ph + 5)) {
                        PHASE_LOCALS; bf16* const xb = (bf16*)(ws + WS_XB); float* const ssq = (float*)(ws + WS_SSQ);
                        pg8::Gemm g{(const bf16*)(ws + WS_U), (const bf16*)(ws + WS_WO) + (size_t)l * DM * DM, MH, DM, DM}; pg8::StaticOrder S; S.init(MH, DM, G, bx);
                        EpiResid E{nullptr, xb + (size_t)hf * MH * DM, ssq + (size_t)hf * MH * 16, 1.0f};
                        pg8::gemm_phase<EpiResid, pg8::StaticOrder, true, true>(lds, g, S, E);
                    }
#endif
                    SEAM(ph + 5);
                }
            }
            const int p1 = pb + (f ? PO_F2I : PO_F1I);
#ifdef PROBE_K
            if (IN(p1) && l == 1 && f == 1) {
                PHASE_LOCALS;
#if PROBE_K != 2
                pg8::Gemm g2{(const bf16*)(ws + WS_XB), (const bf16*)(ws + WS_WFI) + (size_t)(l * 2 + f) * 5632 * DM, M, 5632, DM};
#else
                pg8::Gemm g2{(const bf16*)(ws + WS_R), (const bf16*)(ws + WS_WFI), M, 5632, 2048};
#endif
                pg8::StaticOrder S; S.init(M, 5632, G, bx, WGM_FFI);
#if PROBE_K == 5
                EpiFfnIn Ef{(const float*)(ws + WS_SSQ), (bf16*)(ws + WS_R)};
#pragma unroll 1
                for (int rep = 0; rep < 3; ++rep) { pg8::gemm_phase<EpiFfnIn, pg8::StaticOrder, true, true>(lds, g2, S, Ef); xcd_barrier(bar); }
#elif PROBE_K >= 3
                EpiFfnInCheap Ec{(const float*)(ws + WS_SSQ), (bf16*)(ws + WS_R)}; pg8::gemm_phase<EpiFfnInCheap, pg8::StaticOrder, true, true>(lds, g2, S, Ec); xcd_barrier(bar);
#else
                EpiNull En{(float*)(ws + WS_CTL) + 8};
                pg8::gemm_phase<EpiNull, pg8::StaticOrder, true, true>(lds, g2, S, En); xcd_barrier(bar);
#endif
            }
#endif
#ifndef NOFFNI
            if (IN(p1)) {
                PHASE_LOCALS; bf16* const xb = (bf16*)(ws + WS_XB); float* const ssq = (float*)(ws + WS_SSQ); bf16* const h2 = (bf16*)(ws + WS_R);
                pg8::Gemm g{xb, (const bf16*)(ws + WS_WFI) + (size_t)(l * 2 + f) * 5632 * DM, M, 5632, DM}; pg8::StaticOrder S; S.init(M, 5632, G, bx, WGM_FFI);
                EpiFfnIn E{ssq, h2};
#ifdef PROBE_FFI3
                { EpiFfnInCheap Ec{ssq, h2}; pg8::gemm_phase<EpiFfnInCheap, pg8::StaticOrder, true, true>(lds, g, S, Ec); xcd_barrier(bar); }
#endif
                pg8::gemm_phase<EpiFfnIn, pg8::StaticOrder, true, true>(lds, g, S, E);
#ifdef PROBE_FFI2
                xcd_barrier(bar); pg8::gemm_phase<EpiFfnIn, pg8::StaticOrder, true, true>(lds, g, S, E);
#endif
            }
#endif
            SEAM(p1);
#ifndef NORES2
            if (IN(p1 + 1)) {
                PHASE_LOCALS; bf16* const xb = (bf16*)(ws + WS_XB); float* const ssq = (float*)(ws + WS_SSQ); bf16* const h2 = (bf16*)(ws + WS_R);
                float* const xout = (l == DEPTH - 1 && f == 1) ? ap->out : nullptr;
                pg8::Gemm g{h2, (const bf16*)(ws + WS_WFO) + (size_t)(l * 2 + f) * DM * DFF, M, DM, DFF}; pg8::StaticOrder S; S.init(M, DM, G, bx, WGM_FFO);
                EpiResid E{xout, xb, ssq, 0.5f};
                pg8::gemm_phase<EpiResid, pg8::StaticOrder, true, true>(lds, g, S, E);
            }
#endif
            SEAM(p1 + 1);
        }
    }
#ifdef PROBE_T
    if (blockIdx.x == 0 && threadIdx.x == 0) { volatile LAS unsigned long long* pt_ = (volatile LAS unsigned long long*)(lds0 + 131072 + 2048); const unsigned long long t0_ = __builtin_amdgcn_s_memrealtime(), w_ = 8ull * pt_[0];
        while (__builtin_amdgcn_s_memrealtime() - t0_ < w_) __builtin_amdgcn_s_sleep(8); }
#endif
#undef IN
#undef SEAM
}
static void launch_mega(const Args& a0, int lo, int hi, int grid, hipStream_t st) {
    Args a = a0; a.ph_lo = lo; a.ph_hi = hi;
    hipMemsetAsync(a.ws + WS_CTL, 0, CTL_BYTES, st);
    hipLaunchKernelGGL(mega, dim3(grid), dim3(NTHR), LDS_BYTES, st, a);
}
extern "C" void kernel_launch(void* const* d_in, const int* in_sizes, int n_in, void* d_out, int out_size, void* d_ws, size_t ws_size, hipStream_t stream) {
    static int grid = 0;
    if (grid == 0) {
        if (n_in != 17 || ws_size < WS_END) { fprintf(stderr, "kernel_launch: unexpected n_in %d / ws %zu\n", n_in, ws_size); grid = -1; return; }
        int dev = 0, cus = 0; hipGetDevice(&dev); hipDeviceGetAttribute(&cus, hipDeviceAttributeMultiprocessorCount, dev);
        if (hipFuncSetAttribute((const void*)mega, hipFuncAttributeMaxDynamicSharedMemorySize, LDS_BYTES) != hipSuccess) { fprintf(stderr, "hipFuncSetAttribute failed\n"); grid = -1; return; }
        int per_cu = 0; hipOccupancyMaxActiveBlocksPerMultiprocessor(&per_cu, (const void*)mega, NTHR, LDS_BYTES); (void)hipGetLastError();
        if (per_cu < 1) fprintf(stderr, "note: occupancy query says %d\n", per_cu);
        grid = cus;
    }
    if (grid < 0) return;
    Args a{}; for (int i = 0; i < 17; ++i) a.in[i] = (const float*)d_in[i]; a.out = (float*)d_out; a.ws = (unsigned char*)d_ws; a.ph_lo = 0; a.ph_hi = 0;
    int cur = 0;
    launch_mega(a, cur, N_PHASES, grid, stream);
}
```

```cpp
#include <hip/hip_runtime.h>
#include <cstdio>
#include <cstdint>
#include <cmath>
namespace pg8 {
#define PG8_LAS __attribute__((address_space(3)))
typedef unsigned short bf16_t;
typedef short bf16x8 __attribute__((ext_vector_type(8)));
typedef float f32x4 __attribute__((ext_vector_type(4)));
typedef unsigned u32x4 __attribute__((ext_vector_type(4)));
constexpr int BM = 256, BK = 64, HALF = 128, HTB = HALF * BK * 2  , STAGE_BYTES = 8 * HTB, NXCD = 8, WGM = 4;

__host__ __device__ __forceinline__ int lds_byte(int r, int c) { const int st = (r >> 4) * 2 + (c >> 5), rr = r & 15, cc = c & 31, ob = rr * 64 + cc * 2; return st * 1024 + (ob ^ (((ob >> 9) & 1) << 5)); }
__host__ __device__ __forceinline__ void stage_rc(int b, int& R, int& C) { const int st = b / 1024, sb = b % 1024, swz = sb ^ (((sb >> 9) & 1) << 5); R = (st >> 1) * 16 + swz / 64; C = (st & 1) * 32 + (swz % 64) / 2; }
__host__ __device__ __forceinline__ int perm32(int rho) { const int n = rho >> 4, i = rho & 15; return 8 * (i >> 2) + 4 * n + (i & 3); }

struct Unit { int pm, pn; int ao, bo; };
struct Gemm { const bf16_t* A; const bf16_t* Bt; int M, N, K; };

struct StaticOrder {
    int nM, nN, nwg, G, c, wgm;
    __host__ __device__ void init(int M, int N, int G_, int c_, int wgm_ = WGM) { nM = M / BM; nN = N / BM; nwg = nM * nN; G = G_; c = c_; wgm = wgm_; }
    __host__ __device__ __forceinline__ bool next(int i, Unit& u) const {
        const long L = (long)i * G + c; if (L >= nwg) return false;
        int wgid = (int)L; { const int q = nwg / NXCD, r = nwg % NXCD, xcd = wgid % NXCD, off = wgid / NXCD; wgid = (xcd < r ? xcd * (q + 1) : r * (q + 1) + (xcd - r) * q) + off; }
        const int nig = wgm * nN, gid = wgid / nig, fm = gid * wgm, gsz = (nM - fm) < wgm ? (nM - fm) : wgm;
        u.pm = fm + ((wgid % nig) % gsz); u.pn = (wgid % nig) / gsz; u.ao = 0; u.bo = 0; return true;
    }
    __device__ __forceinline__ void a_ready(const Unit&) const {}
    __device__ __forceinline__ void done(const Unit&) const {}
};

__device__ __forceinline__ unsigned cvt_pk_bf16(float lo, float hi) { unsigned r; asm volatile("v_cvt_pk_bf16_f32 %0, %1, %2" : "=v"(r) : "v"(lo), "v"(hi)); return r; }
typedef float f32x2 __attribute__((ext_vector_type(2)));
__device__ __forceinline__ const char* uni_ptr(const char* p) { const unsigned long long v = (unsigned long long)p; return (const char*)(((unsigned long long)(unsigned)__builtin_amdgcn_readfirstlane((int)(v >> 32)) << 32) | (unsigned)__builtin_amdgcn_readfirstlane((int)v)); }
template <class Epi, class Sched, bool ALIGN_EPI = false, bool SP2 = false>
__device__ __forceinline__ void gemm_phase(PG8_LAS unsigned char* lds, const Gemm g, const Sched& S, const Epi& E) {
    int tid_ = threadIdx.x; asm volatile("" : "+v"(tid_));
    const int tid = tid_, wid = __builtin_amdgcn_readfirstlane(tid >> 6), lane = tid & 63, wr = wid >> 2, wc = wid & 3, fr = lane & 15, fq = lane >> 4;
    const int K = g.K, nt = K / BK;
    unsigned voffA[2], voffB[2];
#pragma unroll
    for (int i = 0; i < 2; ++i) { int R, C; stage_rc(tid * 16 + i * 8192, R, C); const int Rb = Epi::PERM ? ((R & ~31) + perm32(R & 31)) : R;
        voffA[i] = (unsigned)(R * K + C) * 2u; voffB[i] = (unsigned)(Rb * K + C) * 2u; }
    const size_t kstep = (size_t)(BK * 2);
    const size_t hstep = (size_t)HALF * K * 2;
    const size_t tstep = 2 * hstep;
    const unsigned ldsw = (unsigned)wid * 1024u;
    const int aoff = lds_byte(wr * 64 + fr, fq * 8), boff = lds_byte(wc * 32 + fr, fq * 8);
#define PG8_SA(b, h) (((b) * 2 + (h)) * HTB)
#define PG8_SB(b, h) ((4 + (b) * 2 + (h)) * HTB)
#define PG8_STAGE(bufoff, gbase, voff) do { _Pragma("unroll") for (int _i = 0; _i < 2; ++_i) \
        __builtin_amdgcn_global_load_lds((const unsigned*)((const char*)(gbase) + (voff)[_i]), (PG8_LAS unsigned*)(lds + (bufoff) + ldsw + _i * 8192), 16, 0, 0); } while (0)
#define PG8_LDA(dst, b, h) do { _Pragma("unroll") for (int m = 0; m < 4; ++m) _Pragma("unroll") for (int k = 0; k < 2; ++k) dst[m][k] = *(const PG8_LAS bf16x8*)(lds + PG8_SA(b, h) + aoff + m * 2048 + k * 1024); } while (0)
#define PG8_LDB(dst, b, h) do { _Pragma("unroll") for (int n = 0; n < 2; ++n) _Pragma("unroll") for (int k = 0; k < 2; ++k) dst[n][k] = *(const PG8_LAS bf16x8*)(lds + PG8_SB(b, h) + boff + n * 2048 + k * 1024); } while (0)
#define PG8_MMA(ai, bj, At, Bt) do { __builtin_amdgcn_s_setprio(1); _Pragma("unroll") for (int m = 0; m < 4; ++m) _Pragma("unroll") for (int n = 0; n < 2; ++n) _Pragma("unroll") for (int k = 0; k < 2; ++k) \
        acc[ai][bj][m][n] = __builtin_amdgcn_mfma_f32_16x16x32_bf16(Bt[n][k], At[m][k], acc[ai][bj][m][n], 0, 0, 0); __builtin_amdgcn_s_setprio(0); } while (0)
#define PG8_WAIT_V(n) asm volatile("s_waitcnt vmcnt(" #n ")" ::: "memory")
#define PG8_WAIT_L(n) asm volatile("s_waitcnt lgkmcnt(" #n ")" ::: "memory")
#define PG8_WAIT_VE asm volatile("s_waitcnt vmcnt(%0)" :: "n"(8 + Epi::VM_OPS) : "memory")
#define PG8_BAR __builtin_amdgcn_s_barrier()
#define PG8_SCHED __builtin_amdgcn_sched_barrier(0)
    Unit cur, nxt; int ui = 0;
    if (!S.next(0, cur)) return;
    f32x4 acc[2][2][4][2];
#pragma unroll
    for (int a = 0; a < 2; ++a)
#pragma unroll
        for (int b = 0; b < 2; ++b)
#pragma unroll
            for (int m = 0; m < 4; ++m)
#pragma unroll
                for (int n = 0; n < 2; ++n) acc[a][b][m][n] = (f32x4){0.f, 0.f, 0.f, 0.f};
    bf16x8 At[4][2], B0[2][2], B1[2][2];
    const char* cA = uni_ptr((const char*)g.A + (size_t)cur.pm * tstep + cur.ao); const char* cB = uni_ptr((const char*)g.Bt + (size_t)cur.pn * tstep + cur.bo);
    S.a_ready(cur);
    if constexpr (SP2) {
        PG8_STAGE(PG8_SB(0, 0), cB, voffB); PG8_STAGE(PG8_SB(0, 1), cB + hstep, voffB); PG8_STAGE(PG8_SA(0, 0), cA, voffA); PG8_STAGE(PG8_SA(0, 1), cA + hstep, voffA);
        if (wr == 1) PG8_BAR;
        PG8_WAIT_V(2); PG8_BAR;
        PG8_STAGE(PG8_SB(1, 0), cB + kstep, voffB); PG8_STAGE(PG8_SA(1, 0), cA + kstep, voffA); PG8_STAGE(PG8_SB(1, 1), cB + hstep + kstep, voffB); PG8_STAGE(PG8_SA(1, 1), cA + hstep + kstep, voffA);
        PG8_WAIT_V(8); PG8_BAR;
    } else {
        PG8_STAGE(PG8_SB(0, 0), cB, voffB); PG8_STAGE(PG8_SA(0, 0), cA, voffA); PG8_STAGE(PG8_SB(0, 1), cB + hstep, voffB); PG8_STAGE(PG8_SA(0, 1), cA + hstep, voffA);
        if (wr == 1) PG8_BAR;
        PG8_WAIT_V(4); PG8_BAR;
        PG8_STAGE(PG8_SB(1, 0), cB + kstep, voffB); PG8_STAGE(PG8_SA(1, 0), cA + kstep, voffA); PG8_STAGE(PG8_SB(1, 1), cB + hstep + kstep, voffB);
        PG8_WAIT_V(6); PG8_BAR;
    }
    for (;;) {
        const bool has_next = S.next(ui + 1, nxt);
        const char* nA = uni_ptr(has_next ? (const char*)g.A + (size_t)nxt.pm * tstep + nxt.ao : cA); const char* nB = uni_ptr(has_next ? (const char*)g.Bt + (size_t)nxt.pn * tstep + nxt.bo : cB);
        for (int t = 0; t < nt; t += 2) {
            const bool last = (t == nt - 2);
            const char* a1 = cA + (size_t)(t + 1) * kstep;
            const char* a2 = last ? nA : cA + (size_t)(t + 2) * kstep; const char* b2 = last ? nB : cB + (size_t)(t + 2) * kstep;
            const char* a3 = a2 + kstep; const char* b3 = b2 + kstep;
            if (last && has_next) S.a_ready(nxt);
            if constexpr (SP2) {
            const int fresh = __builtin_amdgcn_readfirstlane((t == 0 && ui > 0) ? 1 : 0);
#define PG8_WAIT_V8F asm volatile("s_waitcnt vmcnt(%1)\n\ts_cmp_lg_u32 %0, 0\n\ts_cbranch_scc1 .Lpg8f%=\n\ts_waitcnt vmcnt(8)\n.Lpg8f%=:" :: "s"(fresh), "n"(8 + Epi::VM_OPS) : "memory", "scc")
            PG8_LDB(B0, 0, 0); PG8_LDB(B1, 0, 1); PG8_SCHED; PG8_LDA(At, 0, 0);
            PG8_WAIT_V8F; PG8_WAIT_L(0); PG8_BAR; PG8_MMA(0, 0, At, B0); PG8_MMA(0, 1, At, B1); PG8_BAR; PG8_SCHED;
            PG8_LDA(At, 0, 1); PG8_STAGE(PG8_SB(0, 0), b2, voffB); PG8_STAGE(PG8_SB(0, 1), b2 + hstep, voffB); PG8_STAGE(PG8_SA(0, 0), a2, voffA);
            PG8_WAIT_V8F; PG8_WAIT_L(0); PG8_BAR; PG8_MMA(1, 0, At, B0); PG8_MMA(1, 1, At, B1); PG8_BAR; PG8_SCHED;
            PG8_LDB(B0, 1, 0); PG8_LDB(B1, 1, 1); PG8_SCHED; PG8_LDA(At, 1, 0); PG8_STAGE(PG8_SA(0, 1), a2 + hstep, voffA);
            PG8_WAIT_V8F; PG8_WAIT_L(0); PG8_BAR; PG8_MMA(0, 0, At, B0); PG8_MMA(0, 1, At, B1); PG8_BAR; PG8_SCHED;
#undef PG8_WAIT_V8F
            PG8_LDA(At, 1, 1); PG8_STAGE(PG8_SB(1, 0), b3, voffB); PG8_STAGE(PG8_SB(1, 1), b3 + hstep, voffB); PG8_STAGE(PG8_SA(1, 0), a3, voffA);
            PG8_WAIT_V(8); PG8_WAIT_L(0); PG8_BAR; PG8_MMA(1, 0, At, B0); PG8_MMA(1, 1, At, B1); PG8_BAR; PG8_SCHED;
            PG8_STAGE(PG8_SA(1, 1), a3 + hstep, voffA); PG8_SCHED;
            } else {
            PG8_LDB(B0, 0, 0); PG8_SCHED; PG8_LDA(At, 0, 0); PG8_STAGE(PG8_SA(1, 1), a1 + hstep, voffA);
            PG8_WAIT_L(8); PG8_BAR; PG8_WAIT_L(0); PG8_MMA(0, 0, At, B0); PG8_BAR; PG8_SCHED;
            PG8_LDB(B1, 0, 1); PG8_STAGE(PG8_SB(0, 0), b2, voffB);
            PG8_BAR; PG8_WAIT_L(0); PG8_MMA(0, 1, At, B1); PG8_BAR;
            PG8_LDA(At, 0, 1); PG8_STAGE(PG8_SA(0, 0), a2, voffA);
            PG8_BAR; PG8_WAIT_L(0); PG8_MMA(1, 0, At, B0); PG8_BAR; PG8_SCHED;
            PG8_STAGE(PG8_SB(0, 1), b2 + hstep, voffB);
            PG8_WAIT_V(6); PG8_BAR; PG8_MMA(1, 1, At, B1); PG8_BAR;
            PG8_LDB(B0, 1, 0); PG8_SCHED; PG8_LDA(At, 1, 0); PG8_STAGE(PG8_SA(0, 1), a2 + hstep, voffA);
            PG8_WAIT_L(8); PG8_BAR; PG8_WAIT_L(0); PG8_MMA(0, 0, At, B0); PG8_BAR; PG8_SCHED;
            PG8_LDB(B1, 1, 1); PG8_STAGE(PG8_SB(1, 0), b3, voffB);
            PG8_BAR; PG8_WAIT_L(0); PG8_MMA(0, 1, At, B1); PG8_BAR;
            PG8_LDA(At, 1, 1); PG8_STAGE(PG8_SA(1, 0), a3, voffA);
            PG8_BAR; PG8_WAIT_L(0); PG8_MMA(1, 0, At, B0); PG8_BAR; PG8_SCHED;
            PG8_STAGE(PG8_SB(1, 1), b3 + hstep, voffB);
            PG8_WAIT_V(6); PG8_BAR; PG8_MMA(1, 1, At, B1); PG8_BAR;
            }
        }
        if constexpr (ALIGN_EPI) { if (wr == 0) PG8_BAR; }
        bool keep_acc = false;
        if constexpr (Epi::CHAIN) { keep_acc = E.chain(acc, cur, wr, wc, fr, fq); S.done(cur); }
        else if constexpr (!Epi::AFTER_DRAIN) { E(acc, cur, wr, wc, fr, fq); S.done(cur); }
        if (!has_next) break;
        if (!keep_acc) {
#pragma unroll
        for (int a = 0; a < 2; ++a)
#pragma unroll
            for (int b = 0; b < 2; ++b)
#pragma unroll
                for (int m = 0; m < 4; ++m)
#pragma unroll
                    for (int n = 0; n < 2; ++n) acc[a][b][m][n] = (f32x4){0.f, 0.f, 0.f, 0.f};
        }
        cur = nxt; cA = nA; cB = nB; ++ui;
        if constexpr (ALIGN_EPI) { if (wr == 1) PG8_BAR; }
    }
    PG8_WAIT_V(0);
    if constexpr (!ALIGN_EPI) { if (wr == 0) PG8_BAR; }
    PG8_BAR;
    if constexpr (Epi::AFTER_DRAIN) { E.fused(acc, cur, wr, wc, fr, fq, lds, wid, lane); S.done(cur); }
#undef PG8_SA
#undef PG8_SB
#undef PG8_STAGE
#undef PG8_LDA
#undef PG8_LDB
#undef PG8_MMA
#undef PG8_WAIT_V
#undef PG8_WAIT_L
#undef PG8_WAIT_VE
#undef PG8_BAR
#undef PG8_SCHED
}
}
#define LAS __attribute__((address_space(3)))
#define XB_TMO      128
#define XB_XCNT(j)  (256  + 64 * (j))
#define XB_XSUB(j)  (1280 + 64 * (j))
#define XB_XGEN(j)  (2304 + 64 * (j))
#define XB_TOP      3328
#define XB_TOPGEN   3392
#define XCD_BAR_WORDS 3456
#define XB_SPIN_CAP (1u << 18)

__device__ __forceinline__ unsigned xb_ld(unsigned* p)              { return __hip_atomic_load(p, __ATOMIC_RELAXED, __HIP_MEMORY_SCOPE_AGENT); }
__device__ __forceinline__ unsigned xb_add(unsigned* p, unsigned v) { return __hip_atomic_fetch_add(p, v, __ATOMIC_RELAXED, __HIP_MEMORY_SCOPE_AGENT); }
__device__ __forceinline__ unsigned xb_xcc_id() { return (unsigned)__builtin_amdgcn_s_getreg((3 << 11) | 20) & 0xFu; }
#define XB_SPIN(cond, bar) do { unsigned _sp = 0; while (cond) { __builtin_amdgcn_s_sleep(1); \
    if ((++_sp & 255u) == 0u) { if (xb_ld(&(bar)[XB_TMO])) break; if (_sp > XB_SPIN_CAP) { atomicAdd(&(bar)[XB_TMO], 1u); break; } } } } while (0)

struct XcdBarrier {
    unsigned* bar; unsigned x;
    volatile LAS unsigned* st;
};

__device__ __forceinline__ XcdBarrier xcd_barrier_post(unsigned* bar, volatile LAS unsigned* st) {
    XcdBarrier b; b.bar = bar; b.x = xb_xcc_id(); b.st = st;
    if (threadIdx.x == 0) (void)xb_add(&bar[XB_XCNT(b.x)], 1u);
    return b;
}
__device__ __forceinline__ void xcd_barrier_complete(unsigned* bar, unsigned x, unsigned& nloc, unsigned& nx) {
    const unsigned G = gridDim.x * gridDim.y * gridDim.z;
    unsigned sum, cnt, mine, sp = 0u;
    for (;;) {
        sum = 0u; cnt = 0u; mine = 0u;
#pragma unroll
        for (unsigned j = 0; j < 16; ++j) { const unsigned c = xb_ld(&bar[XB_XCNT(j)]); sum += c; cnt += (c > 0u) ? 1u : 0u; mine = (j == x) ? c : mine; }
        if (sum == G) break;
        __builtin_amdgcn_s_sleep(1);
        if ((++sp & 255u) == 0u) { if (xb_ld(&bar[XB_TMO])) break; if (sp > XB_SPIN_CAP) { atomicAdd(&bar[XB_TMO], 1u); break; } }
    }
    nloc = mine > 0u ? mine : 1u; nx = cnt > 0u ? cnt : 1u;
}

__device__ __forceinline__ void xcd_barrier(const XcdBarrier& b) {
    asm volatile("s_waitcnt vmcnt(0)" ::: "memory");
    __syncthreads();
    if (threadIdx.x == 0) {
        unsigned* bar = b.bar; unsigned bx = b.x; asm volatile("" : "+s"(bar), "+s"(bx));
        __builtin_amdgcn_s_waitcnt(0);
        unsigned nloc = b.st[0], nx = b.st[1];
        if (nloc == 0u) { xcd_barrier_complete(bar, bx, nloc, nx); b.st[0] = nloc; b.st[1] = nx; }
        const unsigned old = xb_add(&bar[XB_XSUB(bx)], 1u);
        const unsigned gen = old / nloc;
        if (old + 1u == (gen + 1u) * nloc) {
            __builtin_amdgcn_fence(__ATOMIC_RELEASE, "agent");
            asm volatile("s_waitcnt vmcnt(0)" ::: "memory");
            const unsigned og = xb_add(&bar[XB_TOP], 1u);
            const unsigned tg = og / nx;
            if (og + 1u == (tg + 1u) * nx) xb_add(&bar[XB_TOPGEN], 1u);
            else XB_SPIN(xb_ld(&bar[XB_TOPGEN]) == tg, bar);
            __builtin_amdgcn_fence(__ATOMIC_ACQUIRE, "agent");
            xb_add(&bar[XB_XGEN(bx)], 1u);
            asm volatile("s_waitcnt vmcnt(0)" ::: "memory");
        } else {
            XB_SPIN(xb_ld(&bar[XB_XGEN(bx)]) == gen, bar);
            __builtin_amdgcn_fence(__ATOMIC_ACQUIRE, "agent");
            asm volatile("s_waitcnt vmcnt(0)" ::: "memory");
        }
    }
    __syncthreads();
}
typedef unsigned short bf16;
typedef unsigned v4u __attribute__((ext_vector_type(4)));
typedef unsigned v2u __attribute__((ext_vector_type(2)));
typedef float f32x4 __attribute__((ext_vector_type(4)));
typedef float f32x16 __attribute__((ext_vector_type(16)));
typedef short bf16x8 __attribute__((ext_vector_type(8)));
typedef short s16x4 __attribute__((ext_vector_type(4)));
constexpr int DM = 1024, NB = 16, SEQ = 2048, DEPTH = 2, DFF = 2816, INW = 8388;
constexpr int M = NB * SEQ, MH = M / 2, HBAT = NB / 2;
constexpr int O_AQ = 0, O_AK = 256, O_AV = 320, O_IQ = 384, O_IK = 512, O_IW = 544, O_B = 548, O_CQ = 1316, O_CKV = 1700, O_CKR = 1956, O_D = 1988, O_G = 4292;
constexpr int NT_IN = 33, N_INP = NT_IN * 256;
constexpr float EPS = 1e-6f, LOG2E = 1.4426950408889634f;
constexpr float C2A = 0.125f * LOG2E;
constexpr float C2C = 0.10206207261596577f * LOG2E;
constexpr int NWAVES = 8, NTHR = 512;
#ifndef WGM_FFO
#define WGM_FFO 4
#endif
#ifndef WGM_FFI
#define WGM_FFI 4
#endif
#ifndef WGM_INP
#define WGM_INP 4
#endif
constexpr size_t MiB = (size_t)1 << 20;
constexpr size_t WS_CTL = 0, CTL_BYTES = 1 * MiB;
constexpr size_t WS_BIAS = 1 * MiB;
constexpr size_t WS_BIASD = WS_BIAS + 20 * 2112 * 4;
constexpr size_t WS_BID = WS_BIASD + 12 * 192 * 4;
constexpr size_t WS_ROPE = 2 * MiB;
constexpr size_t WS_KMEAN = 3 * MiB;
constexpr size_t WS_WFI = 4 * MiB;
constexpr size_t WS_WFO = 48 * MiB;
constexpr size_t WS_WIN = 70 * MiB;
constexpr size_t WS_WO = 103 * MiB;
constexpr size_t WS_WB = 107 * MiB;
constexpr size_t WS_WUQ = 111 * MiB;
constexpr size_t WS_WUKV = 112 * MiB;
constexpr size_t WS_XB = 113 * MiB;
constexpr size_t WS_SSQ = 177 * MiB;
constexpr size_t WS_R = 180 * MiB;
constexpr size_t TILE_B = (size_t)MH * 256 * 2;
constexpr size_t WS_CQL = WS_R + 2 * TILE_B;
constexpr size_t WS_XS = WS_CQL + (size_t)MH * 384 * 2;
constexpr size_t WS_CKVL = WS_R + 4 * TILE_B;
constexpr size_t WS_DC = WS_R + 2 * TILE_B;
constexpr size_t WS_U = WS_R + 11 * TILE_B;
constexpr size_t WS_QN = 444 * MiB, WS_KN = 456 * MiB, WS_VC = 468 * MiB, WS_OC = 476 * MiB;
constexpr size_t WS_IWF = 484 * MiB;
constexpr size_t WS_SSL = 485 * MiB;
constexpr size_t WS_MASK = 486 * MiB;
constexpr size_t WS_LSED = 490 * MiB;
constexpr size_t WS_END = 492 * MiB;
constexpr int CW_BAR = 4096, CW_QUEUE = 16384, CW_SEAM = 32768;
constexpr int PH_PRO = 0, PH_L0 = 1, PH_PER_LAYER = 16, N_PHASES = 1 + 2 * PH_PER_LAYER;
enum { PO_F1I = 0, PO_F1O = 1, PO_INP = 2, PO_PREP = 3, PO_ATT = 4, PO_CMB = 5, PO_MRG = 6, PO_OUT = 7,   PO_F2I = 14, PO_F2O = 15 };

struct Args { const float* in[17]; float* out; unsigned char* ws; int ph_lo, ph_hi; };

__device__ __forceinline__ float bf2f(bf16 b) { return __uint_as_float(((unsigned)b) << 16); }
__device__ __forceinline__ unsigned f2bf(float f) { unsigned u = __float_as_uint(f); return (u + 0x7fffu + ((u >> 16) & 1u)) >> 16; }
typedef float f32x2_t __attribute__((ext_vector_type(2))); typedef __bf16 bf16x2_t __attribute__((ext_vector_type(2)));
__device__ __forceinline__ unsigned pk2(float lo, float hi) { f32x2_t v = {lo, hi}; bf16x2_t b = __builtin_convertvector(v, bf16x2_t); return __builtin_bit_cast(unsigned, b); }
#define CAS __attribute__((address_space(4)))
__device__ __forceinline__ float bperm_f(int srclane, float v) { return __int_as_float(__builtin_amdgcn_ds_bpermute(srclane << 2, __float_as_int(v))); }
__device__ __forceinline__ int bperm_i(int srclane, int v) { return __builtin_amdgcn_ds_bpermute(srclane << 2, v); }
__device__ __forceinline__ float xsum32(float v) { auto rr = __builtin_amdgcn_permlane32_swap(__float_as_uint(v), __float_as_uint(v), false, false); return __uint_as_float(rr[0]) + __uint_as_float(rr[1]); }
__device__ __forceinline__ v4u pair16(v2u X, v2u Y) { auto a = __builtin_amdgcn_permlane32_swap(X.x, Y.x, false, false); auto b = __builtin_amdgcn_permlane32_swap(X.y, Y.y, false, false); v4u o; o.x = a[0]; o.y = b[0]; o.z = a[1]; o.w = b[1]; return o; }
__device__ __forceinline__ float xmax32(float v) { auto rr = __builtin_amdgcn_permlane32_swap(__float_as_uint(v), __float_as_uint(v), false, false); return fmaxf(__uint_as_float(rr[0]), __uint_as_float(rr[1])); }
__host__ __device__ __forceinline__ int inproj_srccol(int n) {
    const int pn = n >> 8, c = n & 255;
    if (pn >= 17) { const int g = pn - 17; return O_G + (g >> 2) * 1024 + (g & 3) * 256 + c; }
    const int slot = (c >> 5) & 3, e = 32 * (c >> 7) + (c & 31);
    switch (pn) {
        case 0: return O_AQ + slot * 64 + e;
        case 1: return slot == 0 ? O_AK + e : slot == 1 ? O_AV + e : O_IQ + (slot - 2) * 64 + e;
        case 2: return O_CQ + slot * 64 + e;
        case 3: if (slot < 2) return O_CQ + 256 + slot * 64 + e; if (slot == 2) return e < 32 ? O_IK + e : O_CKR + (e - 32); return e < 4 ? O_IW + e : -1;
        case 4: return O_CKV + slot * 64 + e;
        default: if (pn <= 7) return O_B + (pn - 5) * 256 + slot * 64 + e; return O_D + (pn - 8) * 256 + slot * 64 + e;
    }
}
__device__ __forceinline__ float row_scale(const float* ssq, int row, int fr, int fq) {
    const f32x4 a = *(const f32x4*)(ssq + (size_t)row * 16 + 4 * fq); float s = (a[0] + a[1]) + (a[2] + a[3]);
    s += bperm_f(((fq ^ 1) << 4) | fr, s); s = xsum32(s);
    return rsqrtf(s * (1.0f / 1024.0f) + EPS);
}
__device__ __forceinline__ void row_scales8(const float* ssq, int row0, int fr, int fq, float (&rs)[2][4]) {
    f32x4 a[2][4];
#pragma unroll
    for (int ai = 0; ai < 2; ++ai)
#pragma unroll
        for (int m = 0; m < 4; ++m) a[ai][m] = *(const f32x4*)(ssq + (size_t)(row0 + ai * 128 + m * 16) * 16 + 4 * fq);
    __builtin_amdgcn_sched_barrier(0);
    float s[2][4], o[2][4];
#pragma unroll
    for (int ai = 0; ai < 2; ++ai)
#pragma unroll
        for (int m = 0; m < 4; ++m) { s[ai][m] = (a[ai][m][0] + a[ai][m][1]) + (a[ai][m][2] + a[ai][m][3]); o[ai][m] = bperm_f(((fq ^ 1) << 4) | fr, s[ai][m]); }
#pragma unroll
    for (int ai = 0; ai < 2; ++ai)
#pragma unroll
        for (int m = 0; m < 4; ++m) rs[ai][m] = rsqrtf(xsum32(s[ai][m] + o[ai][m]) * (1.0f / 1024.0f) + EPS);
}
__device__ __forceinline__ float fast_sigmoid(float x) { return __builtin_amdgcn_rcpf(1.0f + __builtin_amdgcn_exp2f(-x * LOG2E)); }
__device__ __forceinline__ v4u pack8(const f32x4 a, const f32x4 b) { v4u w; w.x = pk2(a[0], a[1]); w.y = pk2(a[2], a[3]); w.z = pk2(b[0], b[1]); w.w = pk2(b[2], b[3]); return w; }

struct EpiFfnIn {
    static constexpr int VM_OPS = 16;
    static constexpr bool CHAIN = false;
    static constexpr bool PERM = true, AFTER_DRAIN = false;
    const float* ssq; bf16* h2;
    __device__ __forceinline__ void operator()(const pg8::f32x4 (&acc)[2][2][4][2], const pg8::Unit& u, int wr, int wc, int fr, int fq) const {
        const int row0 = u.pm * 256 + wr * 64 + fr, colh = u.pn * 128 + wc * 32 + fq * 8;
        float rs[2][4]; row_scales8(ssq, row0, fr, fq, rs);
#pragma unroll
        for (int ai = 0; ai < 2; ++ai)
#pragma unroll
            for (int m = 0; m < 4; ++m) { const int row = row0 + ai * 128 + m * 16; const float s = rs[ai][m], sm = -s * LOG2E, ss = s * s;
                unsigned w[4];
#pragma unroll
                for (int n = 0; n < 2; ++n)
#pragma unroll
                    for (int jp = 0; jp < 2; ++jp) { const f32x2_t a = {acc[ai][0][m][n][2 * jp], acc[ai][0][m][n][2 * jp + 1]}, b = {acc[ai][1][m][n][2 * jp], acc[ai][1][m][n][2 * jp + 1]};
                        const f32x2_t t = a * sm; f32x2_t d = {__builtin_amdgcn_exp2f(t.x), __builtin_amdgcn_exp2f(t.y)}; d = d + 1.0f;
                        const f32x2_t r = {__builtin_amdgcn_rcpf(d.x), __builtin_amdgcn_rcpf(d.y)}, h = ((a * b) * ss) * r; w[2 * n + jp] = pk2(h.x, h.y); }
                v4u wv; wv.x = w[0]; wv.y = w[1]; wv.z = w[2]; wv.w = w[3];
                __builtin_nontemporal_store(wv, (v4u*)(h2 + (size_t)row * DFF + colh)); }
    }
};
struct EpiResid {
    static constexpr int VM_OPS = 32;
    static constexpr bool CHAIN = false;
    static constexpr bool PERM = true, AFTER_DRAIN = false;
    float* out; bf16* xb; float* ssq; float alpha;
    __device__ __forceinline__ void operator()(const pg8::f32x4 (&acc)[2][2][4][2], const pg8::Unit& u, int wr, int wc, int fr, int fq) const {
        const int row0 = u.pm * 256 + wr * 64 + fr, col0 = u.pn * 256 + wc * 32 + fq * 8;
        const bool fin = out != nullptr;
#pragma unroll
        for (int ai = 0; ai < 2; ++ai) {
            v4u bv[4][2];
#pragma unroll
            for (int m = 0; m < 4; ++m)
#pragma unroll
                for (int bj = 0; bj < 2; ++bj) bv[m][bj] = *(const v4u*)(xb + (size_t)(row0 + ai * 128 + m * 16) * DM + col0 + bj * 128);
            __builtin_amdgcn_sched_barrier(0);
#pragma unroll
            for (int m = 0; m < 4; ++m) { const int row = row0 + ai * 128 + m * 16; float ss = 0.f;
#pragma unroll
                for (int bj = 0; bj < 2; ++bj) { const size_t o = (size_t)row * DM + col0 + bj * 128; const v4u b = bv[m][bj];
                    f32x4 x0, x1;
                    x0[0] = __uint_as_float(b.x << 16); x0[1] = __uint_as_float(b.x & 0xffff0000u); x0[2] = __uint_as_float(b.y << 16); x0[3] = __uint_as_float(b.y & 0xffff0000u);
                    x1[0] = __uint_as_float(b.z << 16); x1[1] = __uint_as_float(b.z & 0xffff0000u); x1[2] = __uint_as_float(b.w << 16); x1[3] = __uint_as_float(b.w & 0xffff0000u);
#pragma unroll
                    for (int j = 0; j < 4; ++j) { x0[j] += alpha * acc[ai][bj][m][0][j]; x1[j] += alpha * acc[ai][bj][m][1][j]; ss += x0[j] * x0[j] + x1[j] * x1[j]; }
                    if (fin) { *(f32x4*)(out + o) = x0; *(f32x4*)(out + o + 4) = x1; }
                    *(v4u*)(xb + o) = pack8(x0, x1); }
                ss += bperm_f(((fq ^ 1) << 4) | fr, ss); ss = xsum32(ss);
                if (fq == 0) ssq[(size_t)row * 16 + u.pn * 4 + wc] = ss; }
            __builtin_amdgcn_sched_barrier(0);
        }
    }
};
struct EpiInProj {
    static constexpr int VM_OPS = 24;
    static constexpr bool CHAIN = false;
    static constexpr bool PERM = true, AFTER_DRAIN = false;
    const float* ssq;
    unsigned char* ws;
    const float* g_a; const float* g_b; const float* g_d;
    const float* bgate;
    __device__ __forceinline__ void operator()(const pg8::f32x4 (&acc)[2][2][4][2], const pg8::Unit& u, int wr, int wc, int fr, int fq) const {
        const int pn = u.pn, row0 = u.pm * 256 + wr * 64 + fr;
        bf16* const tiles = (bf16*)(ws + WS_R);
        float rs[2][4]; row_scales8(ssq, row0, fr, fq, rs);
        if (pn >= 17) {
            const int g = pn - 17, nb = g >> 2, ch = g & 3; const float* bg = bgate + nb * 1024 + ch * 256 + wc * 32 + fq * 8;
            f32x4 bv[2][2];
#pragma unroll
            for (int bj = 0; bj < 2; ++bj) { bv[bj][0] = *(const f32x4*)(bg + bj * 128); bv[bj][1] = *(const f32x4*)(bg + bj * 128 + 4); }
            unsigned char* dst = (unsigned char*)(tiles + (size_t)pn * MH * 256) + wc * 32 + fq * 8;
#pragma unroll
            for (int ai = 0; ai < 2; ++ai)
#pragma unroll
                for (int m = 0; m < 4; ++m) { const int row = row0 + ai * 128 + m * 16; const float s = rs[ai][m];
#pragma unroll
                    for (int bj = 0; bj < 2; ++bj) { unsigned q[8];
#pragma unroll
                        for (int j = 0; j < 4; ++j) { q[j] = (unsigned)fmaxf(fast_sigmoid(acc[ai][bj][m][0][j] * s + bv[bj][0][j]) * 255.0f + 0.5f, 1.0f); q[4 + j] = (unsigned)fmaxf(fast_sigmoid(acc[ai][bj][m][1][j] * s + bv[bj][1][j]) * 255.0f + 0.5f, 1.0f); }
                        v2u w; w.x = q[0] | (q[1] << 8) | (q[2] << 16) | (q[3] << 24); w.y = q[4] | (q[5] << 8) | (q[6] << 16) | (q[7] << 24);
                        *(v2u*)(dst + (size_t)row * 256 + bj * 128) = w; } }
            return;
        }
        bf16* dst; int ld; int mode = 0  ; const float* gain = nullptr; float scale = 1.f; float* ssl = nullptr; bool iw = false;
        switch (pn) {
            case 0: dst = tiles + wc * 64; ld = 256; mode = 1; gain = g_a; scale = C2A; break;
            case 1: dst = tiles + (size_t)1 * MH * 256 + wc * 64; ld = 256; if (wc == 0) { mode = 1; gain = g_a + 64; } break;
            case 2: dst = (bf16*)(ws + WS_CQL) + wc * 64; ld = 384; ssl = (float*)(ws + WS_SSL) + wc; break;
            case 3: if (wc < 2) { dst = (bf16*)(ws + WS_CQL) + 256 + wc * 64; ld = 384; ssl = (float*)(ws + WS_SSL) + 4 + wc; } else { dst = (bf16*)(ws + WS_XS) + (wc - 2) * 64; ld = 128; iw = (wc == 3); } break;
            case 4: dst = (bf16*)(ws + WS_CKVL) + wc * 64; ld = 256; ssl = (float*)(ws + WS_SSL) + 6 + wc; break;
            default: dst = tiles + (size_t)pn * MH * 256 + wc * 64; ld = 256;
                if (pn == 5) { mode = 1; gain = g_b; scale = C2A; } else if (pn == 6) { mode = 1; gain = g_b + 64; }
                else if (pn >= 8 && pn <= 10) { mode = 1; gain = g_d; scale = C2A; } else if (pn >= 11 && pn <= 13) { mode = 1; gain = g_d + 64; }
                break;
        }
        f32x4 gv[2][2];
#pragma unroll
        for (int bj = 0; bj < 2; ++bj)
#pragma unroll
            for (int n = 0; n < 2; ++n) gv[bj][n] = mode ? *(const f32x4*)(gain + 32 * bj + 8 * fq + 4 * n) : (f32x4){1.f, 1.f, 1.f, 1.f};
#pragma unroll
        for (int ai = 0; ai < 2; ++ai)
#pragma unroll
            for (int m = 0; m < 4; ++m) { const int row = row0 + ai * 128 + m * 16; const float s = rs[ai][m];
                f32x4 v[2][2]; float ss = 0.f;
#pragma unroll
                for (int bj = 0; bj < 2; ++bj)
#pragma unroll
                    for (int n = 0; n < 2; ++n)
#pragma unroll
                        for (int j = 0; j < 4; ++j) { const float t = acc[ai][bj][m][n][j] * s; v[bj][n][j] = t; ss += t * t; }
                if (mode || ssl) { ss += bperm_f(((fq ^ 1) << 4) | fr, ss); ss = xsum32(ss); }
                if (ssl && fq == 0) ssl[(size_t)row * 16] = ss;
                if (iw && fq == 0) *(f32x4*)((float*)(ws + WS_IWF) + (size_t)row * 4) = v[0][0];
                const float r = mode ? rsqrtf(ss * (1.0f / 64.0f) + EPS) * scale : 1.f;
#pragma unroll
                for (int bj = 0; bj < 2; ++bj) { f32x4 a, b;
#pragma unroll
                    for (int j = 0; j < 4; ++j) { a[j] = v[bj][0][j] * r * gv[bj][0][j]; b[j] = v[bj][1][j] * r * gv[bj][1][j]; }
                    *(v4u*)(dst + (size_t)row * ld + 32 * bj + 8 * fq) = pack8(a, b); } }
    }
};

struct MergeOrder {
    pg8::StaticOrder S; int a1, a2, a3;
    const unsigned* ready; unsigned* tmo;
    __device__ __forceinline__ bool next(int i, pg8::Unit& u) const { pg8::Unit t; if (!S.next(i >> 2, t)) return false; const int n = i & 3; u.pm = t.pm; u.pn = t.pn; u.ao = __builtin_amdgcn_readfirstlane(n == 0 ? 0 : n == 1 ? a1 : n == 2 ? a2 : a3); u.bo = __builtin_amdgcn_readfirstlane(n * (DM * 256 * 2)); return true; }
    __device__ __forceinline__ void a_ready(const pg8::Unit& u) const {
        if (u.bo != 3 * (DM * 256 * 2)) return;
        if (threadIdx.x < 64) { unsigned spins = 0;
            while ((unsigned)__builtin_amdgcn_readfirstlane(__hip_atomic_load(ready + 64 * u.pm, __ATOMIC_RELAXED, __HIP_MEMORY_SCOPE_AGENT)) < 32u) {
                __builtin_amdgcn_s_sleep(2);
                if (++spins > (1u << 22)) { if (threadIdx.x == 0) __hip_atomic_store(tmo, 1u, __ATOMIC_RELAXED, __HIP_MEMORY_SCOPE_AGENT); break; } }
            __builtin_amdgcn_fence(__ATOMIC_ACQUIRE, "agent");
            asm volatile("s_waitcnt vmcnt(0)" ::: "memory"); }
        asm volatile("" ::: "memory"); __builtin_amdgcn_s_barrier(); asm volatile("" ::: "memory");
    }
    __device__ __forceinline__ void done(const pg8::Unit&) const {}
};
struct EpiMerge {
    static constexpr int VM_OPS = 0;
    static constexpr bool PERM = true, AFTER_DRAIN = false, CHAIN = true;
    const bf16* gates;
    bf16* U;
    __device__ __forceinline__ bool chain(pg8::f32x4 (&acc)[2][2][4][2], const pg8::Unit& u, int wr, int wc, int fr, int fq) const {
        const int n = (int)(u.bo / (DM * 256 * 2)); const int row0 = u.pm * 256 + wr * 64 + fr, ct = wc * 32 + fq * 8;
        const unsigned char* gt = (const unsigned char*)(gates + (size_t)(n * 4 + u.pn) * MH * 256) + (size_t)row0 * 256 + ct; bf16* up = U + u.pn * 256 + ct;
        const size_t gnext = (n < 3) ? (size_t)4 * MH * 256 * 2 : 0;
        v2u gv[16], gw[16];
#pragma unroll
        for (int i = 0; i < 16; ++i) { const unsigned char* gp = gt + (size_t)((i >> 3) * 128 + ((i >> 1) & 3) * 16) * 256 + (i & 1) * 128; gv[i] = *(const v2u*)gp; gw[i] = *(const v2u*)(gp + gnext); }
        __builtin_amdgcn_sched_barrier(0);
#pragma unroll
        for (int ai = 0; ai < 2; ++ai)
#pragma unroll
            for (int m = 0; m < 4; ++m) { const int row = row0 + ai * 128 + m * 16;
#pragma unroll
                for (int bj = 0; bj < 2; ++bj) { const v2u a = gv[ai * 8 + m * 2 + bj], b = gw[ai * 8 + m * 2 + bj];
                    if (n < 3) {
#pragma unroll
                        for (int k = 0; k < 4; ++k) { acc[ai][bj][m][0][k] *= (float)((a.x >> (8 * k)) & 0xffu) * __builtin_amdgcn_rcpf((float)((b.x >> (8 * k)) & 0xffu));
                            acc[ai][bj][m][1][k] *= (float)((a.y >> (8 * k)) & 0xffu) * __builtin_amdgcn_rcpf((float)((b.y >> (8 * k)) & 0xffu)); }
                    } else { f32x4 x0, x1; constexpr float Q = 1.0f / 255.0f;
#pragma unroll
                        for (int k = 0; k < 4; ++k) { x0[k] = (float)((a.x >> (8 * k)) & 0xffu) * Q * acc[ai][bj][m][0][k]; x1[k] = (float)((a.y >> (8 * k)) & 0xffu) * Q * acc[ai][bj][m][1][k]; }
                        *(v4u*)(up + (size_t)row * DM + bj * 128) = pack8(x0, x1); } } }
        return n < 3;
    }
};
struct EpiNull {
    static constexpr int VM_OPS = 0;
    static constexpr bool CHAIN = false, PERM = true, AFTER_DRAIN = false;
    float* dummy;
    __device__ __forceinline__ void operator()(const pg8::f32x4 (&acc)[2][2][4][2], const pg8::Unit& u, int wr, int wc, int fr, int fq) const {
        float s = 0.f;
#pragma unroll
        for (int ai = 0; ai < 2; ++ai)
#pragma unroll
            for (int bj = 0; bj < 2; ++bj)
#pragma unroll
                for (int m = 0; m < 4; ++m)
#pragma unroll
                    for (int n = 0; n < 2; ++n) s += acc[ai][bj][m][n][0] + acc[ai][bj][m][n][1] + acc[ai][bj][m][n][2] + acc[ai][bj][m][n][3];
        if (s == 1.2345e-30f) dummy[0] = s;
    }
};
struct EpiFfnInCheap {
    static constexpr int VM_OPS = 0;
    static constexpr bool CHAIN = false;
    static constexpr bool PERM = true, AFTER_DRAIN = false;
    const float* ssq; bf16* h2;
    __device__ __forceinline__ void operator()(const pg8::f32x4 (&acc)[2][2][4][2], const pg8::Unit& u, int wr, int wc, int fr, int fq) const {
        const int row0 = u.pm * 256 + wr * 64 + fr, colh = u.pn * 128 + wc * 32 + fq * 8;
#pragma unroll
        for (int ai = 0; ai < 2; ++ai)
#pragma unroll
            for (int m = 0; m < 4; ++m) { const int row = row0 + ai * 128 + m * 16; f32x4 a = acc[ai][0][m][0] + acc[ai][1][m][0], b = acc[ai][0][m][1] + acc[ai][1][m][1];
#if defined(PROBE_K) && PROBE_K == 4
                __builtin_nontemporal_store(pack8(a, b), (v4u*)(h2 + (size_t)row * DFF + colh)); }
#else
                *(v4u*)(h2 + (size_t)row * DFF + colh) = pack8(a, b); }
#endif
    }
};

struct EpiMergeCheap {
    static constexpr int VM_OPS = 0;
    static constexpr bool PERM = true, AFTER_DRAIN = false, CHAIN = true;
    bf16* U;
    __device__ __forceinline__ bool chain(pg8::f32x4 (&acc)[2][2][4][2], const pg8::Unit& u, int wr, int wc, int fr, int fq) const {
        const int n = (int)(u.bo / (DM * 256 * 2)); const int row0 = u.pm * 256 + wr * 64 + fr, ct = wc * 32 + fq * 8; bf16* up = U + u.pn * 256 + ct;
        if (n == 3) {
#pragma unroll
            for (int ai = 0; ai < 2; ++ai)
#pragma unroll
                for (int m = 0; m < 4; ++m) { const int row = row0 + ai * 128 + m * 16;
#pragma unroll
                    for (int bj = 0; bj < 2; ++bj) *(v4u*)(up + (size_t)row * DM + bj * 128) = pack8(acc[ai][bj][m][0], acc[ai][bj][m][1]); } }
        return n < 3;
    }
};
namespace att {
constexpr int L_BUF = 20480, L_V = 12288;
constexpr int L_BIAS = 3 * L_BUF;
constexpr int L_MASK = L_BIAS + 4 * 2112 * 4;
constexpr int L_BID = L_MASK + 64 * 65 * 4;
constexpr int L_MISC = L_BID + 2112;
constexpr int L_END = L_MISC + 64;
__device__ __forceinline__ void glds16(const void* gsrc, unsigned lds_dst) { unsigned keep;
    asm volatile("s_mov_b32 %0, m0\n\ts_mov_b32 m0, %2\n\ts_nop 0\n\tglobal_load_lds_dwordx4 %1, off\n\ts_mov_b32 m0, %0" : "=&s"(keep) : "v"(gsrc), "s"(lds_dst) : "memory"); }
__device__ __forceinline__ int crow(int r, int hi) { return (r & 3) + 8 * (r >> 2) + 4 * hi; }
__device__ __forceinline__ float max3f(float a, float b, float c) { float r; asm("v_max3_f32 %0, %1, %2, %3" : "=v"(r) : "v"(a), "v"(b), "v"(c)); return r; }
__device__ __forceinline__ unsigned cvtpk(float lo, float hi) { f32x2_t v = {lo, hi}; bf16x2_t b = __builtin_convertvector(v, bf16x2_t); return __builtin_bit_cast(unsigned, b); }
typedef short v4i16_t __attribute__((ext_vector_type(4)));
__device__ __forceinline__ s16x4 vtr(const LAS unsigned char* p) { return __builtin_bit_cast(s16x4, __builtin_amdgcn_ds_read_tr16_b64_v4i16((LAS v4i16_t*)p)); }
#define ATT_WAIT_BAR() asm volatile("s_waitcnt vmcnt(0) lgkmcnt(0)\n\ts_barrier" ::: "memory")
#define ATT_WAIT_BAR_N(N) asm volatile("s_waitcnt vmcnt(" #N ") lgkmcnt(0)\n\ts_barrier" ::: "memory")

struct Unit { int kind, b, h, qt, g, r; };
constexpr int NU_BIG = 768, NU_D0 = 256, NU_D1 = 256, NU_D2 = 512, NU_TOTAL = NU_BIG + NU_D0 + NU_D1 + NU_D2;
__device__ __forceinline__ Unit decode(int idx) {
    Unit u{};
    if (idx < NU_BIG) { const int level = 7 - idx / 96, k = idx % 96;
        if (k < 32) { u.kind = 2; u.b = k >> 2; u.h = k & 3; u.qt = level; }
        else if (k < 64) { u.kind = 1; u.b = (k - 32) >> 2; u.h = k & 3; u.qt = level; }
        else { u.kind = 0; u.b = (k - 64) >> 2; u.qt = 4 * level + 3 - (k & 3); }
        return u; }
    idx -= NU_BIG; u.kind = 3;
    if (idx < NU_D0) { u.g = 0; u.r = 0; u.b = idx >> 5; u.h = (idx >> 3) & 3; u.qt = 7 - (idx & 7); return u; }
    idx -= NU_D0;
    if (idx < NU_D1) { u.g = 1; u.b = idx >> 5; u.h = (idx >> 3) & 3; u.r = (idx >> 1) & 3; u.qt = 1 - (idx & 1); return u; }
    idx -= NU_D1; u.g = 2; u.b = idx >> 6; u.h = (idx >> 4) & 3; u.r = idx & 15; u.qt = 0; return u;
}

template <int KIND> __device__ __forceinline__ void run_unit(unsigned char* ws, LAS unsigned char* lds, const Unit u, const bool dry, unsigned* queue, const bool ahead) {
    constexpr int DQK = (KIND == 2) ? 96 : 64, ND0 = DQK / 16, NCH = DQK / 8;
    int tid_ = threadIdx.x; asm volatile("" : "+v"(tid_));
    const int tid = tid_, lane = tid & 63, r32 = lane & 31, hi = lane >> 5, w = __builtin_amdgcn_readfirstlane(tid >> 6);
    const bf16* const tiles = (const bf16*)(ws + WS_R);
    unsigned pre = 0u; if (ahead && tid == 0) pre = __hip_atomic_fetch_add(queue, 1u, __ATOMIC_RELAXED, __HIP_MEMORY_SCOPE_AGENT);
    const int brow = u.b * SEQ;
    const bf16 *Qp, *Kb, *Vb; bf16* Op; int ldq, ldk, ldv, ldo;
    int tq;
    int kt0, kt1;
    int dil = 1, rr = 0, jb = 0;
    const int head = (KIND == 0) ? (w >> 1) : u.h;
    if constexpr (KIND == 0) { tq = 64 * u.qt + 32 * (w & 1) + r32; ldq = ldk = ldv = ldo = 256;
        Qp = tiles + (size_t)(brow + tq) * 256 + head * 64; Op = (bf16*)Qp; Kb = tiles + (size_t)1 * MH * 256 + (size_t)brow * 256; Vb = Kb + 64; kt0 = 0; kt1 = u.qt; }
    if constexpr (KIND == 1) { tq = 256 * u.qt + 32 * w + r32; ldq = ldk = ldv = ldo = 256;
        Qp = tiles + (size_t)5 * MH * 256 + (size_t)(brow + tq) * 256 + head * 64; Op = (bf16*)Qp; Kb = tiles + (size_t)6 * MH * 256 + (size_t)brow * 256 + head * 64; Vb = tiles + (size_t)7 * MH * 256 + (size_t)brow * 256 + head * 64; kt0 = 0; kt1 = 4 * u.qt + 3; }
    if constexpr (KIND == 2) { tq = 256 * u.qt + 32 * w + r32; ldq = ldk = 384; ldv = ldo = 256;
        Qp = (const bf16*)(ws + WS_QN) + (size_t)(brow + tq) * 384 + head * 96; Op = (bf16*)(ws + WS_OC) + (size_t)(brow + tq) * 256 + head * 64; Kb = (const bf16*)(ws + WS_KN) + (size_t)brow * 384 + head * 96; Vb = (const bf16*)(ws + WS_VC) + (size_t)brow * 256 + head * 64; kt0 = 0; kt1 = 4 * u.qt + 3; }
    if constexpr (KIND == 3) { dil = u.g == 0 ? 1 : u.g == 1 ? 4 : 16; rr = u.r; tq = 256 * u.qt + 32 * w + r32; ldq = ldk = ldv = ldo = 256; jb = 256 * u.qt - 128;
        const int tok = (tq < SEQ / dil ? tq : 0) * dil + rr;
        Qp = tiles + (size_t)(8 + u.g) * MH * 256 + (size_t)(brow + tok) * 256 + head * 64; Op = (bf16*)Qp; Kb = tiles + (size_t)(11 + u.g) * MH * 256 + (size_t)brow * 256 + head * 64; Vb = tiles + (size_t)(14 + u.g) * MH * 256 + (size_t)brow * 256 + head * 64;
        kt0 = (u.qt == 0) ? 2 : 0; kt1 = (u.g == 2) ? 3 : 5; }
    const bool wave_on = (KIND != 3) || (256 * u.qt + 32 * w < SEQ / dil);
    bf16x8 qr[ND0];
#pragma unroll
    for (int d0 = 0; d0 < ND0; ++d0) qr[d0] = *(const bf16x8*)(Qp + 16 * d0 + 8 * hi);
    LAS float* btab = (LAS float*)(lds + L_BIAS);
    if constexpr (KIND == 0) { const float* src = (const float*)(ws + WS_BIAS); for (int i = tid; i < 4 * 2112; i += NTHR) btab[i] = src[i]; }
    if constexpr (KIND == 1) { const float* src = (const float*)(ws + WS_BIAS) + (4 + head) * 2112; for (int i = tid; i < 2112; i += NTHR) btab[i] = src[i]; }
    if constexpr (KIND == 3) { const float* src = (const float*)(ws + WS_BIASD) + (u.g * 4 + head) * 192; if (tid < 256) btab[tid] = tid >= 64 ? src[tid - 64] : 0.f; }
    if constexpr (KIND == 0 || KIND == 1) { if (tid < 132) *(LAS v4u*)(lds + L_BID + 16 * tid) = *(const v4u*)(ws + WS_BID + 16 * tid); }
    unsigned selmask = 0u;
    if constexpr (KIND == 1) {
        const int own = u.qt; const float* km = (const float*)(ws + WS_KMEAN) + (size_t)(u.b * 8) * 256 + head * 64;
        float gate[8];
#pragma unroll
        for (int n = 0; n < 8; ++n) { float a = 0.f;
            if (n < own) {
#pragma unroll
                for (int d0 = 0; d0 < 4; ++d0)
#pragma unroll
                    for (int j = 0; j < 8; ++j) a += bf2f((bf16)qr[d0][j]) * km[n * 256 + 16 * d0 + 8 * hi + j];
                a = xsum32(a); } else a = -INFINITY;
            gate[n] = a; }
#pragma unroll
        for (int rnd = 0; rnd < 3; ++rnd) { int best = -1; float bv = 0.f;
#pragma unroll
            for (int n = 0; n < 8; ++n) { const bool ok = !((selmask >> n) & 1u) && (best < 0 || gate[n] > bv); if (ok) { best = n; bv = gate[n]; } }
            selmask |= 1u << best; }
        selmask &= (1u << own) - 1u;
        if (tid == 0) ((volatile LAS unsigned*)(lds + L_MISC))[1] = 0u;
    }
    const unsigned lds0 = (unsigned)(uintptr_t)lds;
    constexpr int L_VR = 3 * L_V;
    auto tokof = [&](int kt, int j) -> int { if constexpr (KIND == 3) { int jj = jb + 64 * kt + j; jj = jj < 0 ? 0 : jj; return jj * dil + rr; } else return 64 * kt + j; };
    auto dmaK = [&](int kt, int slot) {
        const int tk = tokof(kt, lane);
        glds16(Kb + (size_t)tk * ldk + w * 8, (unsigned)__builtin_amdgcn_readfirstlane(lds0 + slot * L_V + w * 1024));
        if (DQK == 96) glds16(Kb + (size_t)tk * ldk + (8 + (w & 3)) * 8, (unsigned)__builtin_amdgcn_readfirstlane(lds0 + slot * L_V + (8 + (w & 3)) * 1024));
    };
    auto dmaV = [&](int kt, int slot) {
        const int tv = tokof(kt, 16 * (w & 3) + (lane >> 2));
        glds16(Vb + (size_t)tv * ldv + (w >> 2) * 32 + (lane & 3) * 8, (unsigned)__builtin_amdgcn_readfirstlane(lds0 + L_VR + slot * 8192 + w * 1024));
    };
    if constexpr (KIND == 0) {
        const unsigned long long* msrc = (const unsigned long long*)(ws + WS_MASK) + (size_t)((brow + 64 * u.qt) >> 2) * 128; LAS unsigned* mdst = (LAS unsigned*)(lds + L_MASK); const int nw = 2 * (u.qt + 1);
        for (int i = tid; i < 64 * 64; i += NTHR) { const int q = i >> 6, wi = i & 63; if (wi < nw) { const unsigned long long b0 = msrc[(size_t)(q >> 2) * 128 + 2 * wi], b1 = msrc[(size_t)(q >> 2) * 128 + 2 * wi + 1]; const int sh = 16 * (q & 3);
                mdst[q * 65 + wi] = ((unsigned)(b0 >> sh) & 0xffffu) | (((unsigned)(b1 >> sh) & 0xffffu) << 16); } } }
    if constexpr (KIND == 1) { __syncthreads(); if (selmask) (void)__hip_atomic_fetch_or((LAS unsigned*)(lds + L_MISC) + 1, selmask, __ATOMIC_RELAXED, __HIP_MEMORY_SCOPE_WORKGROUP); }
    __syncthreads();
    unsigned umask = 0xffffffffu; if constexpr (KIND == 1) umask = ((volatile LAS unsigned*)(lds + L_MISC))[1];
    asm volatile("s_waitcnt vmcnt(0)" ::: "memory");
#pragma unroll
    for (int d0 = 0; d0 < ND0; ++d0) asm volatile("" : "+v"(qr[d0]));
    asm volatile("" : "+v"(pre)); if (ahead && tid == 0) ((volatile LAS unsigned*)(lds + L_MISC))[2] = pre;
    float mrun = -1e30f; f32x16 o[2], lacc;
#pragma unroll
    for (int i = 0; i < 16; ++i) { o[0][i] = 0.f; o[1][i] = 0.f; lacc[i] = 0.f; }
    const bf16x8 ones = (bf16x8){0x3f80, 0x3f80, 0x3f80, 0x3f80, 0x3f80, 0x3f80, 0x3f80, 0x3f80};
    const LAS unsigned* mrow = (const LAS unsigned*)(lds + L_MASK) + (32 * (w & 1) + r32) * 65;
    auto tile_needed = [&](int kt) -> bool { if constexpr (KIND == 1) { const int blk = kt >> 2; return blk == u.qt || ((umask >> blk) & 1u); } else return true; };
    auto next_tile = [&](int t) -> int { ++t; while (t <= kt1 && !tile_needed(t)) ++t; return t; };
    auto blk_code = [&](int kt, int b) -> int {
        if (!wave_on) return 3;
        if constexpr (KIND == 0) { const int d = 2 * (kt - u.qt) + b - (w & 1); return d < 0 ? 0 : d == 0 ? 1 : 3; }
        if constexpr (KIND == 1) { const int blk = kt >> 2; if (blk == u.qt) { const int d = 2 * (kt & 3) + b - w; return d < 0 ? 0 : d == 0 ? 1 : 3; } return __any((selmask >> blk) & 1u) ? 0 : 3; }
        if constexpr (KIND == 2) { const int d = 2 * kt + b - (8 * u.qt + w); return d < 0 ? 0 : d == 0 ? 1 : 3; }
        if constexpr (KIND == 3) { const int d = 2 * kt + b - w; if (d < 0 || d > 4 || (jb + 64 * kt + 32 * b < 0)) return 3; return d == 4 ? 1 : d == 0 ? 2 : 0; }
        return 0; };
    auto qk = [&](int kslot, f32x16& p0, f32x16& p1) {
        const LAS unsigned char* Ks = lds + kslot * L_V;
        bf16x8 kf[ND0][2];
#pragma unroll
        for (int d0 = 0; d0 < ND0; ++d0) { kf[d0][0] = *(const LAS bf16x8*)(Ks + (2 * d0 + hi) * 1024 + r32 * 16); kf[d0][1] = *(const LAS bf16x8*)(Ks + (2 * d0 + hi) * 1024 + 512 + r32 * 16); }
        __builtin_amdgcn_sched_barrier(0);
#pragma unroll
        for (int i = 0; i < 16; ++i) { p0[i] = 0.f; p1[i] = 0.f; }
#pragma unroll
        for (int d0 = 0; d0 < ND0; ++d0) { p0 = __builtin_amdgcn_mfma_f32_32x32x16_bf16(kf[d0][0], qr[d0], p0, 0, 0, 0); p1 = __builtin_amdgcn_mfma_f32_32x32x16_bf16(kf[d0][1], qr[d0], p1, 0, 0, 0); }
        __builtin_amdgcn_sched_barrier(0); };
    auto sm_pv = [&](int kt, int vslot, int c0, int c1, f32x16& p0, f32x16& p1) {
        const LAS unsigned char* Vs = lds + L_VR + vslot * 8192;
        float cadd = 0.f;
        if constexpr (KIND == 0 || KIND == 1) { const int tqw = tq - r32; int dmin = tqw - 64 * kt - 63, dmax = tqw + 31 - 64 * kt; dmin = dmin < 0 ? 0 : dmin; dmax = dmax < 0 ? 0 : dmax;
            const LAS unsigned char* bid = lds + L_BID + 64; const LAS float* bth = btab + (KIND == 0 ? head * 2112 : 0) + 64;
            if (bid[dmin] == bid[dmax]) cadd = bth[dmin];
            else { const LAS float* bt = bth + (tq - 64 * kt - 4 * hi);
#pragma unroll
                for (int i = 0; i < 16; ++i) { p0[i] += bt[-((i & 3) + 8 * (i >> 2))]; p1[i] += bt[-32 - ((i & 3) + 8 * (i >> 2))]; } }
            if constexpr (KIND == 1) { const int blk = kt >> 2; if (blk != u.qt && !((selmask >> blk) & 1u)) cadd = -INFINITY; } }
        if constexpr (KIND == 3) { const LAS float* bt = btab + 64 + (tq - (jb + 64 * kt + 4 * hi));
#pragma unroll
            for (int i = 0; i < 16; ++i) { p0[i] += bt[-((i & 3) + 8 * (i >> 2))]; p1[i] += bt[-32 - ((i & 3) + 8 * (i >> 2))]; } }
        if (c0 | c1) {
            const int lo0 = (c0 == 2 ? r32 : c0 == 3 ? 64 : 0) - 4 * hi, hi0 = (c0 == 1 ? r32 : c0 == 3 ? -1 : 63) - 4 * hi;
            const int lo1 = (c1 == 2 ? r32 : c1 == 3 ? 64 : 0) - 4 * hi, hi1 = (c1 == 1 ? r32 : c1 == 3 ? -1 : 63) - 4 * hi;
#pragma unroll
            for (int i = 0; i < 16; ++i) { const int c = (i & 3) + 8 * (i >> 2);
                p0[i] = (c < lo0 || c > hi0) ? -INFINITY : p0[i];
                p1[i] = (c < lo1 || c > hi1) ? -INFINITY : p1[i]; } }
        float mxa = max3f(p0[0], p0[1], p1[0]), mxb = max3f(p0[2], p0[3], p1[1]); mxa = max3f(mxa, p1[2], p1[3]);
#pragma unroll
        for (int i = 4; i < 16; i += 4) { mxa = max3f(mxa, p0[i], p0[i + 1]); mxb = max3f(mxb, p0[i + 2], p0[i + 3]); mxa = max3f(mxa, p1[i], p1[i + 1]); mxb = max3f(mxb, p1[i + 2], p1[i + 3]); }
        float mx = xmax32(max3f(mxa, mxb, mxb)) + cadd;
        const float mnew = (mx > mrun + 6.0f) ? mx : mrun;
        if (__any(mnew > mrun)) { const float al = __builtin_amdgcn_exp2f(mrun - mnew);
#pragma unroll
            for (int i = 0; i < 16; ++i) { o[0][i] *= al; o[1][i] *= al; lacc[i] *= al; } }
        mrun = mnew; const float sub = cadd - mnew;
#pragma unroll
        for (int i = 0; i < 16; ++i) { p0[i] = __builtin_amdgcn_exp2f(p0[i] + sub); p1[i] = __builtin_amdgcn_exp2f(p1[i] + sub); }
        if constexpr (KIND == 0) { const int w0 = (int)(mrow[2 * kt] >> (4 * hi)), w1 = (int)(mrow[2 * kt + 1] >> (4 * hi));
#pragma unroll
            for (int i = 0; i < 16; ++i) { const int bp = (i & 3) + 8 * (i >> 2); p0[i] = __int_as_float(__float_as_int(p0[i]) & __builtin_amdgcn_sbfe(w0, bp, 1)); p1[i] = __int_as_float(__float_as_int(p1[i]) & __builtin_amdgcn_sbfe(w1, bp, 1)); } }
        s16x4 vlo[4][2], vhh[4][2];
#pragma unroll
        for (int s = 0; s < 4; ++s)
#pragma unroll
            for (int db = 0; db < 2; ++db) { const LAS unsigned char* vp = Vs + db * 4096 + s * 1024 + ((lane >> 4) & 1) * 32 + (lane & 3) * 8 + (4 * hi + ((lane & 15) >> 2)) * 64; vlo[s][db] = vtr(vp); vhh[s][db] = vtr(vp + 512); }
        bf16x8 pf[4];
#pragma unroll
        for (int s = 0; s < 4; ++s) { v4u pw;
            if (s < 2) { pw.x = cvtpk(p0[8 * s], p0[8 * s + 1]); pw.y = cvtpk(p0[8 * s + 2], p0[8 * s + 3]); pw.z = cvtpk(p0[8 * s + 4], p0[8 * s + 5]); pw.w = cvtpk(p0[8 * s + 6], p0[8 * s + 7]); }
            else { pw.x = cvtpk(p1[8 * s - 16], p1[8 * s - 15]); pw.y = cvtpk(p1[8 * s - 14], p1[8 * s - 13]); pw.z = cvtpk(p1[8 * s - 12], p1[8 * s - 11]); pw.w = cvtpk(p1[8 * s - 10], p1[8 * s - 9]); }
            pf[s] = __builtin_bit_cast(bf16x8, pw); }
        __builtin_amdgcn_sched_barrier(0);
#pragma unroll
        for (int s = 0; s < 4; ++s) {
            lacc = __builtin_amdgcn_mfma_f32_32x32x16_bf16(ones, pf[s], lacc, 0, 0, 0);
#pragma unroll
            for (int db = 0; db < 2; ++db) { const bf16x8 vf = (bf16x8){vlo[s][db][0], vlo[s][db][1], vlo[s][db][2], vlo[s][db][3], vhh[s][db][0], vhh[s][db][1], vhh[s][db][2], vhh[s][db][3]};
                o[db] = __builtin_amdgcn_mfma_f32_32x32x16_bf16(vf, pf[s], o[db], 0, 0, 0); } }
        __builtin_amdgcn_sched_barrier(0); };
#if defined(PROBE_MODE) && PROBE_MODE == 3
    const bool PM_QK = true, PM_SM = !dry;
#elif defined(PROBE_MODE) && PROBE_MODE == 4
    const bool PM_QK = !dry, PM_SM = true;
#elif defined(PROBE_MODE) && PROBE_MODE == 5
    const bool PM_QK = !dry, PM_SM = !dry;
#else
    const bool PM_QK = true, PM_SM = true;
#endif
    constexpr int NOPS = (DQK == 96) ? 3 : 2;
    int cur = next_tile(kt0 - 1), n1 = cur <= kt1 ? next_tile(cur) : cur, n2 = n1 <= kt1 ? next_tile(n1) : n1;
    dmaK(cur, 0);
    if (n1 <= kt1) dmaK(n1, 1);
    dmaV(cur, 0);
    if (n2 <= kt1) { dmaK(n2, 2); dmaV(n1, 1); if (NOPS == 3) ATT_WAIT_BAR_N(3); else ATT_WAIT_BAR_N(2); }
    else { if (n1 <= kt1) dmaV(n1, 1); ATT_WAIT_BAR(); }
    int ks_cur = 0, vs_cur = 0;
    f32x16 sa0, sa1, sb0, sb1;
    { const int c0 = blk_code(cur, 0), c1 = blk_code(cur, 1); if (c0 != 3 || c1 != 3) qk(0, sa0, sa1); }
#define ATT_STEP(x0, x1, y0, y1) { \
        const int n3 = n2 <= kt1 ? next_tile(n2) : n2; \
        const int ks_n1 = ks_cur == 2 ? 0 : ks_cur + 1, vs_n2 = vs_cur == 0 ? 2 : vs_cur - 1; \
        if (n3 <= kt1) { dmaK(n3, ks_cur); dmaV(n2, vs_n2); } else if (n2 <= kt1) dmaV(n2, vs_n2); \
        const int c0 = blk_code(cur, 0), c1 = blk_code(cur, 1); \
        if (n1 <= kt1 && PM_QK) { const int e0 = blk_code(n1, 0), e1 = blk_code(n1, 1); if (e0 != 3 || e1 != 3) qk(ks_n1, y0, y1); } \
        if ((c0 != 3 || c1 != 3) && PM_SM) sm_pv(cur, vs_cur, c0, c1, x0, x1); \
        if (n3 <= kt1) { if (NOPS == 3) ATT_WAIT_BAR_N(3); else ATT_WAIT_BAR_N(2); } else ATT_WAIT_BAR(); \
        cur = n1; n1 = n2; n2 = n3; ks_cur = ks_n1; vs_cur = vs_cur == 2 ? 0 : vs_cur + 1; }
#if defined(PROBE_MODE) && PROBE_MODE == 6
    if (dry) cur = kt1 + 1;
#endif
    while (cur <= kt1) { ATT_STEP(sa0, sa1, sb0, sb1); if (cur > kt1) break; ATT_STEP(sb0, sb1, sa0, sa1); }
#undef ATT_STEP
    if (dry) Op = (bf16*)(ws + WS_END) + (size_t)(tq & 2047) * 256 + head * 64;
    const float lt = lacc[0]; const float inv = 1.0f / lt;
    if (wave_on) {
#pragma unroll
        for (int db = 0; db < 2; ++db)
#pragma unroll
            for (int k2 = 0; k2 < 2; ++k2) { v2u pa, pb; pa.x = cvtpk(o[db][8 * k2] * inv, o[db][8 * k2 + 1] * inv); pa.y = cvtpk(o[db][8 * k2 + 2] * inv, o[db][8 * k2 + 3] * inv); pb.x = cvtpk(o[db][8 * k2 + 4] * inv, o[db][8 * k2 + 5] * inv); pb.y = cvtpk(o[db][8 * k2 + 6] * inv, o[db][8 * k2 + 7] * inv);
                const v4u st = pair16(pa, pb); if (wave_on) *(v4u*)(Op + 32 * db + 16 * k2 + 8 * hi) = st; }
        if constexpr (KIND == 3) { if (hi == 0 && !dry) { const int tok = tq * dil + rr; ((float*)(ws + WS_LSED))[(size_t)(brow + tok) * 16 + u.g * 4 + head] = mrun + log2f(lt); } }
    }
    __syncthreads();
}

__device__ __forceinline__ void phase(unsigned char* ws, LAS unsigned char* lds, unsigned* queue, const bool dry = false, const unsigned kmask = 15u) {
    if (threadIdx.x == 0) ((volatile LAS unsigned*)(lds + L_MISC))[2] = __hip_atomic_fetch_add(queue, 1u, __ATOMIC_RELAXED, __HIP_MEMORY_SCOPE_AGENT);
    for (;;) {
        __syncthreads();
        const int idx = (int)((volatile LAS unsigned*)(lds + L_MISC))[2];
        __syncthreads();
        if (idx >= NU_TOTAL) break;
        const bool ahead = idx < NU_TOTAL - 512;
        const Unit u = decode(idx);
        if ((kmask >> u.kind) & 1u) {
            if (u.kind == 0) run_unit<0>(ws, lds, u, dry, queue, ahead); else if (u.kind == 1) run_unit<1>(ws, lds, u, dry, queue, ahead); else if (u.kind == 2) run_unit<2>(ws, lds, u, dry, queue, ahead); else run_unit<3>(ws, lds, u, dry, queue, ahead);
            if (!ahead && threadIdx.x == 0) ((volatile LAS unsigned*)(lds + L_MISC))[2] = __hip_atomic_fetch_add(queue, 1u, __ATOMIC_RELAXED, __HIP_MEMORY_SCOPE_AGENT);
        } else if (threadIdx.x == 0) ((volatile LAS unsigned*)(lds + L_MISC))[2] = __hip_atomic_fetch_add(queue, 1u, __ATOMIC_RELAXED, __HIP_MEMORY_SCOPE_AGENT);
    }
}
}
#ifndef SEL_NPASS
#define SEL_NPASS 4
#endif
namespace prep {
constexpr int LQ = 392, LKV = 264;
constexpr int L_CQ = 0, L_CKV = 64 * LQ * 2;
constexpr int L_MISC = 131072 - 64;
constexpr int NU_SEL = HBAT * 64, NU_MLA = MH / 64, NU_KM = HBAT * 8, NU_GEMM = MH / 256, NU_TOTAL = NU_GEMM + NU_SEL + NU_MLA + NU_KM;
__device__ __forceinline__ unsigned fkeyu(float f) { const unsigned u = __float_as_uint(f); return (u & 0x80000000u) ? ~u : (u | 0x80000000u); }

__device__ __forceinline__ void mla_unit(unsigned char* ws, LAS unsigned char* lds, int l, int unit, const float* qk_c, const unsigned pv = 0u) {
    int tid_ = threadIdx.x; asm volatile("" : "+v"(tid_));
    const int tid = tid_, lane = tid & 63, r32 = lane & 31, hi = lane >> 5, w = __builtin_amdgcn_readfirstlane(tid >> 6), row0 = unit * 64;
    { const bf16* cql = (const bf16*)(ws + WS_CQL) + (size_t)row0 * 384; const bf16* ckvl = (const bf16*)(ws + WS_CKVL) + (size_t)row0 * 256;
#pragma unroll
      for (int i = 0; i < 6; ++i) { const int c = tid + 512 * i, r = c / 48, ch = c % 48; *(LAS v4u*)(lds + L_CQ + (r * LQ + ch * 8) * 2) = *(const v4u*)(cql + (size_t)r * 384 + ch * 8); }
#pragma unroll
      for (int i = 0; i < 4; ++i) { const int c = tid + 512 * i, r = c >> 5, ch = c & 31; *(LAS v4u*)(lds + L_CKV + (r * LKV + ch * 8) * 2) = *(const v4u*)(ckvl + (size_t)r * 256 + ch * 8); } }
    __syncthreads();
    const float* ssl = (const float*)(ws + WS_SSL); const float* rope = (const float*)(ws + WS_ROPE); const bf16* xs = (const bf16*)(ws + WS_XS);
    if (w < 4) {
        const int h = w; const bf16* wt = (const bf16*)(ws + WS_WUQ) + (size_t)l * 384 * 384 + (size_t)(h * 96) * 384;
        f32x16 acc[3][2];
#pragma unroll
        for (int a = 0; a < 3; ++a)
#pragma unroll
            for (int b = 0; b < 2; ++b)
#pragma unroll
                for (int i = 0; i < 16; ++i) acc[a][b][i] = 0.f;
        bf16x8 wf[3][6];
        const bf16* wl = wt + (size_t)lane * 8;
#define MLQ_ISSUE(st, pr) { _Pragma("unroll") for (int nb = 0; nb < 3; ++nb) { \
            asm volatile("global_load_dwordx4 %0, %1, off" : "=v"(wf[st][nb]) : "v"(wl + (size_t)((2 * (pr)) * 3 + nb) * 512) : "memory"); \
            asm volatile("global_load_dwordx4 %0, %1, off" : "=v"(wf[st][3 + nb]) : "v"(wl + (size_t)((2 * (pr) + 1) * 3 + nb) * 512) : "memory"); } }
#define MLQ_COMPUTE(st, pr) { bf16x8 bfr[2], bgr[2]; \
            _Pragma("unroll") for (int tb = 0; tb < 2; ++tb) { bfr[tb] = *(const LAS bf16x8*)(lds + L_CQ + ((32 * tb + r32) * LQ + 32 * (pr) + 8 * hi) * 2); bgr[tb] = *(const LAS bf16x8*)(lds + L_CQ + ((32 * tb + r32) * LQ + 32 * (pr) + 16 + 8 * hi) * 2); } \
            _Pragma("unroll") for (int nb = 0; nb < 3; ++nb) _Pragma("unroll") for (int tb = 0; tb < 2; ++tb) acc[nb][tb] = __builtin_amdgcn_mfma_f32_32x32x16_bf16(wf[st][nb], bfr[tb], acc[nb][tb], 0, 0, 0); \
            _Pragma("unroll") for (int nb = 0; nb < 3; ++nb) _Pragma("unroll") for (int tb = 0; tb < 2; ++tb) acc[nb][tb] = __builtin_amdgcn_mfma_f32_32x32x16_bf16(wf[st][3 + nb], bgr[tb], acc[nb][tb], 0, 0, 0); }
        asm volatile("s_waitcnt vmcnt(0)" ::: "memory");
        if (!(pv & 2u)) {
        MLQ_ISSUE(0, 0); MLQ_ISSUE(1, 1);
#pragma unroll
        for (int pr = 0; pr < 12; ++pr) {
            if (pr + 2 < 12) { MLQ_ISSUE((pr + 2) % 3, pr + 2); asm volatile("s_waitcnt vmcnt(12)" ::: "memory"); }
            else if (pr + 1 < 12) asm volatile("s_waitcnt vmcnt(6)" ::: "memory"); else asm volatile("s_waitcnt vmcnt(0)" ::: "memory");
#pragma unroll
            for (int k = 0; k < 6; ++k) asm volatile("" : "+v"(wf[pr % 3][k]));
            MLQ_COMPUTE(pr % 3, pr);
        }
        }
#undef MLQ_ISSUE
#undef MLQ_COMPUTE
        bf16* QN = (bf16*)(ws + WS_QN);
        if (!(pv & 1u))
#pragma unroll
        for (int tb = 0; tb < 2; ++tb) { const int row = row0 + 32 * tb + r32, t = row % SEQ; const float* sp = ssl + (size_t)row * 16;
            const float slat = rsqrtf(((sp[0] + sp[1]) + (sp[2] + sp[3]) + (sp[4] + sp[5])) * (1.0f / 384.0f) + EPS);
            float ss = 0.f;
#pragma unroll
            for (int nb = 0; nb < 3; ++nb)
#pragma unroll
                for (int i = 0; i < 16; ++i) { const float v = acc[nb][tb][i] * slat; acc[nb][tb][i] = v; ss += v * v; }
            ss = xsum32(ss); const float hs = rsqrtf(ss * (1.0f / 96.0f) + EPS) * C2C;
#pragma unroll
            for (int nb = 0; nb < 3; ++nb)
#pragma unroll
                for (int i = 0; i < 16; ++i) acc[nb][tb][i] *= hs * qk_c[32 * nb + att::crow(i, hi)];
#pragma unroll
            for (int i = 0; i < 8; ++i) { const int j = att::crow(i, hi); const float c = rope[t * 16 + j], s = rope[SEQ * 16 + t * 16 + j]; const float x1 = acc[2][tb][i], x2 = acc[2][tb][i + 8]; acc[2][tb][i] = x1 * c - x2 * s; acc[2][tb][i + 8] = x1 * s + x2 * c; }
#pragma unroll
            for (int nb = 0; nb < 3; ++nb)
#pragma unroll
                for (int k2 = 0; k2 < 2; ++k2) { v2u pa, pb; pa.x = pk2(acc[nb][tb][8 * k2], acc[nb][tb][8 * k2 + 1]); pa.y = pk2(acc[nb][tb][8 * k2 + 2], acc[nb][tb][8 * k2 + 3]); pb.x = pk2(acc[nb][tb][8 * k2 + 4], acc[nb][tb][8 * k2 + 5]); pb.y = pk2(acc[nb][tb][8 * k2 + 6], acc[nb][tb][8 * k2 + 7]);
                    *(v4u*)(QN + (size_t)row * 384 + h * 96 + 32 * nb + 16 * k2 + 8 * hi) = pair16(pa, pb); } }
    } else {
        const int h = w - 4; const bf16* wt = (const bf16*)(ws + WS_WUKV) + (size_t)l * 512 * 256 + (size_t)(h * 128) * 256;
        f32x16 acc[4][2];
#pragma unroll
        for (int a = 0; a < 4; ++a)
#pragma unroll
            for (int b = 0; b < 2; ++b)
#pragma unroll
                for (int i = 0; i < 16; ++i) acc[a][b][i] = 0.f;
        bf16x8 wf[4][4];
        const bf16* wl = wt + (size_t)lane * 8;
#define MLK_ISSUE(st, ks) { _Pragma("unroll") for (int nb = 0; nb < 4; ++nb) asm volatile("global_load_dwordx4 %0, %1, off" : "=v"(wf[st][nb]) : "v"(wl + (size_t)((ks) * 4 + nb) * 512) : "memory"); }
        asm volatile("s_waitcnt vmcnt(0)" ::: "memory");
        if (!(pv & 2u)) {
        MLK_ISSUE(0, 0); MLK_ISSUE(1, 1); MLK_ISSUE(2, 2);
#pragma unroll
        for (int ks = 0; ks < 16; ++ks) {
            if (ks + 3 < 16) { MLK_ISSUE((ks + 3) % 4, ks + 3); asm volatile("s_waitcnt vmcnt(12)" ::: "memory"); }
            else if (ks + 2 < 16) asm volatile("s_waitcnt vmcnt(8)" ::: "memory"); else if (ks + 1 < 16) asm volatile("s_waitcnt vmcnt(4)" ::: "memory"); else asm volatile("s_waitcnt vmcnt(0)" ::: "memory");
#pragma unroll
            for (int k = 0; k < 4; ++k) asm volatile("" : "+v"(wf[ks % 4][k]));
            bf16x8 bfr[2];
#pragma unroll
            for (int tb = 0; tb < 2; ++tb) bfr[tb] = *(const LAS bf16x8*)(lds + L_CKV + ((32 * tb + r32) * LKV + 16 * ks + 8 * hi) * 2);
#pragma unroll
            for (int nb = 0; nb < 4; ++nb)
#pragma unroll
                for (int tb = 0; tb < 2; ++tb) acc[nb][tb] = __builtin_amdgcn_mfma_f32_32x32x16_bf16(wf[ks % 4][nb], bfr[tb], acc[nb][tb], 0, 0, 0);
        }
        }
#undef MLK_ISSUE
        bf16* KN = (bf16*)(ws + WS_KN); bf16* VC = (bf16*)(ws + WS_VC);
        if (!(pv & 1u))
#pragma unroll
        for (int tb = 0; tb < 2; ++tb) { const int row = row0 + 32 * tb + r32, t = row % SEQ; const float* sp = ssl + (size_t)row * 16;
            const float slat = rsqrtf(((sp[6] + sp[7]) + (sp[8] + sp[9])) * (1.0f / 256.0f) + EPS);
            float kr[16]; float ss = 0.f;
#pragma unroll
            for (int g4 = 0; g4 < 4; ++g4) { const v2u v = *(const v2u*)(xs + (size_t)row * 128 + 32 + 8 * g4 + 4 * hi); kr[4 * g4] = __uint_as_float(v.x << 16); kr[4 * g4 + 1] = __uint_as_float(v.x & 0xffff0000u); kr[4 * g4 + 2] = __uint_as_float(v.y << 16); kr[4 * g4 + 3] = __uint_as_float(v.y & 0xffff0000u); }
#pragma unroll
            for (int i = 0; i < 16; ++i) ss += kr[i] * kr[i];
#pragma unroll
            for (int nb = 0; nb < 2; ++nb)
#pragma unroll
                for (int i = 0; i < 16; ++i) { const float v = acc[nb][tb][i] * slat; acc[nb][tb][i] = v; ss += v * v; }
            ss = xsum32(ss); const float hs = rsqrtf(ss * (1.0f / 96.0f) + EPS);
#pragma unroll
            for (int nb = 0; nb < 2; ++nb)
#pragma unroll
                for (int i = 0; i < 16; ++i) acc[nb][tb][i] *= hs * qk_c[96 + 32 * nb + att::crow(i, hi)];
#pragma unroll
            for (int i = 0; i < 16; ++i) kr[i] *= hs * qk_c[96 + 64 + att::crow(i, hi)];
#pragma unroll
            for (int i = 0; i < 8; ++i) { const int j = att::crow(i, hi); const float c = rope[t * 16 + j], s = rope[SEQ * 16 + t * 16 + j]; const float x1 = kr[i], x2 = kr[i + 8]; kr[i] = x1 * c - x2 * s; kr[i + 8] = x1 * s + x2 * c; }
#pragma unroll
            for (int k2 = 0; k2 < 2; ++k2) {
#pragma unroll
                for (int nb = 0; nb < 2; ++nb) { v2u pa, pb; pa.x = pk2(acc[nb][tb][8 * k2], acc[nb][tb][8 * k2 + 1]); pa.y = pk2(acc[nb][tb][8 * k2 + 2], acc[nb][tb][8 * k2 + 3]); pb.x = pk2(acc[nb][tb][8 * k2 + 4], acc[nb][tb][8 * k2 + 5]); pb.y = pk2(acc[nb][tb][8 * k2 + 6], acc[nb][tb][8 * k2 + 7]);
                    *(v4u*)(KN + (size_t)row * 384 + h * 96 + 32 * nb + 16 * k2 + 8 * hi) = pair16(pa, pb); }
                { v2u pa, pb; pa.x = pk2(kr[8 * k2], kr[8 * k2 + 1]); pa.y = pk2(kr[8 * k2 + 2], kr[8 * k2 + 3]); pb.x = pk2(kr[8 * k2 + 4], kr[8 * k2 + 5]); pb.y = pk2(kr[8 * k2 + 6], kr[8 * k2 + 7]);
                    *(v4u*)(KN + (size_t)row * 384 + h * 96 + 64 + 16 * k2 + 8 * hi) = pair16(pa, pb); }
#pragma unroll
                for (int nb = 2; nb < 4; ++nb) { v2u pa, pb; pa.x = pk2(acc[nb][tb][8 * k2] * slat, acc[nb][tb][8 * k2 + 1] * slat); pa.y = pk2(acc[nb][tb][8 * k2 + 2] * slat, acc[nb][tb][8 * k2 + 3] * slat); pb.x = pk2(acc[nb][tb][8 * k2 + 4] * slat, acc[nb][tb][8 * k2 + 5] * slat); pb.y = pk2(acc[nb][tb][8 * k2 + 6] * slat, acc[nb][tb][8 * k2 + 7] * slat);
                    *(v4u*)(VC + (size_t)row * 256 + h * 64 + 32 * (nb - 2) + 16 * k2 + 8 * hi) = pair16(pa, pb); } } }
    }
    __syncthreads();
}

__device__ __forceinline__ void sel_unit(unsigned char* ws, LAS unsigned char* lds, int unit, const int npass = 4, const bool ties = true, const bool force_simple = false) {
    int tid_ = threadIdx.x; asm volatile("" : "+v"(tid_));
    const int tid = tid_, lane = tid & 63, c16 = lane & 15, g = lane >> 4, w = __builtin_amdgcn_readfirstlane(tid >> 6);
    const int b = unit & 7, qblk = 63 - (unit >> 3), t0 = 32 * qblk + 4 * w, brow = b * SEQ;
    const bf16* t1 = (const bf16*)(ws + WS_R) + (size_t)1 * MH * 256; const bf16* xs = (const bf16*)(ws + WS_XS) + (size_t)brow * 128; const float* iwf = (const float*)(ws + WS_IWF);
    const int tq = t0 + g;
    const int nkt = (t0 + 3) / 16 + 1;
    const bf16x8 af = *(const bf16x8*)(t1 + (size_t)(brow + t0 + (c16 >> 2)) * 256 + 128 + (c16 & 3) * 32 + 8 * g);
    const f32x4 wv = *(const f32x4*)(iwf + (size_t)(brow + tq) * 4);
    constexpr float WS_ = 0.5f * 0.17677669529663687f;
    const float w0 = wv[0] * WS_, w1 = wv[1] * WS_, w2 = wv[2] * WS_, w3 = wv[3] * WS_;
    unsigned key[128];
    const int nblk = (nkt + 15) >> 4;
    const bf16* xsl = xs + (size_t)c16 * 128 + 8 * g;
#pragma unroll
    for (int blk = 0; blk < 8; ++blk) {
        if (blk < nblk) {
            bf16x8 bc[16];
#pragma unroll
            for (int rr = 0; rr < 16; ++rr) bc[rr] = *(const bf16x8*)(xsl + (size_t)(16 * (16 * blk + rr)) * 128);
            __builtin_amdgcn_sched_barrier(0);
#pragma unroll
            for (int rr = 0; rr < 16; ++rr) { const int r = 16 * blk + rr;
                pg8::f32x4 cz = {0.f, 0.f, 0.f, 0.f}; const pg8::f32x4 d = __builtin_amdgcn_mfma_f32_16x16x32_bf16(af, bc[rr], cz, 0, 0, 0);
                const float sc = __builtin_fmaf(fmaxf(d[3], 0.f), w3, __builtin_fmaf(fmaxf(d[2], 0.f), w2, __builtin_fmaf(fmaxf(d[1], 0.f), w1, fmaxf(d[0], 0.f) * w0)));
                key[r] = (16 * r + c16 <= tq) ? fkeyu(sc) : 0u; }
            __builtin_amdgcn_sched_barrier(0);
        } else {
#pragma unroll
            for (int rr = 0; rr < 16; ++rr) key[16 * blk + rr] = 0u;
        }
    }
    LAS unsigned* H = (LAS unsigned*)(lds + w * 4608) + g * 272;
    unsigned prefix = 0u; int rank = 256;
#pragma unroll 1
    for (int pass = 0; pass < npass; ++pass) { const int shift = 24 - 8 * pass;
#pragma unroll
        for (int j = 0; j < 4; ++j) *(LAS v4u*)(H + 16 * c16 + 4 * j) = (v4u){0u, 0u, 0u, 0u};
        H[256 + c16] = 0u;
        const unsigned hp = pass == 0 ? 0u : (prefix >> ((shift + 8) & 31)); const unsigned hmask = pass == 0 ? 0u : 0xffffffffu;
#pragma unroll
        for (int blk = 0; blk < 8; ++blk) if (blk < nblk) {
#pragma unroll
            for (int rr = 0; rr < 16; ++rr) { const unsigned k = key[16 * blk + rr]; const bool mt = (((k >> ((shift + 8) & 31)) & hmask) == hp); const unsigned bin = mt ? ((k >> shift) & 255u) : (unsigned)(256 + c16);
                (void)__hip_atomic_fetch_add(H + bin, 1u, __ATOMIC_RELAXED, __HIP_MEMORY_SCOPE_WORKGROUP); } }
        unsigned hv[16];
#pragma unroll
        for (int j = 0; j < 4; ++j) { const v4u t = *(const LAS v4u*)(H + 16 * c16 + 4 * j); hv[4 * j] = t[0]; hv[4 * j + 1] = t[1]; hv[4 * j + 2] = t[2]; hv[4 * j + 3] = t[3]; }
        int sc = 0;
#pragma unroll
        for (int j = 0; j < 16; ++j) sc += (int)hv[j];
        int suf = sc;
#pragma unroll
        for (int d = 1; d < 16; d <<= 1) { const int o = bperm_i(lane + d, suf); if (c16 + d < 16) suf += o; }
        const int above_lane = suf - sc;
        const bool cross = (above_lane < rank) && (rank <= suf);
        int B = 0, above = 0;
        if (cross) { int run2 = above_lane; bool found = false;
#pragma unroll
            for (int j = 15; j >= 0; --j) { if (!found) { if (run2 + (int)hv[j] >= rank) { B = 16 * c16 + j; above = run2; found = true; } else run2 += (int)hv[j]; } } }
        const unsigned m16 = (unsigned)(__ballot(cross) >> (16 * g)) & 0xffffu;
        const int src = m16 ? (__ffs(m16) - 1) : 0;
        B = bperm_i((lane & 48) + src, B); above = bperm_i((lane & 48) + src, above);
        if (!m16) { B = 0; above = 0; }
        prefix |= (unsigned)B << shift; rank -= above;
    }
    const unsigned T = prefix; const int need = rank;
    unsigned long long mw0 = 0ull, mw1 = 0ull;
    const int cnt_eq = npass > 0 ? (int)H[T & 255u] : 0;
    const bool simple = (__all(cnt_eq == need && T != 0u) && ties) || force_simple;
    if (simple) {
#pragma unroll
        for (int blk = 0; blk < 8; ++blk) if (blk < nblk) {
#pragma unroll
            for (int rr = 0; rr < 16; ++rr) { const int r = 16 * blk + rr; const unsigned long long bs = __ballot(key[r] >= T);
                if (r < 64) mw0 = (lane == r) ? bs : mw0; else mw1 = (lane == r - 64) ? bs : mw1; } }
    } else {
        int run = 0;
#pragma unroll
        for (int blk = 0; blk < 8; ++blk) if (blk < nblk) {
#pragma unroll
            for (int rr = 0; rr < 16; ++rr) { const int r = 16 * blk + rr;
                const bool eq = key[r] == T; const unsigned long long bal = __ballot(eq); const unsigned m16 = (unsigned)(bal >> (16 * g)) & 0xffffu;
                const int rk = run + __popc(m16 & ((1u << c16) - 1u)); run += __popc(m16);
                const unsigned long long bs = __ballot((key[r] > T || (eq && rk < need)) && (16 * r + c16 <= tq));
                if (r < 64) mw0 = (lane == r) ? bs : mw0; else mw1 = (lane == r - 64) ? bs : mw1; } }
    }
    unsigned long long* mq = (unsigned long long*)(ws + WS_MASK) + (size_t)((brow + t0) >> 2) * 128;
    mq[lane] = mw0; mq[64 + lane] = mw1;
}
__device__ __forceinline__ void km_unit(unsigned char* ws, LAS unsigned char* lds, int unit) {
    int tid_ = threadIdx.x; asm volatile("" : "+v"(tid_)); const int tid = tid_, lane = tid & 63, w = tid >> 6; const int b = unit >> 3, n = unit & 7;
    const bf16* bk = (const bf16*)(ws + WS_R) + (size_t)6 * MH * 256 + (size_t)(b * SEQ + n * 256 + 32 * w) * 256 + 4 * lane;
    v2u v[32];
#pragma unroll
    for (int i = 0; i < 32; ++i) v[i] = *(const v2u*)(bk + (size_t)i * 256);
    float s0 = 0.f, s1 = 0.f, s2 = 0.f, s3 = 0.f;
#pragma unroll
    for (int i = 0; i < 32; ++i) { s0 += __uint_as_float(v[i].x << 16); s1 += __uint_as_float(v[i].x & 0xffff0000u); s2 += __uint_as_float(v[i].y << 16); s3 += __uint_as_float(v[i].y & 0xffff0000u); }
    LAS f32x4* red = (LAS f32x4*)lds; red[w * 64 + lane] = (f32x4){s0, s1, s2, s3};
    __syncthreads();
    if (w == 0) { f32x4 t = red[lane];
#pragma unroll
        for (int k = 1; k < 8; ++k) t += red[k * 64 + lane];
        *(f32x4*)((float*)(ws + WS_KMEAN) + (size_t)unit * 256 + 4 * lane) = t * (1.0f / 256.0f); }
    __syncthreads();
}
struct OneUnit { int pm, pn;
    __device__ __forceinline__ bool next(int i, pg8::Unit& u) const { if (i > 0) return false; u.pm = pm; u.pn = pn; u.ao = 0; u.bo = 0; return true; }
    __device__ __forceinline__ void a_ready(const pg8::Unit&) const {}
    __device__ __forceinline__ void done(const pg8::Unit&) const {} };
__device__ __forceinline__ void phase(unsigned char* ws, LAS unsigned char* lds, int l, const float* qk_c, unsigned* queue, const pg8::Gemm& gg, const EpiInProj& ge, const unsigned kmask = 15u) {
    for (;;) {
        if (threadIdx.x == 0) ((volatile LAS unsigned*)(lds + L_MISC))[0] = __hip_atomic_fetch_add(queue, 1u, __ATOMIC_RELAXED, __HIP_MEMORY_SCOPE_AGENT);
        __syncthreads();
        const int idx = (int)((volatile LAS unsigned*)(lds + L_MISC))[0];
        __syncthreads();
        if (idx >= NU_TOTAL) break;
        if (idx < NU_SEL / 2) { if (kmask & 2u) sel_unit(ws, lds, idx, (kmask & 16u) ? 0 : 4, !(kmask & 32u), (kmask & 64u) != 0u); }
        else if (idx < NU_SEL / 2 + NU_GEMM) { if (kmask & 8u) { OneUnit S1{idx - NU_SEL / 2, NT_IN - 1}; pg8::gemm_phase<EpiInProj, OneUnit, true, true>(lds, gg, S1, ge); __syncthreads(); } }
        else if (idx < NU_SEL / 2 + NU_GEMM + NU_MLA) { if (kmask & 4u) mla_unit(ws, lds, l, idx - NU_SEL / 2 - NU_GEMM, qk_c, kmask >> 7); }
        else if (idx < NU_SEL + NU_GEMM + NU_MLA) { if (kmask & 2u) sel_unit(ws, lds, idx - NU_GEMM - NU_MLA, (kmask & 16u) ? 0 : 4, !(kmask & 32u), (kmask & 64u) != 0u); }
        else { if (kmask & 1u) km_unit(ws, lds, idx - NU_SEL - NU_GEMM - NU_MLA); }
    }
}
}
constexpr int RING_BYTES = 131072, MISC_OFF = RING_BYTES + 320, LDS_BYTES = 147456;
#define LDS_WAIT() asm volatile("s_waitcnt lgkmcnt(0)" ::: "memory")
#define VM_WAIT() asm volatile("s_waitcnt vmcnt(0)" ::: "memory")

template <class CM> __device__ __forceinline__ void tr_item(const float* W, int ldw, int K, const float* rowgain, bf16* WT, int nblk, int item, LAS float* scr, int lane, CM cm) {
    const int kb = item / nblk, nb = item % nblk, k0 = 64 * kb, n0 = 32 * nb;
    const int sc = cm(n0 + (lane & 31));
    float tv[32];
#pragma unroll
    for (int i = 0; i < 32; ++i) { const int kk = 2 * i + (lane >> 5); tv[i] = sc >= 0 ? W[(size_t)(k0 + kk) * ldw + sc] : 0.f; }
#pragma unroll
    for (int i = 0; i < 32; ++i) { const int kk = 2 * i + (lane >> 5); float v = tv[i]; if (rowgain) v *= rowgain[k0 + kk]; scr[kk * 33 + (lane & 31)] = v; }
    LDS_WAIT(); asm volatile("" ::: "memory");
    const int c = lane & 7;
#pragma unroll
    for (int j = 0; j < 4; ++j) { const int n = (lane >> 3) + 8 * j; const LAS float* s = scr + (8 * c) * 33 + n;
        v4u o; o.x = pk2(s[0 * 33], s[1 * 33]); o.y = pk2(s[2 * 33], s[3 * 33]); o.z = pk2(s[4 * 33], s[5 * 33]); o.w = pk2(s[6 * 33], s[7 * 33]);
        *(v4u*)(WT + (size_t)(n0 + n) * K + k0 + 8 * c) = o; }
    LDS_WAIT(); asm volatile("" ::: "memory");
}
struct CmId { __device__ __forceinline__ int operator()(int n) const { return n; } };
struct CmFfnIn { __device__ __forceinline__ int operator()(int n) const { const int pn = n >> 8, c = n & 255; return c < 128 ? pn * 128 + c : DFF + pn * 128 + (c - 128); } };
struct CmInProj { __device__ __forceinline__ int operator()(int n) const { return inproj_srccol(n); } };
__device__ __forceinline__ int rel_bucket_dev(int n) { if (n < 16) return n; const int lb = 16 + (int)(logf((float)n / 16.f) / logf(128.f) * 16.f); return lb < 31 ? lb : 31; }

__device__ __forceinline__ void prologue(const Args& a, LAS unsigned char* lds, int vcu, int G, int wave, int lane) {
    unsigned char* ws = a.ws;
    LAS float* scr = (LAS float*)(lds + wave * 16384);
    const int gw = vcu * NWAVES + wave, NGW = G * NWAVES;
    const float* norm_gain = a.in[1]; const float* w_in = a.in[2]; const float* mla_nq = a.in[8]; const float* w_uq = a.in[9]; const float* mla_nkv = a.in[10]; const float* w_ukv = a.in[11];
    const float* w_branch = a.in[12]; const float* w_out = a.in[13]; const float* rel_bias = a.in[14]; const float* w_ffn_in = a.in[15]; const float* w_ffn_out = a.in[16];
    constexpr int I_FI = 16 * (5632 / 32), I_FO = 44 * 32, I_IN = 16 * (N_INP / 32), I_O = 16 * 32, I_B = 4 * 32, I_UQ = 6 * 12, I_UKV = 4 * 16;
    constexpr int NITEMS = 4 * I_FI + 4 * I_FO + 2 * I_IN + 2 * I_O + 8 * I_B; (void)I_UQ; (void)I_UKV;
    for (int it = gw; it < NITEMS; it += NGW) {
        int r = it;
        if (r < 4 * I_FI) { const int w = r / I_FI, l = w >> 1, f = w & 1; tr_item(w_ffn_in + (size_t)w * DM * 2 * DFF, 2 * DFF, DM, norm_gain + (l * 3 + (f ? 2 : 0)) * DM, (bf16*)(ws + WS_WFI) + (size_t)w * 5632 * DM, 5632 / 32, r % I_FI, scr, lane, CmFfnIn()); continue; } r -= 4 * I_FI;
        if (r < 4 * I_FO) { const int w = r / I_FO; tr_item(w_ffn_out + (size_t)w * DFF * DM, DM, DFF, nullptr, (bf16*)(ws + WS_WFO) + (size_t)w * DM * DFF, 32, r % I_FO, scr, lane, CmId()); continue; } r -= 4 * I_FO;
        if (r < 2 * I_IN) { const int l = r / I_IN; tr_item(w_in + (size_t)l * DM * INW, INW, DM, norm_gain + (l * 3 + 1) * DM, (bf16*)(ws + WS_WIN) + (size_t)l * N_INP * DM, N_INP / 32, r % I_IN, scr, lane, CmInProj()); continue; } r -= 2 * I_IN;
        if (r < 2 * I_O) { const int l = r / I_O; tr_item(w_out + (size_t)l * DM * DM, DM, DM, nullptr, (bf16*)(ws + WS_WO) + (size_t)l * DM * DM, 32, r % I_O, scr, lane, CmId()); continue; } r -= 2 * I_O;
        if (r < 8 * I_B) { const int w = r / I_B; tr_item(w_branch + (size_t)w * 256 * DM, DM, 256, nullptr, (bf16*)(ws + WS_WB) + (size_t)w * DM * 256, 32, r % I_B, scr, lane, CmId()); continue; } r -= 8 * I_B;
    }
    const float* x = a.in[0]; bf16* xb = (bf16*)(ws + WS_XB); float* ssq = (float*)(ws + WS_SSQ);
    for (int m0 = gw; m0 < M; m0 += 2 * NGW) {
        f32x4 v[2][4]; float sacc[2] = {0.f, 0.f};
#pragma unroll
        for (int r = 0; r < 2; ++r) { const int m = m0 + r * NGW; if (m < M) { const f32x4* xr = (const f32x4*)(x + (size_t)m * DM) + lane;
#pragma unroll
                for (int j = 0; j < 4; ++j) v[r][j] = xr[64 * j]; } }
#pragma unroll
        for (int r = 0; r < 2; ++r) { const int m = m0 + r * NGW; if (m < M) { unsigned long long* o8 = (unsigned long long*)(xb + (size_t)m * DM) + lane;
#pragma unroll
                for (int j = 0; j < 4; ++j) { const f32x4 t = v[r][j]; o8[64 * j] = (unsigned long long)pk2(t[0], t[1]) | ((unsigned long long)pk2(t[2], t[3]) << 32);
                    sacc[r] += (t[0] * t[0] + t[1] * t[1]) + (t[2] * t[2] + t[3] * t[3]); } } }
#pragma unroll
        for (int r = 0; r < 2; ++r) { const int m = m0 + r * NGW; float s = sacc[r];
            s += bperm_f(lane ^ 1, s); s += bperm_f(lane ^ 2, s); s += bperm_f(lane ^ 4, s); s += bperm_f(lane ^ 8, s); s += bperm_f(lane ^ 16, s); s = xsum32(s);
            if (m < M && lane < 16) ssq[(size_t)m * 16 + lane] = lane == 0 ? s : 0.f; }
    }
    const int gt = gw * 64 + lane, NGT = NGW * 64;
    for (int i = gt; i < 2 * 4 * 24 * 3 * 64; i += NGT) { const int ln = i & 63, nb = (i >> 6) % 3, s = ((i >> 6) / 3) % 24, h = ((i >> 6) / 72) & 3, l = (i >> 6) / 288; const int n = 96 * h + 32 * nb + (ln & 31), k0 = 16 * s + 8 * (ln >> 5);
        float v[8];
#pragma unroll
        for (int j = 0; j < 8; ++j) v[j] = w_uq[(size_t)l * 384 * 384 + (size_t)(k0 + j) * 384 + n] * mla_nq[l * 384 + k0 + j];
        v4u o; o.x = pk2(v[0], v[1]); o.y = pk2(v[2], v[3]); o.z = pk2(v[4], v[5]); o.w = pk2(v[6], v[7]); *(v4u*)(ws + WS_WUQ + (size_t)i * 16) = o; }
    for (int i = gt; i < 2 * 4 * 16 * 4 * 64; i += NGT) { const int ln = i & 63, nb = (i >> 6) & 3, s = (i >> 8) & 15, h = (i >> 12) & 3, l = i >> 14; const int n = 128 * h + 32 * nb + (ln & 31), k0 = 16 * s + 8 * (ln >> 5);
        float v[8];
#pragma unroll
        for (int j = 0; j < 8; ++j) v[j] = w_ukv[(size_t)l * 256 * 512 + (size_t)(k0 + j) * 512 + n] * mla_nkv[l * 256 + k0 + j];
        v4u o; o.x = pk2(v[0], v[1]); o.y = pk2(v[2], v[3]); o.z = pk2(v[4], v[5]); o.w = pk2(v[6], v[7]); *(v4u*)(ws + WS_WUKV + (size_t)i * 16) = o; }
    float* bias = (float*)(ws + WS_BIAS); float* biasd = (float*)(ws + WS_BIASD); float* rope = (float*)(ws + WS_ROPE);
    for (int i = gt; i < 20 * 2112; i += NGT) { const int h = i / 2112, d = i % 2112 - 64; bias[i] = d >= 0 ? rel_bias[h * 32 + rel_bucket_dev(d)] * LOG2E : 0.f; }
    for (int i = gt; i < 12 * 192; i += NGT) { const int gh = i / 192, sd = i % 192, g = gh >> 2, dil = g == 0 ? 1 : g == 1 ? 4 : 16; const int d = sd * dil; biasd[i] = (sd <= 128) ? rel_bias[(8 + gh) * 32 + rel_bucket_dev(d)] * LOG2E : 0.f; }
    { unsigned char* bid = ws + WS_BID; for (int i = gt; i < 2112; i += NGT) { const int d = i - 64; bid[i] = (unsigned char)(d >= 0 ? rel_bucket_dev(d) : 0); } }
    for (int i = gt; i < SEQ * 16; i += NGT) { const int t = i >> 4, j = i & 15; const float fr = powf(10000.f, -(float)j / 16.f), ang = (float)t * fr; rope[i] = cosf(ang); rope[SEQ * 16 + i] = sinf(ang); }
}

typedef __attribute__((address_space(4))) const Args KArgs;
__global__ void __launch_bounds__(NTHR, 2) mega(Args args) {
    extern __shared__ __attribute__((aligned(16))) unsigned char lds_raw[];
    LAS unsigned char* lds0 = (LAS unsigned char*)lds_raw; LAS unsigned char* lds = lds0;
    volatile LAS unsigned* MISC = (volatile LAS unsigned*)(lds + MISC_OFF);
    const int tid = threadIdx.x, lane = tid & 63, wave = __builtin_amdgcn_readfirstlane(tid >> 6);
    const int G = gridDim.x; const int bx = blockIdx.x; const int vcu = (G % 8 == 0) ? (bx % 8) * (G / 8) + bx / 8 : bx;
    unsigned char* const ws0 = args.ws; unsigned char* ws = ws0; unsigned* ctl = (unsigned*)(ws + WS_CTL);
    for (int u = tid; u < (LDS_BYTES - RING_BYTES) / 4; u += NTHR) ((LAS unsigned*)(lds + RING_BYTES))[u] = 0u;
    __syncthreads();
    XcdBarrier bar = xcd_barrier_post(ctl + CW_BAR, MISC + 8);
    const int lo = args.ph_lo, hi = args.ph_hi;
#ifdef PROBE_T
    if (threadIdx.x == 0) { volatile LAS unsigned long long* pt_ = (volatile LAS unsigned long long*)(lds0 + 131072 + 2048); pt_[0] = 0ull; pt_[1] = __builtin_amdgcn_s_memrealtime(); }
#endif
#define IN(k) (lo <= (k) && (k) < hi)
#define PHASE_LOCALS LAS unsigned char* lds = lds0; const KArgs* ap = (const KArgs*)__builtin_amdgcn_kernarg_segment_ptr(); asm volatile("" : "+s"(lds), "+s"(ap)); unsigned char* ws = ap->ws;
#ifdef PROBE_BAR
#define SEAM(k) do { if (IN(k) && IN((k) + 1)) { xcd_barrier(bar); xcd_barrier(bar); } } while (0)
#else
#ifdef PROBE_T
#define PTICK(k) do { if (threadIdx.x == 0) { volatile LAS unsigned long long* pt_ = (volatile LAS unsigned long long*)(lds0 + 131072 + 2048); const unsigned long long n_ = __builtin_amdgcn_s_memrealtime(); \
        int c_ = 8; if ((k) == PH_PRO) c_ = 0; else { int r_ = ((k) - PH_L0) % PH_PER_LAYER; if (r_ == 0 || r_ == 14) c_ = 1; else if (r_ == 1 || r_ == 15) c_ = 2; else { r_ = (r_ - 2) % 6; c_ = r_ == 0 ? 3 : r_ == 1 ? 4 : r_ == 2 ? 5 : r_ == 4 ? 6 : r_ == 5 ? 7 : 8; } } \
        if (c_ == PROBE_T || PROBE_T == 99) pt_[0] += n_ - pt_[1]; pt_[1] = n_; } } while (0)
#else
#define PTICK(k) do {} while (0)
#endif
#define SEAM(k) do { if (IN(k) && IN((k) + 1)) xcd_barrier(bar); PTICK(k); } while (0)
#endif
    #ifndef NOPRO
    if (IN(PH_PRO)) { PHASE_LOCALS; (void)ws; (void)ap; prologue(args, lds, vcu, G, wave, lane); }
#ifdef PROBE_PRO2
    if (IN(PH_PRO)) { xcd_barrier(bar); PHASE_LOCALS; (void)ws; prologue(args, lds, vcu, G, wave, lane); xcd_barrier(bar); prologue(args, lds, vcu, G, wave, lane); xcd_barrier(bar); prologue(args, lds, vcu, G, wave, lane); }
#endif
#endif
    SEAM(PH_PRO);
    for (int l = 0; l < DEPTH; ++l) {
        const int pb = PH_L0 + l * PH_PER_LAYER;
#pragma unroll 1
        for (int f = 0; f < 2; ++f) {
            if (f == 1) {
#pragma unroll 1
                for (int hf = 0; hf < 2; ++hf) {
                    const int ph = pb + PO_INP + 6 * hf;
#ifndef NOINP
                    if (IN(ph)) {
                        PHASE_LOCALS; bf16* const xb = (bf16*)(ws + WS_XB); float* const ssq = (float*)(ws + WS_SSQ);
                        pg8::Gemm g{xb + (size_t)hf * MH * DM, (const bf16*)(ws + WS_WIN) + (size_t)l * N_INP * DM, MH, N_INP - 256, DM}; pg8::StaticOrder S; S.init(MH, N_INP - 256, G, bx, WGM_INP);
                        EpiInProj E{ssq + (size_t)hf * MH * 16, ws, ap->in[4] + l * 128, ap->in[5] + l * 128, ap->in[7] + l * 128, ap->in[3] + (size_t)l * 4 * DM};
#ifdef SKEW_TICKS
                        { const unsigned long long t0_ = __builtin_amdgcn_s_memrealtime(), d_ = (unsigned long long)((bx & 7) * SKEW_TICKS); while (__builtin_amdgcn_s_memrealtime() - t0_ < d_) __builtin_amdgcn_s_sleep(1); }
#endif
                        pg8::gemm_phase<EpiInProj, pg8::StaticOrder, true, true>(lds, g, S, E);
#ifdef PROBE_INP2
                        xcd_barrier(bar); pg8::gemm_phase<EpiInProj, pg8::StaticOrder, true, true>(lds, g, S, E);
#endif
                    }
#endif
                    SEAM(ph);
#ifndef NOPREP
                    if (IN(ph + 1)) { PHASE_LOCALS; bf16* const xb = (bf16*)(ws + WS_XB); float* const ssq = (float*)(ws + WS_SSQ); int kq = DM; asm volatile("" : "+s"(kq));
                        pg8::Gemm gg{xb + (size_t)hf * MH * DM, (const bf16*)(ws + WS_WIN) + (size_t)l * N_INP * DM, MH, N_INP, kq};
                        EpiInProj ge{ssq + (size_t)hf * MH * 16, ws, ap->in[4] + l * 128, ap->in[5] + l * 128, ap->in[7] + l * 128, ap->in[3] + (size_t)l * 4 * DM};
#ifdef PROBE_PREP3
                        { unsigned pk_ = PROBE_PREP3; asm volatile("" : "+s"(pk_)); prep::phase(ws, lds, l, ap->in[6] + l * 192, (unsigned*)(ws + WS_CTL) + CW_QUEUE + 64 * (16 + l * 2 + hf), gg, ge, pk_); xcd_barrier(bar); }
#endif
                        prep::phase(ws, lds, l, ap->in[6] + l * 192, (unsigned*)(ws + WS_CTL) + CW_QUEUE + 64 * (8 + l * 2 + hf), gg, ge);
                    }
#ifdef PROBE_PREP2_OLD
                    if (IN(ph + 1)) { xcd_barrier(bar); PHASE_LOCALS; prep::phase(ws, lds, l, ap->in[6] + l * 192, (unsigned*)(ws + WS_CTL) + CW_QUEUE + 64 * (16 + l * 2 + hf), gg, ge, PROBE_PREP2); }
#endif
#endif
                    SEAM(ph + 1);
#ifdef PROBE_ATT2
                    if (IN(ph + 2)) { PHASE_LOCALS; att::phase(ws, lds, (unsigned*)(ws + WS_CTL) + CW_QUEUE + 64 * (24 + l * 2 + hf), true, PROBE_ATT2); xcd_barrier(bar); }
#endif
                    if (IN(ph + 2)) { PHASE_LOCALS; att::phase(ws, lds, (unsigned*)(ws + WS_CTL) + CW_QUEUE + 64 * (l * 2 + hf)); }
                    SEAM(ph + 2);
                    if (IN(ph + 4)) {
                        PHASE_LOCALS;
                        int kq = 256; asm volatile("" : "+s"(kq));
                        pg8::Gemm g{(const bf16*)(ws + WS_R), (const bf16*)(ws + WS_WB) + (size_t)l * 4 * DM * 256, MH, DM, kq};
                        MergeOrder S; S.S.init(MH, DM, G, bx); S.a1 = (int)(5 * TILE_B); S.a2 = (int)(WS_OC - WS_R); S.a3 = (int)(WS_DC - WS_R);
                        unsigned* cnt = (unsigned*)(ws + WS_CTL) + CW_SEAM + (l * 2 + hf) * 64 * 64; S.ready = cnt; S.tmo = (unsigned*)(ws + WS_CTL) + 2;
                        {
                            const bf16* tiles = (const bf16*)(ws + WS_R); const float* lse = (const float*)(ws + WS_LSED); bf16* dc = (bf16*)(ws + WS_DC);
                            int tid_ = threadIdx.x; asm volatile("" : "+v"(tid_)); const int ln = tid_ & 63, wv = tid_ >> 6, h = ln >> 4;
                            pg8::Unit tu;
                            for (int i = 0; S.S.next(i, tu); ++i) {
#pragma unroll 1
                                for (int half = 0; half < 2; ++half) { const int rbase = tu.pm * 256 + tu.pn * 64 + wv * 8 + half * 4;
                                    v2u va[4], vb[4], vc[4]; float la[4], lb[4], lc[4];
#pragma unroll
                                    for (int r = 0; r < 4; ++r) { const int row = rbase + r; const size_t o = (size_t)row * 256 + 4 * ln;
                                        la[r] = lse[(size_t)row * 16 + h]; lb[r] = lse[(size_t)row * 16 + 4 + h]; lc[r] = lse[(size_t)row * 16 + 8 + h];
                                        va[r] = *(const v2u*)(tiles + (size_t)8 * MH * 256 + o); vb[r] = *(const v2u*)(tiles + (size_t)9 * MH * 256 + o); vc[r] = *(const v2u*)(tiles + (size_t)10 * MH * 256 + o); }
#pragma unroll
                                    for (int r = 0; r < 4; ++r) { const int row = rbase + r;
                                        const float l0 = la[r], l1 = lb[r], l2 = lc[r], mx = fmaxf(l0, fmaxf(l1, l2));
                                        const float e0 = __builtin_amdgcn_exp2f(l0 - mx), e1 = __builtin_amdgcn_exp2f(l1 - mx), e2 = __builtin_amdgcn_exp2f(l2 - mx), inv = 1.0f / (e0 + e1 + e2);
                                        const v2u a = va[r], b = vb[r], c = vc[r];
                                        const unsigned lo = pk2((e0 * __uint_as_float(a.x << 16) + e1 * __uint_as_float(b.x << 16) + e2 * __uint_as_float(c.x << 16)) * inv, (e0 * __uint_as_float(a.x & 0xffff0000u) + e1 * __uint_as_float(b.x & 0xffff0000u) + e2 * __uint_as_float(c.x & 0xffff0000u)) * inv);
                                        const unsigned hi2 = pk2((e0 * __uint_as_float(a.y << 16) + e1 * __uint_as_float(b.y << 16) + e2 * __uint_as_float(c.y << 16)) * inv, (e0 * __uint_as_float(a.y & 0xffff0000u) + e1 * __uint_as_float(b.y & 0xffff0000u) + e2 * __uint_as_float(c.y & 0xffff0000u)) * inv);
                                        __hip_atomic_store((unsigned long long*)(dc + (size_t)row * 256 + 4 * ln), ((unsigned long long)hi2 << 32) | lo, __ATOMIC_RELAXED, __HIP_MEMORY_SCOPE_AGENT); } }
                                asm volatile("s_waitcnt vmcnt(0)" ::: "memory");
                                if (ln == 0) (void)__hip_atomic_fetch_add(cnt + 64 * tu.pm, 1u, __ATOMIC_RELAXED, __HIP_MEMORY_SCOPE_AGENT);
                            }
                        }
                        EpiMerge E{(const bf16*)(ws + WS_R) + (size_t)17 * MH * 256, (bf16*)(ws + WS_U)};
                        pg8::gemm_phase<EpiMerge, MergeOrder, true, true>(lds, g, S, E);
#ifdef PROBE_MRG4
                        { EpiMergeCheap Ec{(bf16*)(ws + WS_U)}; xcd_barrier(bar); pg8::gemm_phase<EpiMergeCheap, MergeOrder, true, true>(lds, g, S, Ec); xcd_barrier(bar); pg8::gemm_phase<EpiMerge, MergeOrder, true, true>(lds, g, S, E); }
#endif
#ifdef PROBE_MRG3
                        xcd_barrier(bar); pg8::gemm_phase<EpiMerge, MergeOrder, true, true>(lds, g, S, E);
#endif
                    }
                    SEAM(ph + 4);
#ifndef NORES
                    if (IN(ph + 5)) {
                        PHASE_LOCALS; bf16* const xb = (bf16*)(ws + WS_XB); float* const ssq = (float*)(ws + WS_SSQ);
                        pg8::Gemm g{(const bf16*)(ws + WS_U), (const bf16*)(ws + WS_WO) + (size_t)l * DM * DM, MH, DM, DM}; pg8::StaticOrder S; S.init(MH, DM, G, bx);
                        EpiResid E{nullptr, xb + (size_t)hf * MH * DM, ssq + (size_t)hf * MH * 16, 1.0f};
                        pg8::gemm_phase<EpiResid, pg8::StaticOrder, true, true>(lds, g, S, E);
                    }
#endif
                    SEAM(ph + 5);
                }
            }
            const int p1 = pb + (f ? PO_F2I : PO_F1I);
#ifdef PROBE_K
            if (IN(p1) && l == 1 && f == 1) {
                PHASE_LOCALS;
#if PROBE_K != 2
                pg8::Gemm g2{(const bf16*)(ws + WS_XB), (const bf16*)(ws + WS_WFI) + (size_t)(l * 2 + f) * 5632 * DM, M, 5632, DM};
#else
                pg8::Gemm g2{(const bf16*)(ws + WS_R), (const bf16*)(ws + WS_WFI), M, 5632, 2048};
#endif
                pg8::StaticOrder S; S.init(M, 5632, G, bx, WGM_FFI);
#if PROBE_K == 5
                EpiFfnIn Ef{(const float*)(ws + WS_SSQ), (bf16*)(ws + WS_R)};
#pragma unroll 1
                for (int rep = 0; rep < 3; ++rep) { pg8::gemm_phase<EpiFfnIn, pg8::StaticOrder, true, true>(lds, g2, S, Ef); xcd_barrier(bar); }
#elif PROBE_K >= 3
                EpiFfnInCheap Ec{(const float*)(ws + WS_SSQ), (bf16*)(ws + WS_R)}; pg8::gemm_phase<EpiFfnInCheap, pg8::StaticOrder, true, true>(lds, g2, S, Ec); xcd_barrier(bar);
#else
                EpiNull En{(float*)(ws + WS_CTL) + 8};
                pg8::gemm_phase<EpiNull, pg8::StaticOrder, true, true>(lds, g2, S, En); xcd_barrier(bar);
#endif
            }
#endif
#ifndef NOFFNI
            if (IN(p1)) {
                PHASE_LOCALS; bf16* const xb = (bf16*)(ws + WS_XB); float* const ssq = (float*)(ws + WS_SSQ); bf16* const h2 = (bf16*)(ws + WS_R);
                pg8::Gemm g{xb, (const bf16*)(ws + WS_WFI) + (size_t)(l * 2 + f) * 5632 * DM, M, 5632, DM}; pg8::StaticOrder S; S.init(M, 5632, G, bx, WGM_FFI);
                EpiFfnIn E{ssq, h2};
#ifdef PROBE_FFI3
                { EpiFfnInCheap Ec{ssq, h2}; pg8::gemm_phase<EpiFfnInCheap, pg8::StaticOrder, true, true>(lds, g, S, Ec); xcd_barrier(bar); }
#endif
                pg8::gemm_phase<EpiFfnIn, pg8::StaticOrder, true, true>(lds, g, S, E);
#ifdef PROBE_FFI2
                xcd_barrier(bar); pg8::gemm_phase<EpiFfnIn, pg8::StaticOrder, true, true>(lds, g, S, E);
#endif
            }
#endif
            SEAM(p1);
#ifndef NORES2
            if (IN(p1 + 1)) {
                PHASE_LOCALS; bf16* const xb = (bf16*)(ws + WS_XB); float* const ssq = (float*)(ws + WS_SSQ); bf16* const h2 = (bf16*)(ws + WS_R);
                float* const xout = (l == DEPTH - 1 && f == 1) ? ap->out : nullptr;
                pg8::Gemm g{h2, (const bf16*)(ws + WS_WFO) + (size_t)(l * 2 + f) * DM * DFF, M, DM, DFF}; pg8::StaticOrder S; S.init(M, DM, G, bx, WGM_FFO);
                EpiResid E{xout, xb, ssq, 0.5f};
                pg8::gemm_phase<EpiResid, pg8::StaticOrder, true, true>(lds, g, S, E);
            }
#endif
            SEAM(p1 + 1);
        }
    }
#ifdef PROBE_T
    if (blockIdx.x == 0 && threadIdx.x == 0) { volatile LAS unsigned long long* pt_ = (volatile LAS unsigned long long*)(lds0 + 131072 + 2048); const unsigned long long t0_ = __builtin_amdgcn_s_memrealtime(), w_ = 8ull * pt_[0];
        while (__builtin_amdgcn_s_memrealtime() - t0_ < w_) __builtin_amdgcn_s_sleep(8); }
#endif
#undef IN
#undef SEAM
}
static void launch_mega(const Args& a0, int lo, int hi, int grid, hipStream_t st) {
    Args a = a0; a.ph_lo = lo; a.ph_hi = hi;
    hipMemsetAsync(a.ws + WS_CTL, 0, CTL_BYTES, st);
    hipLaunchKernelGGL(mega, dim3(grid), dim3(NTHR), LDS_BYTES, st, a);
}
extern "C" void kernel_launch(void* const* d_in, const int* in_sizes, int n_in, void* d_out, int out_size, void* d_ws, size_t ws_size, hipStream_t stream) {
    static int grid = 0;
    if (grid == 0) {
        if (n_in != 17 || ws_size < WS_END) { fprintf(stderr, "kernel_launch: unexpected n_in %d / ws %zu\n", n_in, ws_size); grid = -1; return; }
        int dev = 0, cus = 0; hipGetDevice(&dev); hipDeviceGetAttribute(&cus, hipDeviceAttributeMultiprocessorCount, dev);
        if (hipFuncSetAttribute((const void*)mega, hipFuncAttributeMaxDynamicSharedMemorySize, LDS_BYTES) != hipSuccess) { fprintf(stderr, "hipFuncSetAttribute failed\n"); grid = -1; return; }
        int per_cu = 0; hipOccupancyMaxActiveBlocksPerMultiprocessor(&per_cu, (const void*)mega, NTHR, LDS_BYTES); (void)hipGetLastError();
        if (per_cu < 1) fprintf(stderr, "note: occupancy query says %d\n", per_cu);
        grid = cus;
    }
    if (grid < 0) return;
    Args a{}; for (int i = 0; i < 17; ++i) a.in[i] = (const float*)d_in[i]; a.out = (float*)d_out; a.ws = (unsigned char*)d_ws; a.ph_lo = 0; a.ph_hi = 0;
    int cur = 0;
    launch_mega(a, cur, N_PHASES, grid, stream);
}
```

```cpp
#include <hip/hip_runtime.h>
#include <cstdio>
#include <cstdint>
#include <cmath>
namespace pg8 {
#define PG8_LAS __attribute__((address_space(3)))
typedef unsigned short bf16_t;
typedef short bf16x8 __attribute__((ext_vector_type(8)));
typedef float f32x4 __attribute__((ext_vector_type(4)));
typedef unsigned u32x4 __attribute__((ext_vector_type(4)));
constexpr int BM = 256, BK = 64, HALF = 128, HTB = HALF * BK * 2  , STAGE_BYTES = 8 * HTB, NXCD = 8, WGM = 4;

__host__ __device__ __forceinline__ int lds_byte(int r, int c) { const int st = (r >> 4) * 2 + (c >> 5), rr = r & 15, cc = c & 31, ob = rr * 64 + cc * 2; return st * 1024 + (ob ^ (((ob >> 9) & 1) << 5)); }
__host__ __device__ __forceinline__ void stage_rc(int b, int& R, int& C) { const int st = b / 1024, sb = b % 1024, swz = sb ^ (((sb >> 9) & 1) << 5); R = (st >> 1) * 16 + swz / 64; C = (st & 1) * 32 + (swz % 64) / 2; }
__host__ __device__ __forceinline__ int perm32(int rho) { const int n = rho >> 4, i = rho & 15; return 8 * (i >> 2) + 4 * n + (i & 3); }

struct Unit { int pm, pn; int ao, bo; };
struct Gemm { const bf16_t* A; const bf16_t* Bt; int M, N, K; };

struct StaticOrder {
    int nM, nN, nwg, G, c, wgm;
    __host__ __device__ void init(int M, int N, int G_, int c_, int wgm_ = WGM) { nM = M / BM; nN = N / BM; nwg = nM * nN; G = G_; c = c_; wgm = wgm_; }
    __host__ __device__ __forceinline__ bool next(int i, Unit& u) const {
        const long L = (long)i * G + c; if (L >= nwg) return false;
        int wgid = (int)L; { const int q = nwg / NXCD, r = nwg % NXCD, xcd = wgid % NXCD, off = wgid / NXCD; wgid = (xcd < r ? xcd * (q + 1) : r * (q + 1) + (xcd - r) * q) + off; }
        const int nig = wgm * nN, gid = wgid / nig, fm = gid * wgm, gsz = (nM - fm) < wgm ? (nM - fm) : wgm;
        u.pm = fm + ((wgid % nig) % gsz); u.pn = (wgid % nig) / gsz; u.ao = 0; u.bo = 0; return true;
    }
    __device__ __forceinline__ void a_ready(const Unit&) const {}
    __device__ __forceinline__ void done(const Unit&) const {}
};

__device__ __forceinline__ unsigned cvt_pk_bf16(float lo, float hi) { unsigned r; asm volatile("v_cvt_pk_bf16_f32 %0, %1, %2" : "=v"(r) : "v"(lo), "v"(hi)); return r; }
typedef float f32x2 __attribute__((ext_vector_type(2)));
__device__ __forceinline__ const char* uni_ptr(const char* p) { const unsigned long long v = (unsigned long long)p; return (const char*)(((unsigned long long)(unsigned)__builtin_amdgcn_readfirstlane((int)(v >> 32)) << 32) | (unsigned)__builtin_amdgcn_readfirstlane((int)v)); }
constexpr int RS_OFF = 131072 + 4096;
struct NoRs {};
template <class Epi, class Sched, bool ALIGN_EPI = false, bool SP2 = false>
__device__ __forceinline__ void gemm_phase(PG8_LAS unsigned char* lds, const Gemm g, const Sched& S, const Epi& E) {
    int tid_ = threadIdx.x; asm volatile("" : "+v"(tid_));
    const int tid = tid_, wid = __builtin_amdgcn_readfirstlane(tid >> 6), lane = tid & 63, wr = wid >> 2, wc = wid & 3, fr = lane & 15, fq = lane >> 4;
    const int K = g.K, nt = K / BK;
    unsigned voffA[2], voffB[2];
#pragma unroll
    for (int i = 0; i < 2; ++i) { int R, C; stage_rc(tid * 16 + i * 8192, R, C); const int Rb = Epi::PERM ? ((R & ~31) + perm32(R & 31)) : R;
        voffA[i] = (unsigned)(R * K + C) * 2u; voffB[i] = (unsigned)(Rb * K + C) * 2u; }
    const size_t kstep = (size_t)(BK * 2);
    const size_t hstep = (size_t)HALF * K * 2;
    const size_t tstep = 2 * hstep;
    const unsigned ldsw = (unsigned)wid * 1024u;
    const int aoff = lds_byte(wr * 64 + fr, fq * 8), boff = lds_byte(wc * 32 + fr, fq * 8);
#define PG8_SA(b, h) (((b) * 2 + (h)) * HTB)
#define PG8_SB(b, h) ((4 + (b) * 2 + (h)) * HTB)
#define PG8_STAGE(bufoff, gbase, voff) do { _Pragma("unroll") for (int _i = 0; _i < 2; ++_i) \
        __builtin_amdgcn_global_load_lds((const unsigned*)((const char*)(gbase) + (voff)[_i]), (PG8_LAS unsigned*)(lds + (bufoff) + ldsw + _i * 8192), 16, 0, 0); } while (0)
#define PG8_LDA(dst, b, h) do { _Pragma("unroll") for (int m = 0; m < 4; ++m) _Pragma("unroll") for (int k = 0; k < 2; ++k) dst[m][k] = *(const PG8_LAS bf16x8*)(lds + PG8_SA(b, h) + aoff + m * 2048 + k * 1024); } while (0)
#define PG8_LDB(dst, b, h) do { _Pragma("unroll") for (int n = 0; n < 2; ++n) _Pragma("unroll") for (int k = 0; k < 2; ++k) dst[n][k] = *(const PG8_LAS bf16x8*)(lds + PG8_SB(b, h) + boff + n * 2048 + k * 1024); } while (0)
#define PG8_MMA(ai, bj, At, Bt) do { __builtin_amdgcn_s_setprio(1); _Pragma("unroll") for (int m = 0; m < 4; ++m) _Pragma("unroll") for (int n = 0; n < 2; ++n) _Pragma("unroll") for (int k = 0; k < 2; ++k) \
        acc[ai][bj][m][n] = __builtin_amdgcn_mfma_f32_16x16x32_bf16(Bt[n][k], At[m][k], acc[ai][bj][m][n], 0, 0, 0); __builtin_amdgcn_s_setprio(0); } while (0)
#define PG8_WAIT_V(n) asm volatile("s_waitcnt vmcnt(" #n ")" ::: "memory")
#define PG8_WAIT_L(n) asm volatile("s_waitcnt lgkmcnt(" #n ")" ::: "memory")
#define PG8_WAIT_VE asm volatile("s_waitcnt vmcnt(%0)" :: "n"(8 + Epi::VM_OPS) : "memory")
#define PG8_BAR __builtin_amdgcn_s_barrier()
#define PG8_SCHED __builtin_amdgcn_sched_barrier(0)
    Unit cur, nxt; int ui = 0;
    if (!S.next(0, cur)) return;
    f32x4 acc[2][2][4][2];
#pragma unroll
    for (int a = 0; a < 2; ++a)
#pragma unroll
        for (int b = 0; b < 2; ++b)
#pragma unroll
            for (int m = 0; m < 4; ++m)
#pragma unroll
                for (int n = 0; n < 2; ++n) acc[a][b][m][n] = (f32x4){0.f, 0.f, 0.f, 0.f};
    bf16x8 At[4][2], B0[2][2], B1[2][2];
    const char* cA = uni_ptr((const char*)g.A + (size_t)cur.pm * tstep + cur.ao); const char* cB = uni_ptr((const char*)g.Bt + (size_t)cur.pn * tstep + cur.bo);
    typename Epi::Rs rsr;
    if constexpr (Epi::ROWSCALE) { E.rs_issue(cur, tid, rsr); E.rs_commit(rsr, tid, lds + RS_OFF, 0); }
    S.a_ready(cur);
    if constexpr (SP2) {
        PG8_STAGE(PG8_SB(0, 0), cB, voffB); PG8_STAGE(PG8_SB(0, 1), cB + hstep, voffB); PG8_STAGE(PG8_SA(0, 0), cA, voffA); PG8_STAGE(PG8_SA(0, 1), cA + hstep, voffA);
        if (wr == 1) PG8_BAR;
        PG8_WAIT_V(2); PG8_BAR;
        PG8_STAGE(PG8_SB(1, 0), cB + kstep, voffB); PG8_STAGE(PG8_SA(1, 0), cA + kstep, voffA); PG8_STAGE(PG8_SB(1, 1), cB + hstep + kstep, voffB); PG8_STAGE(PG8_SA(1, 1), cA + hstep + kstep, voffA);
        PG8_WAIT_V(8); PG8_BAR;
    } else {
        PG8_STAGE(PG8_SB(0, 0), cB, voffB); PG8_STAGE(PG8_SA(0, 0), cA, voffA); PG8_STAGE(PG8_SB(0, 1), cB + hstep, voffB); PG8_STAGE(PG8_SA(0, 1), cA + hstep, voffA);
        if (wr == 1) PG8_BAR;
        PG8_WAIT_V(4); PG8_BAR;
        PG8_STAGE(PG8_SB(1, 0), cB + kstep, voffB); PG8_STAGE(PG8_SA(1, 0), cA + kstep, voffA); PG8_STAGE(PG8_SB(1, 1), cB + hstep + kstep, voffB);
        PG8_WAIT_V(6); PG8_BAR;
    }
    for (;;) {
        const bool has_next = S.next(ui + 1, nxt);
        const char* nA = uni_ptr(has_next ? (const char*)g.A + (size_t)nxt.pm * tstep + nxt.ao : cA); const char* nB = uni_ptr(has_next ? (const char*)g.Bt + (size_t)nxt.pn * tstep + nxt.bo : cB);
        for (int t = 0; t < nt; t += 2) {
            const bool last = (t == nt - 2);
            const char* a1 = cA + (size_t)(t + 1) * kstep;
            const char* a2 = last ? nA : cA + (size_t)(t + 2) * kstep; const char* b2 = last ? nB : cB + (size_t)(t + 2) * kstep;
            const char* a3 = a2 + kstep; const char* b3 = b2 + kstep;
            if (last && has_next) S.a_ready(nxt);
            if constexpr (SP2) {
            const int fresh = __builtin_amdgcn_readfirstlane((t == 0 && ui > 0) ? 1 : 0);
#define PG8_WAIT_V8F asm volatile("s_waitcnt vmcnt(%1)\n\ts_cmp_lg_u32 %0, 0\n\ts_cbranch_scc1 .Lpg8f%=\n\ts_waitcnt vmcnt(8)\n.Lpg8f%=:" :: "s"(fresh), "n"(8 + Epi::VM_OPS) : "memory", "scc")
            PG8_LDB(B0, 0, 0); PG8_LDB(B1, 0, 1); PG8_SCHED; PG8_LDA(At, 0, 0);
            PG8_WAIT_V8F; PG8_WAIT_L(0); PG8_BAR; PG8_MMA(0, 0, At, B0); PG8_MMA(0, 1, At, B1); PG8_BAR; PG8_SCHED;
            PG8_LDA(At, 0, 1); PG8_STAGE(PG8_SB(0, 0), b2, voffB); PG8_STAGE(PG8_SB(0, 1), b2 + hstep, voffB); PG8_STAGE(PG8_SA(0, 0), a2, voffA);
            PG8_WAIT_V8F; PG8_WAIT_L(0); PG8_BAR; PG8_MMA(1, 0, At, B0); PG8_MMA(1, 1, At, B1); PG8_BAR; PG8_SCHED;
            PG8_LDB(B0, 1, 0); PG8_LDB(B1, 1, 1); PG8_SCHED; PG8_LDA(At, 1, 0); PG8_STAGE(PG8_SA(0, 1), a2 + hstep, voffA);
            PG8_WAIT_V8F; PG8_WAIT_L(0); PG8_BAR; PG8_MMA(0, 0, At, B0); PG8_MMA(0, 1, At, B1); PG8_BAR; PG8_SCHED;
#undef PG8_WAIT_V8F
            PG8_LDA(At, 1, 1); PG8_STAGE(PG8_SB(1, 0), b3, voffB); PG8_STAGE(PG8_SB(1, 1), b3 + hstep, voffB); PG8_STAGE(PG8_SA(1, 0), a3, voffA);
            PG8_WAIT_V(8); PG8_WAIT_L(0); PG8_BAR; PG8_MMA(1, 0, At, B0); PG8_MMA(1, 1, At, B1); PG8_BAR; PG8_SCHED;
            PG8_STAGE(PG8_SA(1, 1), a3 + hstep, voffA); PG8_SCHED;
            } else {
            PG8_LDB(B0, 0, 0); PG8_SCHED; PG8_LDA(At, 0, 0); PG8_STAGE(PG8_SA(1, 1), a1 + hstep, voffA);
            PG8_WAIT_L(8); PG8_BAR; PG8_WAIT_L(0); PG8_MMA(0, 0, At, B0); PG8_BAR; PG8_SCHED;
            PG8_LDB(B1, 0, 1); PG8_STAGE(PG8_SB(0, 0), b2, voffB);
            PG8_BAR; PG8_WAIT_L(0); PG8_MMA(0, 1, At, B1); PG8_BAR;
            PG8_LDA(At, 0, 1); PG8_STAGE(PG8_SA(0, 0), a2, voffA);
            PG8_BAR; PG8_WAIT_L(0); PG8_MMA(1, 0, At, B0); PG8_BAR; PG8_SCHED;
            PG8_STAGE(PG8_SB(0, 1), b2 + hstep, voffB);
            PG8_WAIT_V(6); PG8_BAR; PG8_MMA(1, 1, At, B1); PG8_BAR;
            PG8_LDB(B0, 1, 0); PG8_SCHED; PG8_LDA(At, 1, 0); PG8_STAGE(PG8_SA(0, 1), a2 + hstep, voffA);
            PG8_WAIT_L(8); PG8_BAR; PG8_WAIT_L(0); PG8_MMA(0, 0, At, B0); PG8_BAR; PG8_SCHED;
            PG8_LDB(B1, 1, 1); PG8_STAGE(PG8_SB(1, 0), b3, voffB);
            PG8_BAR; PG8_WAIT_L(0); PG8_MMA(0, 1, At, B1); PG8_BAR;
            PG8_LDA(At, 1, 1); PG8_STAGE(PG8_SA(1, 0), a3, voffA);
            PG8_BAR; PG8_WAIT_L(0); PG8_MMA(1, 0, At, B0); PG8_BAR; PG8_SCHED;
            PG8_STAGE(PG8_SB(1, 1), b3 + hstep, voffB);
            PG8_WAIT_V(6); PG8_BAR; PG8_MMA(1, 1, At, B1); PG8_BAR;
            }
        }
        if constexpr (ALIGN_EPI) { if (wr == 0) PG8_BAR; }
        bool keep_acc = false;
        if constexpr (Epi::CHAIN) { keep_acc = E.chain(acc, cur, wr, wc, fr, fq); S.done(cur); }
        else if constexpr (Epi::ROWSCALE) { E(acc, cur, wr, wc, fr, fq, (const PG8_LAS float*)(lds + RS_OFF) + (ui & 1) * 512, has_next, nxt, tid, rsr); S.done(cur); }
        else if constexpr (!Epi::AFTER_DRAIN) { E(acc, cur, wr, wc, fr, fq); S.done(cur); }
        if constexpr (Epi::ROWSCALE) { PG8_SCHED; if (has_next) E.rs_commit(rsr, tid, lds + RS_OFF, (ui + 1) & 1); }
        if (!has_next) break;
        if (!keep_acc) {
#pragma unroll
        for (int a = 0; a < 2; ++a)
#pragma unroll
            for (int b = 0; b < 2; ++b)
#pragma unroll
                for (int m = 0; m < 4; ++m)
#pragma unroll
                    for (int n = 0; n < 2; ++n) acc[a][b][m][n] = (f32x4){0.f, 0.f, 0.f, 0.f};
        }
        cur = nxt; cA = nA; cB = nB; ++ui;
        if constexpr (ALIGN_EPI) { if (wr == 1) PG8_BAR; }
    }
    PG8_WAIT_V(0);
    if constexpr (!ALIGN_EPI) { if (wr == 0) PG8_BAR; }
    PG8_BAR;
    if constexpr (Epi::AFTER_DRAIN) { E.fused(acc, cur, wr, wc, fr, fq, lds, wid, lane); S.done(cur); }
#undef PG8_SA
#undef PG8_SB
#undef PG8_STAGE
#undef PG8_LDA
#undef PG8_LDB
#undef PG8_MMA
#undef PG8_WAIT_V
#undef PG8_WAIT_L
#undef PG8_WAIT_VE
#undef PG8_BAR
#undef PG8_SCHED
}
}
#define LAS __attribute__((address_space(3)))
#define XB_TMO      128
#define XB_XCNT(j)  (256  + 64 * (j))
#define XB_XSUB(j)  (1280 + 64 * (j))
#define XB_XGEN(j)  (2304 + 64 * (j))
#define XB_TOP      3328
#define XB_TOPGEN   3392
#define XCD_BAR_WORDS 3456
#define XB_SPIN_CAP (1u << 18)

__device__ __forceinline__ unsigned xb_ld(unsigned* p)              { return __hip_atomic_load(p, __ATOMIC_RELAXED, __HIP_MEMORY_SCOPE_AGENT); }
__device__ __forceinline__ unsigned xb_add(unsigned* p, unsigned v) { return __hip_atomic_fetch_add(p, v, __ATOMIC_RELAXED, __HIP_MEMORY_SCOPE_AGENT); }
__device__ __forceinline__ unsigned xb_xcc_id() { return (unsigned)__builtin_amdgcn_s_getreg((3 << 11) | 20) & 0xFu; }
#define XB_SPIN(cond, bar) do { unsigned _sp = 0; while (cond) { __builtin_amdgcn_s_sleep(1); \
    if ((++_sp & 255u) == 0u) { if (xb_ld(&(bar)[XB_TMO])) break; if (_sp > XB_SPIN_CAP) { atomicAdd(&(bar)[XB_TMO], 1u); break; } } } } while (0)

struct XcdBarrier {
    unsigned* bar; unsigned x;
    volatile LAS unsigned* st;
};

__device__ __forceinline__ XcdBarrier xcd_barrier_post(unsigned* bar, volatile LAS unsigned* st) {
    XcdBarrier b; b.bar = bar; b.x = xb_xcc_id(); b.st = st;
    if (threadIdx.x == 0) (void)xb_add(&bar[XB_XCNT(b.x)], 1u);
    return b;
}
__device__ __forceinline__ void xcd_barrier_complete(unsigned* bar, unsigned x, unsigned& nloc, unsigned& nx) {
    const unsigned G = gridDim.x * gridDim.y * gridDim.z;
    unsigned sum, cnt, mine, sp = 0u;
    for (;;) {
        sum = 0u; cnt = 0u; mine = 0u;
#pragma unroll
        for (unsigned j = 0; j < 16; ++j) { const unsigned c = xb_ld(&bar[XB_XCNT(j)]); sum += c; cnt += (c > 0u) ? 1u : 0u; mine = (j == x) ? c : mine; }
        if (sum == G) break;
        __builtin_amdgcn_s_sleep(1);
        if ((++sp & 255u) == 0u) { if (xb_ld(&bar[XB_TMO])) break; if (sp > XB_SPIN_CAP) { atomicAdd(&bar[XB_TMO], 1u); break; } }
    }
    nloc = mine > 0u ? mine : 1u; nx = cnt > 0u ? cnt : 1u;
}

__device__ __forceinline__ void xcd_barrier(const XcdBarrier& b) {
    asm volatile("s_waitcnt vmcnt(0)" ::: "memory");
    __syncthreads();
    if (threadIdx.x == 0) {
        unsigned* bar = b.bar; unsigned bx = b.x; asm volatile("" : "+s"(bar), "+s"(bx));
        __builtin_amdgcn_s_waitcnt(0);
        unsigned nloc = b.st[0], nx = b.st[1];
        if (nloc == 0u) { xcd_barrier_complete(bar, bx, nloc, nx); b.st[0] = nloc; b.st[1] = nx; }
        const unsigned old = xb_add(&bar[XB_XSUB(bx)], 1u);
        const unsigned gen = old / nloc;
        if (old + 1u == (gen + 1u) * nloc) {
            __builtin_amdgcn_fence(__ATOMIC_RELEASE, "agent");
            asm volatile("s_waitcnt vmcnt(0)" ::: "memory");
            const unsigned og = xb_add(&bar[XB_TOP], 1u);
            const unsigned tg = og / nx;
            if (og + 1u == (tg + 1u) * nx) xb_add(&bar[XB_TOPGEN], 1u);
            else XB_SPIN(xb_ld(&bar[XB_TOPGEN]) == tg, bar);
            __builtin_amdgcn_fence(__ATOMIC_ACQUIRE, "agent");
            xb_add(&bar[XB_XGEN(bx)], 1u);
            asm volatile("s_waitcnt vmcnt(0)" ::: "memory");
        } else {
            XB_SPIN(xb_ld(&bar[XB_XGEN(bx)]) == gen, bar);
            __builtin_amdgcn_fence(__ATOMIC_ACQUIRE, "agent");
            asm volatile("s_waitcnt vmcnt(0)" ::: "memory");
        }
    }
    __syncthreads();
}
typedef unsigned short bf16;
typedef unsigned v4u __attribute__((ext_vector_type(4)));
typedef unsigned v2u __attribute__((ext_vector_type(2)));
typedef float f32x4 __attribute__((ext_vector_type(4)));
typedef float f32x16 __attribute__((ext_vector_type(16)));
typedef short bf16x8 __attribute__((ext_vector_type(8)));
typedef short s16x4 __attribute__((ext_vector_type(4)));
constexpr int DM = 1024, NB = 16, SEQ = 2048, DEPTH = 2, DFF = 2816, INW = 8388;
constexpr int M = NB * SEQ, MH = M / 2, HBAT = NB / 2;
constexpr int O_AQ = 0, O_AK = 256, O_AV = 320, O_IQ = 384, O_IK = 512, O_IW = 544, O_B = 548, O_CQ = 1316, O_CKV = 1700, O_CKR = 1956, O_D = 1988, O_G = 4292;
constexpr int NT_IN = 33, N_INP = NT_IN * 256;
constexpr float EPS = 1e-6f, LOG2E = 1.4426950408889634f;
constexpr float C2A = 0.125f * LOG2E;
constexpr float C2C = 0.10206207261596577f * LOG2E;
constexpr int NWAVES = 8, NTHR = 512;
#ifndef WGM_FFO
#define WGM_FFO 4
#endif
#ifndef WGM_FFI
#define WGM_FFI 4
#endif
#ifndef WGM_INP
#define WGM_INP 4
#endif
constexpr size_t MiB = (size_t)1 << 20;
constexpr size_t WS_CTL = 0, CTL_BYTES = 1 * MiB;
constexpr size_t WS_BIAS = 1 * MiB;
constexpr size_t WS_BIASD = WS_BIAS + 20 * 2112 * 4;
constexpr size_t WS_BID = WS_BIASD + 12 * 192 * 4;
constexpr size_t WS_ROPE = 2 * MiB;
constexpr size_t WS_KMEAN = 3 * MiB;
constexpr size_t WS_WFI = 4 * MiB;
constexpr size_t WS_WFO = 48 * MiB;
constexpr size_t WS_WIN = 70 * MiB;
constexpr size_t WS_WO = 103 * MiB;
constexpr size_t WS_WB = 107 * MiB;
constexpr size_t WS_WUQ = 111 * MiB;
constexpr size_t WS_WUKV = 112 * MiB;
constexpr size_t WS_XB = 113 * MiB;
constexpr size_t WS_SSQ = 177 * MiB;
constexpr size_t WS_R = 180 * MiB;
constexpr size_t TILE_B = (size_t)MH * 256 * 2;
constexpr size_t WS_CQL = WS_R + 2 * TILE_B;
constexpr size_t WS_XS = WS_CQL + (size_t)MH * 384 * 2;
constexpr size_t WS_CKVL = WS_R + 4 * TILE_B;
constexpr size_t WS_DC = WS_R + 2 * TILE_B;
constexpr size_t WS_U = WS_R + 11 * TILE_B;
constexpr size_t WS_QN = 444 * MiB, WS_KN = 456 * MiB, WS_VC = 468 * MiB, WS_OC = 476 * MiB;
constexpr size_t WS_IWF = 484 * MiB;
constexpr size_t WS_SSL = 485 * MiB;
constexpr size_t WS_MASK = 486 * MiB;
constexpr size_t WS_LSED = 490 * MiB;
constexpr size_t WS_END = 492 * MiB;
constexpr int CW_BAR = 4096, CW_QUEUE = 16384, CW_SEAM = 32768;
constexpr int PH_PRO = 0, PH_L0 = 1, PH_PER_LAYER = 16, N_PHASES = 1 + 2 * PH_PER_LAYER;
enum { PO_F1I = 0, PO_F1O = 1, PO_INP = 2, PO_PREP = 3, PO_ATT = 4, PO_CMB = 5, PO_MRG = 6, PO_OUT = 7,   PO_F2I = 14, PO_F2O = 15 };

struct Args { const float* in[17]; float* out; unsigned char* ws; int ph_lo, ph_hi; };

__device__ __forceinline__ float bf2f(bf16 b) { return __uint_as_float(((unsigned)b) << 16); }
__device__ __forceinline__ unsigned f2bf(float f) { unsigned u = __float_as_uint(f); return (u + 0x7fffu + ((u >> 16) & 1u)) >> 16; }
typedef float f32x2_t __attribute__((ext_vector_type(2))); typedef __bf16 bf16x2_t __attribute__((ext_vector_type(2)));
__device__ __forceinline__ unsigned pk2(float lo, float hi) { f32x2_t v = {lo, hi}; bf16x2_t b = __builtin_convertvector(v, bf16x2_t); return __builtin_bit_cast(unsigned, b); }
#define CAS __attribute__((address_space(4)))
__device__ __forceinline__ float bperm_f(int srclane, float v) { return __int_as_float(__builtin_amdgcn_ds_bpermute(srclane << 2, __float_as_int(v))); }
__device__ __forceinline__ int bperm_i(int srclane, int v) { return __builtin_amdgcn_ds_bpermute(srclane << 2, v); }
__device__ __forceinline__ float xsum32(float v) { auto rr = __builtin_amdgcn_permlane32_swap(__float_as_uint(v), __float_as_uint(v), false, false); return __uint_as_float(rr[0]) + __uint_as_float(rr[1]); }
__device__ __forceinline__ v4u pair16(v2u X, v2u Y) { auto a = __builtin_amdgcn_permlane32_swap(X.x, Y.x, false, false); auto b = __builtin_amdgcn_permlane32_swap(X.y, Y.y, false, false); v4u o; o.x = a[0]; o.y = b[0]; o.z = a[1]; o.w = b[1]; return o; }
__device__ __forceinline__ float xmax32(float v) { auto rr = __builtin_amdgcn_permlane32_swap(__float_as_uint(v), __float_as_uint(v), false, false); return fmaxf(__uint_as_float(rr[0]), __uint_as_float(rr[1])); }
__host__ __device__ __forceinline__ int inproj_srccol(int n) {
    const int pn = n >> 8, c = n & 255;
    if (pn >= 17) { const int g = pn - 17; return O_G + (g >> 2) * 1024 + (g & 3) * 256 + c; }
    const int slot = (c >> 5) & 3, e = 32 * (c >> 7) + (c & 31);
    switch (pn) {
        case 0: return O_AQ + slot * 64 + e;
        case 1: return slot == 0 ? O_AK + e : slot == 1 ? O_AV + e : O_IQ + (slot - 2) * 64 + e;
        case 2: return O_CQ + slot * 64 + e;
        case 3: if (slot < 2) return O_CQ + 256 + slot * 64 + e; if (slot == 2) return e < 32 ? O_IK + e : O_CKR + (e - 32); return e < 4 ? O_IW + e : -1;
        case 4: return O_CKV + slot * 64 + e;
        default: if (pn <= 7) return O_B + (pn - 5) * 256 + slot * 64 + e; return O_D + (pn - 8) * 256 + slot * 64 + e;
    }
}
__device__ __forceinline__ float row_scale(const float* ssq, int row, int fr, int fq) {
    const f32x4 a = *(const f32x4*)(ssq + (size_t)row * 16 + 4 * fq); float s = (a[0] + a[1]) + (a[2] + a[3]);
    s += bperm_f(((fq ^ 1) << 4) | fr, s); s = xsum32(s);
    return rsqrtf(s * (1.0f / 1024.0f) + EPS);
}
__device__ __forceinline__ void row_scales8(const float* ssq, int row0, int fr, int fq, float (&rs)[2][4]) {
    f32x4 a[2][4];
#pragma unroll
    for (int ai = 0; ai < 2; ++ai)
#pragma unroll
        for (int m = 0; m < 4; ++m) a[ai][m] = *(const f32x4*)(ssq + (size_t)(row0 + ai * 128 + m * 16) * 16 + 4 * fq);
    __builtin_amdgcn_sched_barrier(0);
    float s[2][4], o[2][4];
#pragma unroll
    for (int ai = 0; ai < 2; ++ai)
#pragma unroll
        for (int m = 0; m < 4; ++m) { s[ai][m] = (a[ai][m][0] + a[ai][m][1]) + (a[ai][m][2] + a[ai][m][3]); o[ai][m] = bperm_f(((fq ^ 1) << 4) | fr, s[ai][m]); }
#pragma unroll
    for (int ai = 0; ai < 2; ++ai)
#pragma unroll
        for (int m = 0; m < 4; ++m) rs[ai][m] = rsqrtf(xsum32(s[ai][m] + o[ai][m]) * (1.0f / 1024.0f) + EPS);
}
__device__ __forceinline__ float fast_sigmoid(float x) { return __builtin_amdgcn_rcpf(1.0f + __builtin_amdgcn_exp2f(-x * LOG2E)); }
__device__ __forceinline__ v4u pack8(const f32x4 a, const f32x4 b) { v4u w; w.x = pk2(a[0], a[1]); w.y = pk2(a[2], a[3]); w.z = pk2(b[0], b[1]); w.w = pk2(b[2], b[3]); return w; }

struct RsRegs { f32x4 a, b, c, d; float e; };
__device__ __forceinline__ void rs_issue_rows(const float* ssq, int pm, int tid, RsRegs& r) {
    if (tid < 256) { const f32x4* sp = (const f32x4*)(ssq + (size_t)(pm * 256 + tid) * 16); r.a = sp[0]; r.b = sp[1]; r.c = sp[2]; r.d = sp[3]; } }
__device__ __forceinline__ void rs_commit_rows(const RsRegs& r, int tid, LAS unsigned char* tab, int buf) {
    if (tid < 256) { const float s = (((r.a[0] + r.a[1]) + (r.a[2] + r.a[3])) + ((r.b[0] + r.b[1]) + (r.b[2] + r.b[3]))) + (((r.c[0] + r.c[1]) + (r.c[2] + r.c[3])) + ((r.d[0] + r.d[1]) + (r.d[2] + r.d[3])));
        ((LAS float*)tab)[buf * 512 + tid] = rsqrtf(s * (1.0f / 1024.0f) + EPS); } }
struct EpiFfnIn {
    static constexpr bool ROWSCALE = true; static constexpr int VM_OPS = 8;
    static constexpr bool CHAIN = false;
    static constexpr bool PERM = true, AFTER_DRAIN = false;
    const float* ssq; bf16* h2;
    typedef RsRegs Rs;
    __device__ __forceinline__ void rs_issue(const pg8::Unit& u, int tid, Rs& r) const { rs_issue_rows(ssq, u.pm, tid, r); }
    __device__ __forceinline__ void rs_commit(const Rs& r, int tid, LAS unsigned char* tab, int buf) const { rs_commit_rows(r, tid, tab, buf); }
    __device__ __forceinline__ void operator()(const pg8::f32x4 (&acc)[2][2][4][2], const pg8::Unit& u, int wr, int wc, int fr, int fq, const LAS float* rst, bool has_next, const pg8::Unit& nx, int tid, Rs& rsr) const {
        const int row0 = u.pm * 256 + wr * 64 + fr, colh = u.pn * 128 + wc * 32 + fq * 8;
        if (has_next) rs_issue(nx, tid, rsr);
        asm volatile("" ::: "memory");
        float rs[2][4];
#pragma unroll
        for (int ai = 0; ai < 2; ++ai)
#pragma unroll
            for (int m = 0; m < 4; ++m) rs[ai][m] = rst[ai * 128 + wr * 64 + m * 16 + fr];
#pragma unroll
        for (int ai = 0; ai < 2; ++ai)
#pragma unroll
            for (int m = 0; m < 4; ++m) { const int row = row0 + ai * 128 + m * 16; const float s = rs[ai][m], sm = -s * LOG2E, ss = s * s;
                unsigned w[4];
#pragma unroll
                for (int n = 0; n < 2; ++n)
#pragma unroll
                    for (int jp = 0; jp < 2; ++jp) { const f32x2_t a = {acc[ai][0][m][n][2 * jp], acc[ai][0][m][n][2 * jp + 1]}, b = {acc[ai][1][m][n][2 * jp], acc[ai][1][m][n][2 * jp + 1]};
                        const f32x2_t t = a * sm; f32x2_t d = {__builtin_amdgcn_exp2f(t.x), __builtin_amdgcn_exp2f(t.y)}; d = d + 1.0f;
                        const f32x2_t r = {__builtin_amdgcn_rcpf(d.x), __builtin_amdgcn_rcpf(d.y)}, h = ((a * b) * ss) * r; w[2 * n + jp] = pk2(h.x, h.y); }
                v4u wv; wv.x = w[0]; wv.y = w[1]; wv.z = w[2]; wv.w = w[3];
                *(v4u*)(h2 + (size_t)row * DFF + colh) = wv; }
    }
};
struct EpiResid {
    static constexpr bool ROWSCALE = false; typedef pg8::NoRs Rs; static constexpr int VM_OPS = 32;
    static constexpr bool CHAIN = false;
    static constexpr bool PERM = true, AFTER_DRAIN = false;
    float* out; bf16* xb; float* ssq; float alpha;
    __device__ __forceinline__ void operator()(const pg8::f32x4 (&acc)[2][2][4][2], const pg8::Unit& u, int wr, int wc, int fr, int fq) const {
        const int row0 = u.pm * 256 + wr * 64 + fr, col0 = u.pn * 256 + wc * 32 + fq * 8;
        const bool fin = out != nullptr;
        v4u bv[2][4][2];
#pragma unroll
        for (int ai = 0; ai < 2; ++ai)
#pragma unroll
            for (int m = 0; m < 4; ++m)
#pragma unroll
                for (int bj = 0; bj < 2; ++bj) bv[ai][m][bj] = *(const v4u*)(xb + (size_t)(row0 + ai * 128 + m * 16) * DM + col0 + bj * 128);
        __builtin_amdgcn_sched_barrier(0);
#pragma unroll
        for (int ai = 0; ai < 2; ++ai) {
#pragma unroll
            for (int m = 0; m < 4; ++m) { const int row = row0 + ai * 128 + m * 16; float ss = 0.f;
#pragma unroll
                for (int bj = 0; bj < 2; ++bj) { const size_t o = (size_t)row * DM + col0 + bj * 128; const v4u b = bv[ai][m][bj];
                    f32x4 x0, x1;
                    x0[0] = __uint_as_float(b.x << 16); x0[1] = __uint_as_float(b.x & 0xffff0000u); x0[2] = __uint_as_float(b.y << 16); x0[3] = __uint_as_float(b.y & 0xffff0000u);
                    x1[0] = __uint_as_float(b.z << 16); x1[1] = __uint_as_float(b.z & 0xffff0000u); x1[2] = __uint_as_float(b.w << 16); x1[3] = __uint_as_float(b.w & 0xffff0000u);
#pragma unroll
                    for (int j = 0; j < 4; ++j) { x0[j] += alpha * acc[ai][bj][m][0][j]; x1[j] += alpha * acc[ai][bj][m][1][j]; ss += x0[j] * x0[j] + x1[j] * x1[j]; }
                    if (fin) { *(f32x4*)(out + o) = x0; *(f32x4*)(out + o + 4) = x1; }
                    *(v4u*)(xb + o) = pack8(x0, x1); }
                ss += bperm_f(((fq ^ 1) << 4) | fr, ss); ss = xsum32(ss);
                if (fq == 0) ssq[(size_t)row * 16 + u.pn * 4 + wc] = ss; }
            __builtin_amdgcn_sched_barrier(0);
        }
    }
};
struct EpiInProj {
    static constexpr bool ROWSCALE = true; static constexpr int VM_OPS = 16;
    static constexpr bool CHAIN = false;
    static constexpr bool PERM = true, AFTER_DRAIN = false;
    const float* ssq;
    unsigned char* ws;
    const float* g_a; const float* g_b; const float* g_d;
    const float* bgate;
    typedef RsRegs Rs;
    __device__ __forceinline__ const float* colvec(int pn, int& n) const {
        if (pn >= 17) { const int g = pn - 17; n = 256; return bgate + (g >> 2) * 1024 + (g & 3) * 256; }
        n = 64;
        switch (pn) { case 0: return g_a; case 1: return g_a + 64; case 5: return g_b; case 6: return g_b + 64; case 8: case 9: case 10: return g_d; case 11: case 12: case 13: return g_d + 64; default: n = 0; return g_a; } }
    __device__ __forceinline__ void rs_issue(const pg8::Unit& u, int tid, Rs& r) const { rs_issue_rows(ssq, u.pm, tid, r);
        if (tid >= 256) { int n; const float* v = colvec(u.pn, n); r.e = (tid - 256 < n) ? v[tid - 256] : 1.0f; } }
    __device__ __forceinline__ void rs_commit(const Rs& r, int tid, LAS unsigned char* tab, int buf) const { rs_commit_rows(r, tid, tab, buf); if (tid >= 256) ((LAS float*)tab)[buf * 512 + tid] = r.e; }
    __device__ __forceinline__ void operator()(const pg8::f32x4 (&acc)[2][2][4][2], const pg8::Unit& u, int wr, int wc, int fr, int fq, const LAS float* rst, bool has_next, const pg8::Unit& nx, int tid, Rs& rsr) const {
        const int pn = u.pn, row0 = u.pm * 256 + wr * 64 + fr;
        if (has_next) rs_issue(nx, tid, rsr);
        asm volatile("" ::: "memory");
        const LAS float* cv = rst + 256;
        bf16* const tiles = (bf16*)(ws + WS_R);
        float rs[2][4];
#pragma unroll
        for (int ai = 0; ai < 2; ++ai)
#pragma unroll
            for (int m = 0; m < 4; ++m) rs[ai][m] = rst[ai * 128 + wr * 64 + m * 16 + fr];
        if (pn >= 17) {
            f32x4 bv[2][2];
#pragma unroll
            for (int bj = 0; bj < 2; ++bj) { bv[bj][0] = *(const LAS f32x4*)(cv + wc * 32 + fq * 8 + bj * 128); bv[bj][1] = *(const LAS f32x4*)(cv + wc * 32 + fq * 8 + bj * 128 + 4); }
            unsigned char* dst = (unsigned char*)(tiles + (size_t)pn * MH * 256) + wc * 32 + fq * 8;
#pragma unroll
            for (int ai = 0; ai < 2; ++ai)
#pragma unroll
                for (int m = 0; m < 4; ++m) { const int row = row0 + ai * 128 + m * 16; const float s = rs[ai][m];
#pragma unroll
                    for (int bj = 0; bj < 2; ++bj) { unsigned q[8];
#pragma unroll
                        for (int j = 0; j < 4; ++j) { q[j] = (unsigned)fmaxf(fast_sigmoid(acc[ai][bj][m][0][j] * s + bv[bj][0][j]) * 255.0f + 0.5f, 1.0f); q[4 + j] = (unsigned)fmaxf(fast_sigmoid(acc[ai][bj][m][1][j] * s + bv[bj][1][j]) * 255.0f + 0.5f, 1.0f); }
                        v2u w; w.x = q[0] | (q[1] << 8) | (q[2] << 16) | (q[3] << 24); w.y = q[4] | (q[5] << 8) | (q[6] << 16) | (q[7] << 24);
                        *(v2u*)(dst + (size_t)row * 256 + bj * 128) = w; } }
            return;
        }
        bf16* dst; int ld; int mode = 0  ; const float* gain = nullptr; float scale = 1.f; float* ssl = nullptr; bool iw = false;
        switch (pn) {
            case 0: dst = tiles + wc * 64; ld = 256; mode = 1; gain = g_a; scale = C2A; break;
            case 1: dst = tiles + (size_t)1 * MH * 256 + wc * 64; ld = 256; if (wc == 0) { mode = 1; gain = g_a + 64; } break;
            case 2: dst = (bf16*)(ws + WS_CQL) + wc * 64; ld = 384; ssl = (float*)(ws + WS_SSL) + wc; break;
            case 3: if (wc < 2) { dst = (bf16*)(ws + WS_CQL) + 256 + wc * 64; ld = 384; ssl = (float*)(ws + WS_SSL) + 4 + wc; } else { dst = (bf16*)(ws + WS_XS) + (wc - 2) * 64; ld = 128; iw = (wc == 3); } break;
            case 4: dst = (bf16*)(ws + WS_CKVL) + wc * 64; ld = 256; ssl = (float*)(ws + WS_SSL) + 6 + wc; break;
            default: dst = tiles + (size_t)pn * MH * 256 + wc * 64; ld = 256;
                if (pn == 5) { mode = 1; gain = g_b; scale = C2A; } else if (pn == 6) { mode = 1; gain = g_b + 64; }
                else if (pn >= 8 && pn <= 10) { mode = 1; gain = g_d; scale = C2A; } else if (pn >= 11 && pn <= 13) { mode = 1; gain = g_d + 64; }
                break;
        }
        f32x4 gv[2][2];
#pragma unroll
        for (int bj = 0; bj < 2; ++bj)
#pragma unroll
            for (int n = 0; n < 2; ++n) gv[bj][n] = mode ? *(const LAS f32x4*)(cv + 32 * bj + 8 * fq + 4 * n) : (f32x4){1.f, 1.f, 1.f, 1.f};
#pragma unroll
        for (int ai = 0; ai < 2; ++ai)
#pragma unroll
            for (int m = 0; m < 4; ++m) { const int row = row0 + ai * 128 + m * 16; const float s = rs[ai][m];
                f32x4 v[2][2]; float ss = 0.f;
#pragma unroll
                for (int bj = 0; bj < 2; ++bj)
#pragma unroll
                    for (int n = 0; n < 2; ++n)
#pragma unroll
                        for (int j = 0; j < 4; ++j) { const float t = acc[ai][bj][m][n][j] * s; v[bj][n][j] = t; ss += t * t; }
                if (mode || ssl) { ss += bperm_f(((fq ^ 1) << 4) | fr, ss); ss = xsum32(ss); }
                if (ssl && fq == 0) ssl[(size_t)row * 16] = ss;
                if (iw && fq == 0) *(f32x4*)((float*)(ws + WS_IWF) + (size_t)row * 4) = v[0][0];
                const float r = mode ? rsqrtf(ss * (1.0f / 64.0f) + EPS) * scale : 1.f;
#pragma unroll
                for (int bj = 0; bj < 2; ++bj) { f32x4 a, b;
#pragma unroll
                    for (int j = 0; j < 4; ++j) { a[j] = v[bj][0][j] * r * gv[bj][0][j]; b[j] = v[bj][1][j] * r * gv[bj][1][j]; }
                    *(v4u*)(dst + (size_t)row * ld + 32 * bj + 8 * fq) = pack8(a, b); } }
    }
};

struct MergeOrder {
    pg8::StaticOrder S; int a1, a2, a3;
    const unsigned* ready; unsigned* tmo;
    __device__ __forceinline__ bool next(int i, pg8::Unit& u) const { pg8::Unit t; if (!S.next(i >> 2, t)) return false; const int n = i & 3; u.pm = t.pm; u.pn = t.pn; u.ao = __builtin_amdgcn_readfirstlane(n == 0 ? 0 : n == 1 ? a1 : n == 2 ? a2 : a3); u.bo = __builtin_amdgcn_readfirstlane(n * (DM * 256 * 2)); return true; }
    __device__ __forceinline__ void a_ready(const pg8::Unit& u) const {
        if (u.bo != 3 * (DM * 256 * 2)) return;
        if (threadIdx.x < 64) { unsigned spins = 0;
            while ((unsigned)__builtin_amdgcn_readfirstlane(__hip_atomic_load(ready + 64 * u.pm, __ATOMIC_RELAXED, __HIP_MEMORY_SCOPE_AGENT)) < 32u) {
                __builtin_amdgcn_s_sleep(2);
                if (++spins > (1u << 22)) { if (threadIdx.x == 0) __hip_atomic_store(tmo, 1u, __ATOMIC_RELAXED, __HIP_MEMORY_SCOPE_AGENT); break; } }
            __builtin_amdgcn_fence(__ATOMIC_ACQUIRE, "agent");
            asm volatile("s_waitcnt vmcnt(0)" ::: "memory"); }
        asm volatile("" ::: "memory"); __builtin_amdgcn_s_barrier(); asm volatile("" ::: "memory");
    }
    __device__ __forceinline__ void done(const pg8::Unit&) const {}
};
struct EpiMerge {
    static constexpr bool ROWSCALE = false; typedef pg8::NoRs Rs; static constexpr int VM_OPS = 0;
    static constexpr bool PERM = true, AFTER_DRAIN = false, CHAIN = true;
    const bf16* gates;
    bf16* U;
    __device__ __forceinline__ bool chain(pg8::f32x4 (&acc)[2][2][4][2], const pg8::Unit& u, int wr, int wc, int fr, int fq) const {
        const int n = (int)(u.bo / (DM * 256 * 2)); const int row0 = u.pm * 256 + wr * 64 + fr, ct = wc * 32 + fq * 8;
        const unsigned char* gt = (const unsigned char*)(gates + (size_t)(n * 4 + u.pn) * MH * 256) + (size_t)row0 * 256 + ct; bf16* up = U + u.pn * 256 + ct;
        const size_t gnext = (n < 3) ? (size_t)4 * MH * 256 * 2 : 0;
        v2u gv[16], gw[16];
#pragma unroll
        for (int i = 0; i < 16; ++i) { const unsigned char* gp = gt + (size_t)((i >> 3) * 128 + ((i >> 1) & 3) * 16) * 256 + (i & 1) * 128; gv[i] = *(const v2u*)gp; gw[i] = *(const v2u*)(gp + gnext); }
        __builtin_amdgcn_sched_barrier(0);
#pragma unroll
        for (int ai = 0; ai < 2; ++ai)
#pragma unroll
            for (int m = 0; m < 4; ++m) { const int row = row0 + ai * 128 + m * 16;
#pragma unroll
                for (int bj = 0; bj < 2; ++bj) { const v2u a = gv[ai * 8 + m * 2 + bj], b = gw[ai * 8 + m * 2 + bj];
                    if (n < 3) {
#pragma unroll
                        for (int k = 0; k < 4; ++k) { acc[ai][bj][m][0][k] *= (float)((a.x >> (8 * k)) & 0xffu) * __builtin_amdgcn_rcpf((float)((b.x >> (8 * k)) & 0xffu));
                            acc[ai][bj][m][1][k] *= (float)((a.y >> (8 * k)) & 0xffu) * __builtin_amdgcn_rcpf((float)((b.y >> (8 * k)) & 0xffu)); }
                    } else { f32x4 x0, x1; constexpr float Q = 1.0f / 255.0f;
#pragma unroll
                        for (int k = 0; k < 4; ++k) { x0[k] = (float)((a.x >> (8 * k)) & 0xffu) * Q * acc[ai][bj][m][0][k]; x1[k] = (float)((a.y >> (8 * k)) & 0xffu) * Q * acc[ai][bj][m][1][k]; }
                        *(v4u*)(up + (size_t)row * DM + bj * 128) = pack8(x0, x1); } } }
        return n < 3;
    }
};
struct EpiNull {
    static constexpr bool ROWSCALE = false; typedef pg8::NoRs Rs; static constexpr int VM_OPS = 0;
    static constexpr bool CHAIN = false, PERM = true, AFTER_DRAIN = false;
    float* dummy;
    __device__ __forceinline__ void operator()(const pg8::f32x4 (&acc)[2][2][4][2], const pg8::Unit& u, int wr, int wc, int fr, int fq) const {
        float s = 0.f;
#pragma unroll
        for (int ai = 0; ai < 2; ++ai)
#pragma unroll
            for (int bj = 0; bj < 2; ++bj)
#pragma unroll
                for (int m = 0; m < 4; ++m)
#pragma unroll
                    for (int n = 0; n < 2; ++n) s += acc[ai][bj][m][n][0] + acc[ai][bj][m][n][1] + acc[ai][bj][m][n][2] + acc[ai][bj][m][n][3];
        if (s == 1.2345e-30f) dummy[0] = s;
    }
};
struct EpiFfnInCheap {
    static constexpr bool ROWSCALE = false; typedef pg8::NoRs Rs; static constexpr int VM_OPS = 0;
    static constexpr bool CHAIN = false;
    static constexpr bool PERM = true, AFTER_DRAIN = false;
    const float* ssq; bf16* h2;
    __device__ __forceinline__ void operator()(const pg8::f32x4 (&acc)[2][2][4][2], const pg8::Unit& u, int wr, int wc, int fr, int fq) const {
        const int row0 = u.pm * 256 + wr * 64 + fr, colh = u.pn * 128 + wc * 32 + fq * 8;
#pragma unroll
        for (int ai = 0; ai < 2; ++ai)
#pragma unroll
            for (int m = 0; m < 4; ++m) { const int row = row0 + ai * 128 + m * 16; f32x4 a = acc[ai][0][m][0] + acc[ai][1][m][0], b = acc[ai][0][m][1] + acc[ai][1][m][1];
#if defined(PROBE_K) && PROBE_K == 4
                __builtin_nontemporal_store(pack8(a, b), (v4u*)(h2 + (size_t)row * DFF + colh)); }
#else
                *(v4u*)(h2 + (size_t)row * DFF + colh) = pack8(a, b); }
#endif
    }
};

struct EpiMergeCheap {
    static constexpr bool ROWSCALE = false; typedef pg8::NoRs Rs; static constexpr int VM_OPS = 0;
    static constexpr bool PERM = true, AFTER_DRAIN = false, CHAIN = true;
    bf16* U;
    __device__ __forceinline__ bool chain(pg8::f32x4 (&acc)[2][2][4][2], const pg8::Unit& u, int wr, int wc, int fr, int fq) const {
        const int n = (int)(u.bo / (DM * 256 * 2)); const int row0 = u.pm * 256 + wr * 64 + fr, ct = wc * 32 + fq * 8; bf16* up = U + u.pn * 256 + ct;
        if (n == 3) {
#pragma unroll
            for (int ai = 0; ai < 2; ++ai)
#pragma unroll
                for (int m = 0; m < 4; ++m) { const int row = row0 + ai * 128 + m * 16;
#pragma unroll
                    for (int bj = 0; bj < 2; ++bj) *(v4u*)(up + (size_t)row * DM + bj * 128) = pack8(acc[ai][bj][m][0], acc[ai][bj][m][1]); } }
        return n < 3;
    }
};
namespace att {
constexpr int L_BIAS = 65536;
constexpr int L_MASK = L_BIAS + 4 * 2112 * 4;
constexpr int L_BID = L_MASK + 64 * 65 * 4;
constexpr int L_MISC = L_BID + 2112;
constexpr int L_END = L_MISC + 64;
__device__ __forceinline__ void glds16(const void* gsrc, unsigned lds_dst) { unsigned keep;
    asm volatile("s_mov_b32 %0, m0\n\ts_mov_b32 m0, %2\n\ts_nop 0\n\tglobal_load_lds_dwordx4 %1, off\n\ts_mov_b32 m0, %0" : "=&s"(keep) : "v"(gsrc), "s"(lds_dst) : "memory"); }
__device__ __forceinline__ void glds16s(const void* sbase, unsigned voff, unsigned lds_dst) { unsigned keep;
    asm volatile("s_mov_b32 %0, m0\n\ts_mov_b32 m0, %3\n\ts_nop 0\n\tglobal_load_lds_dwordx4 %1, %2\n\ts_mov_b32 m0, %0" : "=&s"(keep) : "v"(voff), "s"(sbase), "s"(lds_dst) : "memory"); }
__device__ __forceinline__ int crow(int r, int hi) { return (r & 3) + 8 * (r >> 2) + 4 * hi; }
__device__ __forceinline__ float max3f(float a, float b, float c) { float r; asm("v_max3_f32 %0, %1, %2, %3" : "=v"(r) : "v"(a), "v"(b), "v"(c)); return r; }
__device__ __forceinline__ unsigned cvtpk(float lo, float hi) { f32x2_t v = {lo, hi}; bf16x2_t b = __builtin_convertvector(v, bf16x2_t); return __builtin_bit_cast(unsigned, b); }
typedef short v4i16_t __attribute__((ext_vector_type(4)));
__device__ __forceinline__ s16x4 vtr(const LAS unsigned char* p) { return __builtin_bit_cast(s16x4, __builtin_amdgcn_ds_read_tr16_b64_v4i16((LAS v4i16_t*)p)); }
#define ATT_WAIT_BAR() asm volatile("s_waitcnt vmcnt(0) lgkmcnt(0)\n\ts_barrier" ::: "memory")
#define ATT_WAIT_BAR_N(N) asm volatile("s_waitcnt vmcnt(" #N ") lgkmcnt(0)\n\ts_barrier" ::: "memory")

struct Unit { int kind, b, h, qt, g, r; };
constexpr int NU_BIG = 768, NU_D0 = 256, NU_D1 = 256, NU_D2 = 512, NU_TOTAL = NU_BIG + NU_D0 + NU_D1 + NU_D2;
__device__ __forceinline__ Unit decode(int idx) {
    Unit u{};
    if (idx < NU_BIG) { const int level = 7 - idx / 96, k = idx % 96;
        if (k < 32) { u.kind = 2; u.b = k >> 2; u.h = k & 3; u.qt = level; }
        else if (k < 64) { u.kind = 1; u.b = (k - 32) >> 2; u.h = k & 3; u.qt = level; }
        else { u.kind = 0; u.b = (k - 64) >> 2; u.qt = 4 * level + 3 - (k & 3); }
        return u; }
    idx -= NU_BIG; u.kind = 3;
    if (idx < NU_D0) { u.g = 0; u.r = 0; u.b = idx >> 5; u.h = (idx >> 3) & 3; u.qt = 7 - (idx & 7); return u; }
    idx -= NU_D0;
    if (idx < NU_D1) { u.g = 1; u.b = idx >> 5; u.h = (idx >> 3) & 3; u.r = (idx >> 1) & 3; u.qt = 1 - (idx & 1); return u; }
    idx -= NU_D1; u.g = 2; u.b = idx >> 6; u.h = (idx >> 4) & 3; u.r = idx & 15; u.qt = 0; return u;
}

template <int KIND> __device__ __forceinline__ void run_unit(unsigned char* ws, LAS unsigned char* lds, const Unit u, const bool dry, unsigned* queue, const bool ahead) {
    constexpr int DQK = (KIND == 2) ? 96 : 64, ND0 = DQK / 16, NCH = DQK / 8;
    int tid_ = threadIdx.x; asm volatile("" : "+v"(tid_));
    const int tid = tid_, lane = tid & 63, r32 = lane & 31, hi = lane >> 5, w = __builtin_amdgcn_readfirstlane(tid >> 6);
    const bf16* const tiles = (const bf16*)(ws + WS_R);
    unsigned pre = 0u; if (ahead && tid == 0) pre = __hip_atomic_fetch_add(queue, 1u, __ATOMIC_RELAXED, __HIP_MEMORY_SCOPE_AGENT);
    const int brow = u.b * SEQ;
    const bf16 *Qp, *Kb, *Vb; bf16* Op; int ldq, ldk, ldv, ldo;
    int tq;
    int kt0, kt1;
    int dil = 1, rr = 0, jb = 0;
    const int head = (KIND == 0) ? (w >> 1) : u.h;
    if constexpr (KIND == 0) { tq = 64 * u.qt + 32 * (w & 1) + r32; ldq = ldk = ldv = ldo = 256;
        Qp = tiles + (size_t)(brow + tq) * 256 + head * 64; Op = (bf16*)Qp; Kb = tiles + (size_t)1 * MH * 256 + (size_t)brow * 256; Vb = Kb + 64; kt0 = 0; kt1 = u.qt; }
    if constexpr (KIND == 1) { tq = 256 * u.qt + 32 * w + r32; ldq = ldk = ldv = ldo = 256;
        Qp = tiles + (size_t)5 * MH * 256 + (size_t)(brow + tq) * 256 + head * 64; Op = (bf16*)Qp; Kb = tiles + (size_t)6 * MH * 256 + (size_t)brow * 256 + head * 64; Vb = tiles + (size_t)7 * MH * 256 + (size_t)brow * 256 + head * 64; kt0 = 0; kt1 = 4 * u.qt + 3; }
    if constexpr (KIND == 2) { tq = 256 * u.qt + 32 * w + r32; ldq = ldk = 384; ldv = ldo = 256;
        Qp = (const bf16*)(ws + WS_QN) + (size_t)(brow + tq) * 384 + head * 96; Op = (bf16*)(ws + WS_OC) + (size_t)(brow + tq) * 256 + head * 64; Kb = (const bf16*)(ws + WS_KN) + (size_t)brow * 384 + head * 96; Vb = (const bf16*)(ws + WS_VC) + (size_t)brow * 256 + head * 64; kt0 = 0; kt1 = 4 * u.qt + 3; }
    if constexpr (KIND == 3) { dil = u.g == 0 ? 1 : u.g == 1 ? 4 : 16; rr = u.r; tq = 256 * u.qt + 32 * w + r32; ldq = ldk = ldv = ldo = 256; jb = 256 * u.qt - 128;
        const int tok = (tq < SEQ / dil ? tq : 0) * dil + rr;
        Qp = tiles + (size_t)(8 + u.g) * MH * 256 + (size_t)(brow + tok) * 256 + head * 64; Op = (bf16*)Qp; Kb = tiles + (size_t)(11 + u.g) * MH * 256 + (size_t)brow * 256 + head * 64; Vb = tiles + (size_t)(14 + u.g) * MH * 256 + (size_t)brow * 256 + head * 64;
        kt0 = (u.qt == 0) ? 2 : 0; kt1 = (u.g == 2) ? 3 : 5; }
    const bool wave_on = (KIND != 3) || (256 * u.qt + 32 * w < SEQ / dil);
    bf16x8 qr[ND0];
#pragma unroll
    for (int d0 = 0; d0 < ND0; ++d0) qr[d0] = *(const bf16x8*)(Qp + 16 * d0 + 8 * hi);
    LAS float* btab = (LAS float*)(lds + L_BIAS);
    if constexpr (KIND == 0) { const v4u* src = (const v4u*)(ws + WS_BIAS); v4u tv[5];
#pragma unroll
        for (int j = 0; j < 5; ++j) { const int i = tid + NTHR * j; tv[j] = src[i < 2112 ? i : 2111]; }
#pragma unroll
        for (int j = 0; j < 5; ++j) { const int i = tid + NTHR * j; if (i < 2112) *(LAS v4u*)((LAS unsigned char*)btab + 16 * i) = tv[j]; } }
    if constexpr (KIND == 1) { const float* src = (const float*)(ws + WS_BIAS) + (4 + head) * 2112; for (int i = tid; i < 2112; i += NTHR) btab[i] = src[i]; }
    if constexpr (KIND == 3) { const float* src = (const float*)(ws + WS_BIASD) + (u.g * 4 + head) * 192; if (tid < 256) btab[tid] = tid >= 64 ? src[tid - 64] : 0.f; }
    if constexpr (KIND == 0 || KIND == 1) { if (tid < 132) *(LAS v4u*)(lds + L_BID + 16 * tid) = *(const v4u*)(ws + WS_BID + 16 * tid); }
    unsigned selmask = 0u;
    if constexpr (KIND == 1) {
        const int own = u.qt; const float* km = (const float*)(ws + WS_KMEAN) + (size_t)(u.b * 8) * 256 + head * 64;
        float gate[8];
#pragma unroll
        for (int n = 0; n < 8; ++n) { float a = 0.f;
            if (n < own) {
#pragma unroll
                for (int d0 = 0; d0 < 4; ++d0)
#pragma unroll
                    for (int j = 0; j < 8; ++j) a += bf2f((bf16)qr[d0][j]) * km[n * 256 + 16 * d0 + 8 * hi + j];
                a = xsum32(a); } else a = -INFINITY;
            gate[n] = a; }
#pragma unroll
        for (int rnd = 0; rnd < 3; ++rnd) { int best = -1; float bv = 0.f;
#pragma unroll
            for (int n = 0; n < 8; ++n) { const bool ok = !((selmask >> n) & 1u) && (best < 0 || gate[n] > bv); if (ok) { best = n; bv = gate[n]; } }
            selmask |= 1u << best; }
        selmask &= (1u << own) - 1u;
        if (tid == 0) ((volatile LAS unsigned*)(lds + L_MISC))[1] = 0u;
    }
    const unsigned lds0 = (unsigned)(uintptr_t)lds;
    constexpr int KS = (DQK == 96) ? 12288 : 8192, L_VR = 4 * KS;
    auto tokof = [&](int kt, int j) -> int { if constexpr (KIND == 3) { int jj = jb + 64 * kt + j; jj = jj < 0 ? 0 : jj; return jj * dil + rr; } else return 64 * kt + j; };
    const unsigned voK = (unsigned)(lane * ldk * 2), voV = (unsigned)(((16 * (w & 3) + (lane >> 2)) * ldv + (lane & 3) * 8) * 2);
    auto dmaK = [&](int kt, int slot) {
        if constexpr (KIND == 3) { const int tk = tokof(kt, lane);
            glds16(Kb + (size_t)tk * ldk + w * 8, (unsigned)__builtin_amdgcn_readfirstlane(lds0 + slot * KS + w * 1024)); }
        else { const char* sb = (const char*)Kb + (size_t)kt * (size_t)(64 * 2) * ldk + w * 16;
            glds16s(sb, voK, (unsigned)__builtin_amdgcn_readfirstlane(lds0 + slot * KS + w * 1024));
            if (DQK == 96) glds16s(sb + ((8 + (w & 3)) - w) * 16, voK, (unsigned)__builtin_amdgcn_readfirstlane(lds0 + slot * KS + (8 + (w & 3)) * 1024)); }
    };
    auto dmaV = [&](int kt, int slot) {
        if constexpr (KIND == 3) { const int tv = tokof(kt, 16 * (w & 3) + (lane >> 2));
            glds16(Vb + (size_t)tv * ldv + (w >> 2) * 32 + (lane & 3) * 8, (unsigned)__builtin_amdgcn_readfirstlane(lds0 + L_VR + slot * 8192 + w * 1024)); }
        else glds16s((const char*)Vb + (size_t)kt * (size_t)(64 * 2) * ldv + (w >> 2) * 64, voV, (unsigned)__builtin_amdgcn_readfirstlane(lds0 + L_VR + slot * 8192 + w * 1024));
    };
    if constexpr (KIND == 0) {
        const unsigned long long* msrc = (const unsigned long long*)(ws + WS_MASK) + (size_t)((brow + 64 * u.qt) >> 2) * 128; LAS unsigned* mdst = (LAS unsigned*)(lds + L_MASK); const int nw = 2 * (u.qt + 1);
        for (int i = tid; i < 64 * 64; i += NTHR) { const int q = i >> 6, wi = i & 63; if (wi < nw) { const unsigned long long b0 = msrc[(size_t)(q >> 2) * 128 + 2 * wi], b1 = msrc[(size_t)(q >> 2) * 128 + 2 * wi + 1]; const int sh = 16 * (q & 3);
                mdst[q * 65 + wi] = ((unsigned)(b0 >> sh) & 0xffffu) | (((unsigned)(b1 >> sh) & 0xffffu) << 16); } } }
    if constexpr (KIND == 1) { __syncthreads(); if (selmask) (void)__hip_atomic_fetch_or((LAS unsigned*)(lds + L_MISC) + 1, selmask, __ATOMIC_RELAXED, __HIP_MEMORY_SCOPE_WORKGROUP); }
    __syncthreads();
    unsigned umask = 0xffffffffu; if constexpr (KIND == 1) umask = ((volatile LAS unsigned*)(lds + L_MISC))[1];
    asm volatile("s_waitcnt vmcnt(0)" ::: "memory");
#pragma unroll
    for (int d0 = 0; d0 < ND0; ++d0) asm volatile("" : "+v"(qr[d0]));
    asm volatile("" : "+v"(pre)); if (ahead && tid == 0) ((volatile LAS unsigned*)(lds + L_MISC))[2] = pre;
    float mrun = -1e30f; f32x16 o[2], lacc;
#pragma unroll
    for (int i = 0; i < 16; ++i) { o[0][i] = 0.f; o[1][i] = 0.f; lacc[i] = 0.f; }
    const bf16x8 ones = (bf16x8){0x3f80, 0x3f80, 0x3f80, 0x3f80, 0x3f80, 0x3f80, 0x3f80, 0x3f80};
    const LAS unsigned* mrow = (const LAS unsigned*)(lds + L_MASK) + (32 * (w & 1) + r32) * 65;
    auto tile_needed = [&](int kt) -> bool { if constexpr (KIND == 1) { const int blk = kt >> 2; return blk == u.qt || ((umask >> blk) & 1u); } else return true; };
    auto next_tile = [&](int t) -> int { ++t; while (t <= kt1 && !tile_needed(t)) ++t; return t; };
    auto blk_code = [&](int kt, int b) -> int {
        if (!wave_on) return 3;
        if constexpr (KIND == 0) { const int d = 2 * (kt - u.qt) + b - (w & 1); return d < 0 ? 0 : d == 0 ? 1 : 3; }
        if constexpr (KIND == 1) { const int blk = kt >> 2; if (blk == u.qt) { const int d = 2 * (kt & 3) + b - w; return d < 0 ? 0 : d == 0 ? 1 : 3; } return __any((selmask >> blk) & 1u) ? 0 : 3; }
        if constexpr (KIND == 2) { const int d = 2 * kt + b - (8 * u.qt + w); return d < 0 ? 0 : d == 0 ? 1 : 3; }
        if constexpr (KIND == 3) { const int d = 2 * kt + b - w; if (d < 0 || d > 4 || (jb + 64 * kt + 32 * b < 0)) return 3; return d == 4 ? 1 : d == 0 ? 2 : 0; }
        return 0; };
    auto qk = [&](int kslot, f32x16& p0, f32x16& p1) {
        const LAS unsigned char* Ks = lds + kslot * KS;
        bf16x8 kf[ND0][2];
#pragma unroll
        for (int d0 = 0; d0 < ND0; ++d0) { kf[d0][0] = *(const LAS bf16x8*)(Ks + (2 * d0 + hi) * 1024 + r32 * 16); kf[d0][1] = *(const LAS bf16x8*)(Ks + (2 * d0 + hi) * 1024 + 512 + r32 * 16); }
        __builtin_amdgcn_sched_barrier(0);
#pragma unroll
        for (int i = 0; i < 16; ++i) { p0[i] = 0.f; p1[i] = 0.f; }
#pragma unroll
        for (int d0 = 0; d0 < ND0; ++d0) { p0 = __builtin_amdgcn_mfma_f32_32x32x16_bf16(kf[d0][0], qr[d0], p0, 0, 0, 0); p1 = __builtin_amdgcn_mfma_f32_32x32x16_bf16(kf[d0][1], qr[d0], p1, 0, 0, 0); }
        __builtin_amdgcn_sched_barrier(0); };
    auto sm_pv = [&](int kt, int vslot, int c0, int c1, f32x16& p0, f32x16& p1) {
        const LAS unsigned char* Vs = lds + L_VR + vslot * 8192;
        float cadd = 0.f;
        if constexpr (KIND == 0 || KIND == 1) { const int tqw = tq - r32; int dmin = tqw - 64 * kt - 63, dmax = tqw + 31 - 64 * kt; dmin = dmin < 0 ? 0 : dmin; dmax = dmax < 0 ? 0 : dmax;
            const LAS unsigned char* bid = lds + L_BID + 64; const LAS float* bth = btab + (KIND == 0 ? head * 2112 : 0) + 64;
            if (bid[dmin] == bid[dmax]) cadd = bth[dmin];
            else { const LAS float* bt = bth + (tq - 64 * kt - 4 * hi);
#pragma unroll
                for (int i = 0; i < 16; ++i) { p0[i] += bt[-((i & 3) + 8 * (i >> 2))]; p1[i] += bt[-32 - ((i & 3) + 8 * (i >> 2))]; } }
            if constexpr (KIND == 1) { const int blk = kt >> 2; if (blk != u.qt && !((selmask >> blk) & 1u)) cadd = -INFINITY; } }
        if constexpr (KIND == 3) { const LAS float* bt = btab + 64 + (tq - (jb + 64 * kt + 4 * hi));
#pragma unroll
            for (int i = 0; i < 16; ++i) { p0[i] += bt[-((i & 3) + 8 * (i >> 2))]; p1[i] += bt[-32 - ((i & 3) + 8 * (i >> 2))]; } }
        if (c0 | c1) {
            const int lo0 = (c0 == 2 ? r32 : c0 == 3 ? 64 : 0) - 4 * hi, hi0 = (c0 == 1 ? r32 : c0 == 3 ? -1 : 63) - 4 * hi;
            const int lo1 = (c1 == 2 ? r32 : c1 == 3 ? 64 : 0) - 4 * hi, hi1 = (c1 == 1 ? r32 : c1 == 3 ? -1 : 63) - 4 * hi;
#pragma unroll
            for (int i = 0; i < 16; ++i) { const int c = (i & 3) + 8 * (i >> 2);
                p0[i] = (c < lo0 || c > hi0) ? -INFINITY : p0[i];
                p1[i] = (c < lo1 || c > hi1) ? -INFINITY : p1[i]; } }
        float mxa = max3f(p0[0], p0[1], p1[0]), mxb = max3f(p0[2], p0[3], p1[1]); mxa = max3f(mxa, p1[2], p1[3]);
#pragma unroll
        for (int i = 4; i < 16; i += 4) { mxa = max3f(mxa, p0[i], p0[i + 1]); mxb = max3f(mxb, p0[i + 2], p0[i + 3]); mxa = max3f(mxa, p1[i], p1[i + 1]); mxb = max3f(mxb, p1[i + 2], p1[i + 3]); }
        float mx = xmax32(max3f(mxa, mxb, mxb)) + cadd;
        const float mnew = (mx > mrun + 6.0f) ? mx : mrun;
        if (__any(mnew > mrun)) { const float al = __builtin_amdgcn_exp2f(mrun - mnew);
#pragma unroll
            for (int i = 0; i < 16; ++i) { o[0][i] *= al; o[1][i] *= al; lacc[i] *= al; } }
        mrun = mnew; const float sub = cadd - mnew;
        int w0 = 0, w1 = 0; if constexpr (KIND == 0) { w0 = (int)(mrow[2 * kt] >> (4 * hi)); w1 = (int)(mrow[2 * kt + 1] >> (4 * hi)); }
        s16x4 vlo[4][2], vhh[4][2];
#pragma unroll
        for (int s = 0; s < 4; ++s)
#pragma unroll
            for (int db = 0; db < 2; ++db) { const LAS unsigned char* vp = Vs + db * 4096 + s * 1024 + ((lane >> 4) & 1) * 32 + (lane & 3) * 8 + (4 * hi + ((lane & 15) >> 2)) * 64; vlo[s][db] = vtr(vp); vhh[s][db] = vtr(vp + 512); }
#pragma unroll
        for (int s = 0; s < 4; ++s) { float e[8];
#pragma unroll
            for (int j = 0; j < 8; ++j) { const float x = (s < 2) ? p0[8 * s + j] : p1[8 * s - 16 + j]; e[j] = __builtin_amdgcn_exp2f(x + sub); }
            if constexpr (KIND == 0) { const int ww = (s < 2) ? w0 : w1;
#pragma unroll
                for (int j = 0; j < 8; ++j) { const int i = (8 * s + j) & 15, bp = (i & 3) + 8 * (i >> 2); e[j] = __int_as_float(__float_as_int(e[j]) & __builtin_amdgcn_sbfe(ww, bp, 1)); } }
            v4u pw; pw.x = cvtpk(e[0], e[1]); pw.y = cvtpk(e[2], e[3]); pw.z = cvtpk(e[4], e[5]); pw.w = cvtpk(e[6], e[7]);
            const bf16x8 pf = __builtin_bit_cast(bf16x8, pw);
            __builtin_amdgcn_sched_barrier(0);
            lacc = __builtin_amdgcn_mfma_f32_32x32x16_bf16(ones, pf, lacc, 0, 0, 0);
#pragma unroll
            for (int db = 0; db < 2; ++db) { const bf16x8 vf = (bf16x8){vlo[s][db][0], vlo[s][db][1], vlo[s][db][2], vlo[s][db][3], vhh[s][db][0], vhh[s][db][1], vhh[s][db][2], vhh[s][db][3]};
                o[db] = __builtin_amdgcn_mfma_f32_32x32x16_bf16(vf, pf, o[db], 0, 0, 0); }
            __builtin_amdgcn_sched_barrier(0); }
        __builtin_amdgcn_sched_barrier(0); };
#if defined(PROBE_MODE) && PROBE_MODE == 3
    const bool PM_QK = true, PM_SM = !dry;
#elif defined(PROBE_MODE) && PROBE_MODE == 4
    const bool PM_QK = !dry, PM_SM = true;
#elif defined(PROBE_MODE) && PROBE_MODE == 5
    const bool PM_QK = !dry, PM_SM = !dry;
#else
    const bool PM_QK = true, PM_SM = true;
#endif
    constexpr int NOPS = (DQK == 96) ? 3 : 2;
    int cur = next_tile(kt0 - 1), n1 = cur <= kt1 ? next_tile(cur) : cur, n2 = n1 <= kt1 ? next_tile(n1) : n1, n3 = n2 <= kt1 ? next_tile(n2) : n2;
    dmaK(cur, 0);
    if (n1 <= kt1) dmaK(n1, 1);
    dmaV(cur, 0);
    if (n3 <= kt1) { dmaK(n2, 2); dmaV(n1, 1); dmaK(n3, 3); dmaV(n2, 2); if (NOPS == 3) ATT_WAIT_BAR_N(6); else ATT_WAIT_BAR_N(4); }
    else { if (n2 <= kt1) { dmaK(n2, 2); dmaV(n1, 1); dmaV(n2, 2); } else if (n1 <= kt1) dmaV(n1, 1); ATT_WAIT_BAR(); }
    int ks_cur = 0, vs_cur = 0;
    f32x16 sa0, sa1, sb0, sb1;
    { const int c0 = blk_code(cur, 0), c1 = blk_code(cur, 1); if (c0 != 3 || c1 != 3) qk(0, sa0, sa1); }
#define ATT_STEP(x0, x1, y0, y1) { \
        const int n4 = n3 <= kt1 ? next_tile(n3) : n3; \
        const int ks_n1 = (ks_cur + 1) & 3, vs_n3 = (vs_cur + 3) & 3; \
        if (n4 <= kt1) { dmaK(n4, ks_cur); dmaV(n3, vs_n3); } else if (n3 <= kt1) dmaV(n3, vs_n3); \
        const int c0 = blk_code(cur, 0), c1 = blk_code(cur, 1); \
        if (n1 <= kt1 && PM_QK) { const int e0 = blk_code(n1, 0), e1 = blk_code(n1, 1); if (e0 != 3 || e1 != 3) qk(ks_n1, y0, y1); } \
        if ((c0 != 3 || c1 != 3) && PM_SM) sm_pv(cur, vs_cur, c0, c1, x0, x1); \
        if (n4 <= kt1) { if (NOPS == 3) ATT_WAIT_BAR_N(6); else ATT_WAIT_BAR_N(4); } else ATT_WAIT_BAR(); \
        cur = n1; n1 = n2; n2 = n3; n3 = n4; ks_cur = ks_n1; vs_cur = (vs_cur + 1) & 3; }
#if defined(PROBE_MODE) && PROBE_MODE == 6
    if (dry) cur = kt1 + 1;
#endif
    while (cur <= kt1) { ATT_STEP(sa0, sa1, sb0, sb1); if (cur > kt1) break; ATT_STEP(sb0, sb1, sa0, sa1); }
#undef ATT_STEP
    if (dry) Op = (bf16*)(ws + WS_END) + (size_t)(tq & 2047) * 256 + head * 64;
    const float lt = lacc[0]; const float inv = 1.0f / lt;
    if (wave_on) {
#pragma unroll
        for (int db = 0; db < 2; ++db)
#pragma unroll
            for (int k2 = 0; k2 < 2; ++k2) { v2u pa, pb; pa.x = cvtpk(o[db][8 * k2] * inv, o[db][8 * k2 + 1] * inv); pa.y = cvtpk(o[db][8 * k2 + 2] * inv, o[db][8 * k2 + 3] * inv); pb.x = cvtpk(o[db][8 * k2 + 4] * inv, o[db][8 * k2 + 5] * inv); pb.y = cvtpk(o[db][8 * k2 + 6] * inv, o[db][8 * k2 + 7] * inv);
                const v4u st = pair16(pa, pb); if (wave_on) *(v4u*)(Op + 32 * db + 16 * k2 + 8 * hi) = st; }
        if constexpr (KIND == 3) { if (hi == 0 && !dry) { const int tok = tq * dil + rr; ((float*)(ws + WS_LSED))[(size_t)(brow + tok) * 16 + u.g * 4 + head] = mrun + log2f(lt); } }
    }
    __syncthreads();
}

__device__ __forceinline__ void phase(unsigned char* ws, LAS unsigned char* lds, unsigned* queue, const bool dry = false, const unsigned kmask = 15u) {
    if (threadIdx.x == 0) ((volatile LAS unsigned*)(lds + L_MISC))[2] = __hip_atomic_fetch_add(queue, 1u, __ATOMIC_RELAXED, __HIP_MEMORY_SCOPE_AGENT);
    for (;;) {
        __syncthreads();
        const int idx = (int)((volatile LAS unsigned*)(lds + L_MISC))[2];
        __syncthreads();
        if (idx >= NU_TOTAL) break;
        const bool ahead = idx < NU_TOTAL - 512;
        const Unit u = decode(idx);
        if ((kmask >> u.kind) & 1u) {
            if (u.kind == 0) run_unit<0>(ws, lds, u, dry, queue, ahead); else if (u.kind == 1) run_unit<1>(ws, lds, u, dry, queue, ahead); else if (u.kind == 2) run_unit<2>(ws, lds, u, dry, queue, ahead); else run_unit<3>(ws, lds, u, dry, queue, ahead);
            if (!ahead && threadIdx.x == 0) ((volatile LAS unsigned*)(lds + L_MISC))[2] = __hip_atomic_fetch_add(queue, 1u, __ATOMIC_RELAXED, __HIP_MEMORY_SCOPE_AGENT);
        } else if (threadIdx.x == 0) ((volatile LAS unsigned*)(lds + L_MISC))[2] = __hip_atomic_fetch_add(queue, 1u, __ATOMIC_RELAXED, __HIP_MEMORY_SCOPE_AGENT);
    }
}
}
#ifndef SEL_NPASS
#define SEL_NPASS 4
#endif
namespace prep {
constexpr int LQ = 392, LKV = 264;
constexpr int L_CQ = 0, L_CKV = 64 * LQ * 2;
constexpr int L_MISC = 131072 - 64;
constexpr int NU_SEL = HBAT * 64, NU_MLA = MH / 64, NU_KM = HBAT * 8, NU_GEMM = MH / 256, NU_TOTAL = NU_GEMM + NU_SEL + NU_MLA + NU_KM;
__device__ __forceinline__ unsigned fkeyu(float f) { const unsigned u = __float_as_uint(f); return (u & 0x80000000u) ? ~u : (u | 0x80000000u); }

__device__ __forceinline__ void mla_unit(unsigned char* ws, LAS unsigned char* lds, int l, int unit, const float* qk_c, const unsigned pv = 0u) {
    int tid_ = threadIdx.x; asm volatile("" : "+v"(tid_));
    const int tid = tid_, lane = tid & 63, r32 = lane & 31, hi = lane >> 5, w = __builtin_amdgcn_readfirstlane(tid >> 6), row0 = unit * 64;
    { const bf16* cql = (const bf16*)(ws + WS_CQL) + (size_t)row0 * 384; const bf16* ckvl = (const bf16*)(ws + WS_CKVL) + (size_t)row0 * 256;
#pragma unroll
      for (int i = 0; i < 6; ++i) { const int c = tid + 512 * i, r = c / 48, ch = c % 48; *(LAS v4u*)(lds + L_CQ + (r * LQ + ch * 8) * 2) = *(const v4u*)(cql + (size_t)r * 384 + ch * 8); }
#pragma unroll
      for (int i = 0; i < 4; ++i) { const int c = tid + 512 * i, r = c >> 5, ch = c & 31; *(LAS v4u*)(lds + L_CKV + (r * LKV + ch * 8) * 2) = *(const v4u*)(ckvl + (size_t)r * 256 + ch * 8); } }
    __syncthreads();
    const float* ssl = (const float*)(ws + WS_SSL); const float* rope = (const float*)(ws + WS_ROPE); const bf16* xs = (const bf16*)(ws + WS_XS);
    if (w < 4) {
        const int h = w; const bf16* wt = (const bf16*)(ws + WS_WUQ) + (size_t)l * 384 * 384 + (size_t)(h * 96) * 384;
        f32x16 acc[3][2];
#pragma unroll
        for (int a = 0; a < 3; ++a)
#pragma unroll
            for (int b = 0; b < 2; ++b)
#pragma unroll
                for (int i = 0; i < 16; ++i) acc[a][b][i] = 0.f;
        bf16x8 wf[3][6];
        const bf16* wl = wt + (size_t)lane * 8;
#define MLQ_ISSUE(st, pr) { _Pragma("unroll") for (int nb = 0; nb < 3; ++nb) { \
            asm volatile("global_load_dwordx4 %0, %1, off" : "=v"(wf[st][nb]) : "v"(wl + (size_t)((2 * (pr)) * 3 + nb) * 512) : "memory"); \
            asm volatile("global_load_dwordx4 %0, %1, off" : "=v"(wf[st][3 + nb]) : "v"(wl + (size_t)((2 * (pr) + 1) * 3 + nb) * 512) : "memory"); } }
#define MLQ_COMPUTE(st, pr) { bf16x8 bfr[2], bgr[2]; \
            _Pragma("unroll") for (int tb = 0; tb < 2; ++tb) { bfr[tb] = *(const LAS bf16x8*)(lds + L_CQ + ((32 * tb + r32) * LQ + 32 * (pr) + 8 * hi) * 2); bgr[tb] = *(const LAS bf16x8*)(lds + L_CQ + ((32 * tb + r32) * LQ + 32 * (pr) + 16 + 8 * hi) * 2); } \
            _Pragma("unroll") for (int nb = 0; nb < 3; ++nb) _Pragma("unroll") for (int tb = 0; tb < 2; ++tb) acc[nb][tb] = __builtin_amdgcn_mfma_f32_32x32x16_bf16(wf[st][nb], bfr[tb], acc[nb][tb], 0, 0, 0); \
            _Pragma("unroll") for (int nb = 0; nb < 3; ++nb) _Pragma("unroll") for (int tb = 0; tb < 2; ++tb) acc[nb][tb] = __builtin_amdgcn_mfma_f32_32x32x16_bf16(wf[st][3 + nb], bgr[tb], acc[nb][tb], 0, 0, 0); }
        asm volatile("s_waitcnt vmcnt(0)" ::: "memory");
        if (!(pv & 2u)) {
        MLQ_ISSUE(0, 0); MLQ_ISSUE(1, 1);
#pragma unroll
        for (int pr = 0; pr < 12; ++pr) {
            if (pr + 2 < 12) { MLQ_ISSUE((pr + 2) % 3, pr + 2); asm volatile("s_waitcnt vmcnt(12)" ::: "memory"); }
            else if (pr + 1 < 12) asm volatile("s_waitcnt vmcnt(6)" ::: "memory"); else asm volatile("s_waitcnt vmcnt(0)" ::: "memory");
#pragma unroll
            for (int k = 0; k < 6; ++k) asm volatile("" : "+v"(wf[pr % 3][k]));
            MLQ_COMPUTE(pr % 3, pr);
        }
        }
#undef MLQ_ISSUE
#undef MLQ_COMPUTE
        bf16* QN = (bf16*)(ws + WS_QN);
        if (!(pv & 1u))
#pragma unroll
        for (int tb = 0; tb < 2; ++tb) { const int row = row0 + 32 * tb + r32, t = row % SEQ; const float* sp = ssl + (size_t)row * 16;
            const float slat = rsqrtf(((sp[0] + sp[1]) + (sp[2] + sp[3]) + (sp[4] + sp[5])) * (1.0f / 384.0f) + EPS);
            float ss = 0.f;
#pragma unroll
            for (int nb = 0; nb < 3; ++nb)
#pragma unroll
                for (int i = 0; i < 16; ++i) { const float v = acc[nb][tb][i] * slat; acc[nb][tb][i] = v; ss += v * v; }
            ss = xsum32(ss); const float hs = rsqrtf(ss * (1.0f / 96.0f) + EPS) * C2C;
#pragma unroll
            for (int nb = 0; nb < 3; ++nb)
#pragma unroll
                for (int i = 0; i < 16; ++i) acc[nb][tb][i] *= hs * qk_c[32 * nb + att::crow(i, hi)];
#pragma unroll
            for (int i = 0; i < 8; ++i) { const int j = att::crow(i, hi); const float c = rope[t * 16 + j], s = rope[SEQ * 16 + t * 16 + j]; const float x1 = acc[2][tb][i], x2 = acc[2][tb][i + 8]; acc[2][tb][i] = x1 * c - x2 * s; acc[2][tb][i + 8] = x1 * s + x2 * c; }
#pragma unroll
            for (int nb = 0; nb < 3; ++nb)
#pragma unroll
                for (int k2 = 0; k2 < 2; ++k2) { v2u pa, pb; pa.x = pk2(acc[nb][tb][8 * k2], acc[nb][tb][8 * k2 + 1]); pa.y = pk2(acc[nb][tb][8 * k2 + 2], acc[nb][tb][8 * k2 + 3]); pb.x = pk2(acc[nb][tb][8 * k2 + 4], acc[nb][tb][8 * k2 + 5]); pb.y = pk2(acc[nb][tb][8 * k2 + 6], acc[nb][tb][8 * k2 + 7]);
                    *(v4u*)(QN + (size_t)row * 384 + h * 96 + 32 * nb + 16 * k2 + 8 * hi) = pair16(pa, pb); } }
    } else {
        const int h = w - 4; const bf16* wt = (const bf16*)(ws + WS_WUKV) + (size_t)l * 512 * 256 + (size_t)(h * 128) * 256;
        f32x16 acc[4][2];
#pragma unroll
        for (int a = 0; a < 4; ++a)
#pragma unroll
            for (int b = 0; b < 2; ++b)
#pragma unroll
                for (int i = 0; i < 16; ++i) acc[a][b][i] = 0.f;
        bf16x8 wf[4][4];
        const bf16* wl = wt + (size_t)lane * 8;
#define MLK_ISSUE(st, ks) { _Pragma("unroll") for (int nb = 0; nb < 4; ++nb) asm volatile("global_load_dwordx4 %0, %1, off" : "=v"(wf[st][nb]) : "v"(wl + (size_t)((ks) * 4 + nb) * 512) : "memory"); }
        asm volatile("s_waitcnt vmcnt(0)" ::: "memory");
        if (!(pv & 2u)) {
        MLK_ISSUE(0, 0); MLK_ISSUE(1, 1); MLK_ISSUE(2, 2);
#pragma unroll
        for (int ks = 0; ks < 16; ++ks) {
            if (ks + 3 < 16) { MLK_ISSUE((ks + 3) % 4, ks + 3); asm volatile("s_waitcnt vmcnt(12)" ::: "memory"); }
            else if (ks + 2 < 16) asm volatile("s_waitcnt vmcnt(8)" ::: "memory"); else if (ks + 1 < 16) asm volatile("s_waitcnt vmcnt(4)" ::: "memory"); else asm volatile("s_waitcnt vmcnt(0)" ::: "memory");
#pragma unroll
            for (int k = 0; k < 4; ++k) asm volatile("" : "+v"(wf[ks % 4][k]));
            bf16x8 bfr[2];
#pragma unroll
            for (int tb = 0; tb < 2; ++tb) bfr[tb] = *(const LAS bf16x8*)(lds + L_CKV + ((32 * tb + r32) * LKV + 16 * ks + 8 * hi) * 2);
#pragma unroll
            for (int nb = 0; nb < 4; ++nb)
#pragma unroll
                for (int tb = 0; tb < 2; ++tb) acc[nb][tb] = __builtin_amdgcn_mfma_f32_32x32x16_bf16(wf[ks % 4][nb], bfr[tb], acc[nb][tb], 0, 0, 0);
        }
        }
#undef MLK_ISSUE
        bf16* KN = (bf16*)(ws + WS_KN); bf16* VC = (bf16*)(ws + WS_VC);
        if (!(pv & 1u))
#pragma unroll
        for (int tb = 0; tb < 2; ++tb) { const int row = row0 + 32 * tb + r32, t = row % SEQ; const float* sp = ssl + (size_t)row * 16;
            const float slat = rsqrtf(((sp[6] + sp[7]) + (sp[8] + sp[9])) * (1.0f / 256.0f) + EPS);
            float kr[16]; float ss = 0.f;
#pragma unroll
            for (int g4 = 0; g4 < 4; ++g4) { const v2u v = *(const v2u*)(xs + (size_t)row * 128 + 32 + 8 * g4 + 4 * hi); kr[4 * g4] = __uint_as_float(v.x << 16); kr[4 * g4 + 1] = __uint_as_float(v.x & 0xffff0000u); kr[4 * g4 + 2] = __uint_as_float(v.y << 16); kr[4 * g4 + 3] = __uint_as_float(v.y & 0xffff0000u); }
#pragma unroll
            for (int i = 0; i < 16; ++i) ss += kr[i] * kr[i];
#pragma unroll
            for (int nb = 0; nb < 2; ++nb)
#pragma unroll
                for (int i = 0; i < 16; ++i) { const float v = acc[nb][tb][i] * slat; acc[nb][tb][i] = v; ss += v * v; }
            ss = xsum32(ss); const float hs = rsqrtf(ss * (1.0f / 96.0f) + EPS);
#pragma unroll
            for (int nb = 0; nb < 2; ++nb)
#pragma unroll
                for (int i = 0; i < 16; ++i) acc[nb][tb][i] *= hs * qk_c[96 + 32 * nb + att::crow(i, hi)];
#pragma unroll
            for (int i = 0; i < 16; ++i) kr[i] *= hs * qk_c[96 + 64 + att::crow(i, hi)];
#pragma unroll
            for (int i = 0; i < 8; ++i) { const int j = att::crow(i, hi); const float c = rope[t * 16 + j], s = rope[SEQ * 16 + t * 16 + j]; const float x1 = kr[i], x2 = kr[i + 8]; kr[i] = x1 * c - x2 * s; kr[i + 8] = x1 * s + x2 * c; }
#pragma unroll
            for (int k2 = 0; k2 < 2; ++k2) {
#pragma unroll
                for (int nb = 0; nb < 2; ++nb) { v2u pa, pb; pa.x = pk2(acc[nb][tb][8 * k2], acc[nb][tb][8 * k2 + 1]); pa.y = pk2(acc[nb][tb][8 * k2 + 2], acc[nb][tb][8 * k2 + 3]); pb.x = pk2(acc[nb][tb][8 * k2 + 4], acc[nb][tb][8 * k2 + 5]); pb.y = pk2(acc[nb][tb][8 * k2 + 6], acc[nb][tb][8 * k2 + 7]);
                    *(v4u*)(KN + (size_t)row * 384 + h * 96 + 32 * nb + 16 * k2 + 8 * hi) = pair16(pa, pb); }
                { v2u pa, pb; pa.x = pk2(kr[8 * k2], kr[8 * k2 + 1]); pa.y = pk2(kr[8 * k2 + 2], kr[8 * k2 + 3]); pb.x = pk2(kr[8 * k2 + 4], kr[8 * k2 + 5]); pb.y = pk2(kr[8 * k2 + 6], kr[8 * k2 + 7]);
                    *(v4u*)(KN + (size_t)row * 384 + h * 96 + 64 + 16 * k2 + 8 * hi) = pair16(pa, pb); }
#pragma unroll
                for (int nb = 2; nb < 4; ++nb) { v2u pa, pb; pa.x = pk2(acc[nb][tb][8 * k2] * slat, acc[nb][tb][8 * k2 + 1] * slat); pa.y = pk2(acc[nb][tb][8 * k2 + 2] * slat, acc[nb][tb][8 * k2 + 3] * slat); pb.x = pk2(acc[nb][tb][8 * k2 + 4] * slat, acc[nb][tb][8 * k2 + 5] * slat); pb.y = pk2(acc[nb][tb][8 * k2 + 6] * slat, acc[nb][tb][8 * k2 + 7] * slat);
                    *(v4u*)(VC + (size_t)row * 256 + h * 64 + 32 * (nb - 2) + 16 * k2 + 8 * hi) = pair16(pa, pb); } } }
    }
    __syncthreads();
}

__device__ __forceinline__ void sel_unit(unsigned char* ws, LAS unsigned char* lds, int unit, const int npass = 4, const bool ties = true, const bool force_simple = false) {
    int tid_ = threadIdx.x; asm volatile("" : "+v"(tid_));
    const int tid = tid_, lane = tid & 63, c16 = lane & 15, g = lane >> 4, w = __builtin_amdgcn_readfirstlane(tid >> 6);
    const int b = unit & 7, qblk = 63 - (unit >> 3), t0 = 32 * qblk + 4 * w, brow = b * SEQ;
    const bf16* t1 = (const bf16*)(ws + WS_R) + (size_t)1 * MH * 256; const bf16* xs = (const bf16*)(ws + WS_XS) + (size_t)brow * 128; const float* iwf = (const float*)(ws + WS_IWF);
    const int tq = t0 + g;
    const int nkt = (t0 + 3) / 16 + 1;
    const bf16x8 af = *(const bf16x8*)(t1 + (size_t)(brow + t0 + (c16 >> 2)) * 256 + 128 + (c16 & 3) * 32 + 8 * g);
    const f32x4 wv = *(const f32x4*)(iwf + (size_t)(brow + tq) * 4);
    constexpr float WS_ = 0.5f * 0.17677669529663687f;
    const float w0 = wv[0] * WS_, w1 = wv[1] * WS_, w2 = wv[2] * WS_, w3 = wv[3] * WS_;
    unsigned key[128];
    const int nblk = (nkt + 15) >> 4;
    const bf16* xsl = xs + (size_t)c16 * 128 + 8 * g;
#pragma unroll
    for (int blk = 0; blk < 8; ++blk) {
        if (blk < nblk) {
            bf16x8 bc[16];
#pragma unroll
            for (int rr = 0; rr < 16; ++rr) bc[rr] = *(const bf16x8*)(xsl + (size_t)(16 * (16 * blk + rr)) * 128);
            __builtin_amdgcn_sched_barrier(0);
#pragma unroll
            for (int rr = 0; rr < 16; ++rr) { const int r = 16 * blk + rr;
                pg8::f32x4 cz = {0.f, 0.f, 0.f, 0.f}; const pg8::f32x4 d = __builtin_amdgcn_mfma_f32_16x16x32_bf16(af, bc[rr], cz, 0, 0, 0);
                const float sc = __builtin_fmaf(fmaxf(d[3], 0.f), w3, __builtin_fmaf(fmaxf(d[2], 0.f), w2, __builtin_fmaf(fmaxf(d[1], 0.f), w1, fmaxf(d[0], 0.f) * w0)));
                key[r] = (16 * r + c16 <= tq) ? fkeyu(sc) : 0u; }
            __builtin_amdgcn_sched_barrier(0);
        } else {
#pragma unroll
            for (int rr = 0; rr < 16; ++rr) key[16 * blk + rr] = 0u;
        }
    }
    LAS unsigned* H = (LAS unsigned*)(lds + w * 4608) + g * 272;
    unsigned prefix = 0u; int rank = 256, binc = 0;
#pragma unroll 1
    for (int pass = 0; pass < npass; ++pass) { const int shift = 24 - 8 * pass;
        if (pass == 3 && __all(binc == rank)) break;
#pragma unroll
        for (int j = 0; j < 4; ++j) *(LAS v4u*)(H + 16 * c16 + 4 * j) = (v4u){0u, 0u, 0u, 0u};
        H[256 + c16] = 0u;
        const unsigned hp = pass == 0 ? 0u : (prefix >> ((shift + 8) & 31)); const unsigned hmask = pass == 0 ? 0u : 0xffffffffu;
#pragma unroll
        for (int blk = 0; blk < 8; ++blk) if (blk < nblk) {
#pragma unroll
            for (int rr = 0; rr < 16; ++rr) { const unsigned k = key[16 * blk + rr]; const bool mt = (((k >> ((shift + 8) & 31)) & hmask) == hp); const unsigned bin = mt ? ((k >> shift) & 255u) : (unsigned)(256 + c16);
                (void)__hip_atomic_fetch_add(H + bin, 1u, __ATOMIC_RELAXED, __HIP_MEMORY_SCOPE_WORKGROUP); } }
        unsigned hv[16];
#pragma unroll
        for (int j = 0; j < 4; ++j) { const v4u t = *(const LAS v4u*)(H + 16 * c16 + 4 * j); hv[4 * j] = t[0]; hv[4 * j + 1] = t[1]; hv[4 * j + 2] = t[2]; hv[4 * j + 3] = t[3]; }
        int sc = 0;
#pragma unroll
        for (int j = 0; j < 16; ++j) sc += (int)hv[j];
        int suf = sc;
#pragma unroll
        for (int d = 1; d < 16; d <<= 1) { const int o = bperm_i(lane + d, suf); if (c16 + d < 16) suf += o; }
        const int above_lane = suf - sc;
        const bool cross = (above_lane < rank) && (rank <= suf);
        int B = 0, above = 0, bc = 0;
        if (cross) { int run2 = above_lane; bool found = false;
#pragma unroll
            for (int j = 15; j >= 0; --j) { if (!found) { if (run2 + (int)hv[j] >= rank) { B = 16 * c16 + j; above = run2; bc = (int)hv[j]; found = true; } else run2 += (int)hv[j]; } } }
        const unsigned m16 = (unsigned)(__ballot(cross) >> (16 * g)) & 0xffffu;
        const int src = m16 ? (__ffs(m16) - 1) : 0;
        B = bperm_i((lane & 48) + src, B); above = bperm_i((lane & 48) + src, above); bc = bperm_i((lane & 48) + src, bc);
        if (!m16) { B = 0; above = 0; bc = -1; }
        prefix |= (unsigned)B << shift; rank -= above; binc = bc;
    }
    const unsigned T = prefix; const int need = rank;
    unsigned long long mw0 = 0ull, mw1 = 0ull;
    const int cnt_eq = npass > 0 ? binc : 0;
    const bool simple = (__all(cnt_eq == need && T != 0u) && ties) || force_simple;
    if (simple) {
#pragma unroll
        for (int blk = 0; blk < 8; ++blk) if (blk < nblk) {
#pragma unroll
            for (int rr = 0; rr < 16; ++rr) { const int r = 16 * blk + rr; const unsigned long long bs = __ballot(key[r] >= T);
                if (r < 64) mw0 = (lane == r) ? bs : mw0; else mw1 = (lane == r - 64) ? bs : mw1; } }
    } else {
        int run = 0;
#pragma unroll
        for (int blk = 0; blk < 8; ++blk) if (blk < nblk) {
#pragma unroll
            for (int rr = 0; rr < 16; ++rr) { const int r = 16 * blk + rr;
                const bool eq = key[r] == T; const unsigned long long bal = __ballot(eq); const unsigned m16 = (unsigned)(bal >> (16 * g)) & 0xffffu;
                const int rk = run + __popc(m16 & ((1u << c16) - 1u)); run += __popc(m16);
                const unsigned long long bs = __ballot((key[r] > T || (eq && rk < need)) && (16 * r + c16 <= tq));
                if (r < 64) mw0 = (lane == r) ? bs : mw0; else mw1 = (lane == r - 64) ? bs : mw1; } }
    }
    unsigned long long* mq = (unsigned long long*)(ws + WS_MASK) + (size_t)((brow + t0) >> 2) * 128;
    mq[lane] = mw0; mq[64 + lane] = mw1;
}
__device__ __forceinline__ void km_unit(unsigned char* ws, LAS unsigned char* lds, int unit) {
    int tid_ = threadIdx.x; asm volatile("" : "+v"(tid_)); const int tid = tid_, lane = tid & 63, w = tid >> 6; const int b = unit >> 3, n = unit & 7;
    const bf16* bk = (const bf16*)(ws + WS_R) + (size_t)6 * MH * 256 + (size_t)(b * SEQ + n * 256 + 32 * w) * 256 + 4 * lane;
    v2u v[32];
#pragma unroll
    for (int i = 0; i < 32; ++i) v[i] = *(const v2u*)(bk + (size_t)i * 256);
    float s0 = 0.f, s1 = 0.f, s2 = 0.f, s3 = 0.f;
#pragma unroll
    for (int i = 0; i < 32; ++i) { s0 += __uint_as_float(v[i].x << 16); s1 += __uint_as_float(v[i].x & 0xffff0000u); s2 += __uint_as_float(v[i].y << 16); s3 += __uint_as_float(v[i].y & 0xffff0000u); }
    LAS f32x4* red = (LAS f32x4*)lds; red[w * 64 + lane] = (f32x4){s0, s1, s2, s3};
    __syncthreads();
    if (w == 0) { f32x4 t = red[lane];
#pragma unroll
        for (int k = 1; k < 8; ++k) t += red[k * 64 + lane];
        *(f32x4*)((float*)(ws + WS_KMEAN) + (size_t)unit * 256 + 4 * lane) = t * (1.0f / 256.0f); }
    __syncthreads();
}
struct OneUnit { int pm, pn;
    __device__ __forceinline__ bool next(int i, pg8::Unit& u) const { if (i > 0) return false; u.pm = pm; u.pn = pn; u.ao = 0; u.bo = 0; return true; }
    __device__ __forceinline__ void a_ready(const pg8::Unit&) const {}
    __device__ __forceinline__ void done(const pg8::Unit&) const {} };
__device__ __forceinline__ void phase(unsigned char* ws, LAS unsigned char* lds, int l, const float* qk_c, unsigned* queue, const pg8::Gemm& gg, const EpiInProj& ge, const unsigned kmask = 15u) {
    for (;;) {
        if (threadIdx.x == 0) ((volatile LAS unsigned*)(lds + L_MISC))[0] = __hip_atomic_fetch_add(queue, 1u, __ATOMIC_RELAXED, __HIP_MEMORY_SCOPE_AGENT);
        __syncthreads();
        const int idx = (int)((volatile LAS unsigned*)(lds + L_MISC))[0];
        __syncthreads();
        if (idx >= NU_TOTAL) break;
        if (idx < NU_SEL / 2) { if (kmask & 2u) sel_unit(ws, lds, idx, (kmask & 16u) ? 0 : 4, !(kmask & 32u), (kmask & 64u) != 0u); }
        else if (idx < NU_SEL / 2 + NU_GEMM) { if (kmask & 8u) { OneUnit S1{idx - NU_SEL / 2, NT_IN - 1}; pg8::gemm_phase<EpiInProj, OneUnit, true, true>(lds, gg, S1, ge); __syncthreads(); } }
        else if (idx < NU_SEL / 2 + NU_GEMM + NU_MLA) { if (kmask & 4u) mla_unit(ws, lds, l, idx - NU_SEL / 2 - NU_GEMM, qk_c, kmask >> 7); }
        else if (idx < NU_SEL + NU_GEMM + NU_MLA) { if (kmask & 2u) sel_unit(ws, lds, idx - NU_GEMM - NU_MLA, (kmask & 16u) ? 0 : 4, !(kmask & 32u), (kmask & 64u) != 0u); }
        else { if (kmask & 1u) km_unit(ws, lds, idx - NU_SEL - NU_GEMM - NU_MLA); }
    }
}
}
constexpr int RING_BYTES = 131072, MISC_OFF = RING_BYTES + 320, LDS_BYTES = 147456;
#define LDS_WAIT() asm volatile("s_waitcnt lgkmcnt(0)" ::: "memory")
#define VM_WAIT() asm volatile("s_waitcnt vmcnt(0)" ::: "memory")

template <class CM> __device__ __forceinline__ void tr_item(const float* W, int ldw, int K, const float* rowgain, bf16* WT, int nblk, int item, LAS float* scr, int lane, CM cm) {
    const int kb = item / nblk, nb = item % nblk, k0 = 64 * kb, n0 = 32 * nb;
    const int sc = cm(n0 + (lane & 31));
    float tv[32];
#pragma unroll
    for (int i = 0; i < 32; ++i) { const int kk = 2 * i + (lane >> 5); tv[i] = sc >= 0 ? W[(size_t)(k0 + kk) * ldw + sc] : 0.f; }
#pragma unroll
    for (int i = 0; i < 32; ++i) { const int kk = 2 * i + (lane >> 5); float v = tv[i]; if (rowgain) v *= rowgain[k0 + kk]; scr[kk * 33 + (lane & 31)] = v; }
    LDS_WAIT(); asm volatile("" ::: "memory");
    const int c = lane & 7;
#pragma unroll
    for (int j = 0; j < 4; ++j) { const int n = (lane >> 3) + 8 * j; const LAS float* s = scr + (8 * c) * 33 + n;
        v4u o; o.x = pk2(s[0 * 33], s[1 * 33]); o.y = pk2(s[2 * 33], s[3 * 33]); o.z = pk2(s[4 * 33], s[5 * 33]); o.w = pk2(s[6 * 33], s[7 * 33]);
        *(v4u*)(WT + (size_t)(n0 + n) * K + k0 + 8 * c) = o; }
    LDS_WAIT(); asm volatile("" ::: "memory");
}
struct CmId { __device__ __forceinline__ int operator()(int n) const { return n; } };
struct CmFfnIn { __device__ __forceinline__ int operator()(int n) const { const int pn = n >> 8, c = n & 255; return c < 128 ? pn * 128 + c : DFF + pn * 128 + (c - 128); } };
struct CmInProj { __device__ __forceinline__ int operator()(int n) const { return inproj_srccol(n); } };
__device__ __forceinline__ int rel_bucket_dev(int n) { if (n < 16) return n; const int lb = 16 + (int)(logf((float)n / 16.f) / logf(128.f) * 16.f); return lb < 31 ? lb : 31; }

__device__ __forceinline__ void prologue(const Args& a, LAS unsigned char* lds, int vcu, int G, int wave, int lane) {
    unsigned char* ws = a.ws;
    LAS float* scr = (LAS float*)(lds + wave * 16384);
    const int gw = vcu * NWAVES + wave, NGW = G * NWAVES;
    const float* norm_gain = a.in[1]; const float* w_in = a.in[2]; const float* mla_nq = a.in[8]; const float* w_uq = a.in[9]; const float* mla_nkv = a.in[10]; const float* w_ukv = a.in[11];
    const float* w_branch = a.in[12]; const float* w_out = a.in[13]; const float* rel_bias = a.in[14]; const float* w_ffn_in = a.in[15]; const float* w_ffn_out = a.in[16];
    constexpr int I_FI = 16 * (5632 / 32), I_FO = 44 * 32, I_IN = 16 * (N_INP / 32), I_O = 16 * 32, I_B = 4 * 32, I_UQ = 6 * 12, I_UKV = 4 * 16;
    constexpr int NITEMS = 4 * I_FI + 4 * I_FO + 2 * I_IN + 2 * I_O + 8 * I_B; (void)I_UQ; (void)I_UKV;
    for (int it = gw; it < NITEMS; it += NGW) {
        int r = it;
        if (r < 4 * I_FI) { const int w = r / I_FI, l = w >> 1, f = w & 1; tr_item(w_ffn_in + (size_t)w * DM * 2 * DFF, 2 * DFF, DM, norm_gain + (l * 3 + (f ? 2 : 0)) * DM, (bf16*)(ws + WS_WFI) + (size_t)w * 5632 * DM, 5632 / 32, r % I_FI, scr, lane, CmFfnIn()); continue; } r -= 4 * I_FI;
        if (r < 4 * I_FO) { const int w = r / I_FO; tr_item(w_ffn_out + (size_t)w * DFF * DM, DM, DFF, nullptr, (bf16*)(ws + WS_WFO) + (size_t)w * DM * DFF, 32, r % I_FO, scr, lane, CmId()); continue; } r -= 4 * I_FO;
        if (r < 2 * I_IN) { const int l = r / I_IN; tr_item(w_in + (size_t)l * DM * INW, INW, DM, norm_gain + (l * 3 + 1) * DM, (bf16*)(ws + WS_WIN) + (size_t)l * N_INP * DM, N_INP / 32, r % I_IN, scr, lane, CmInProj()); continue; } r -= 2 * I_IN;
        if (r < 2 * I_O) { const int l = r / I_O; tr_item(w_out + (size_t)l * DM * DM, DM, DM, nullptr, (bf16*)(ws + WS_WO) + (size_t)l * DM * DM, 32, r % I_O, scr, lane, CmId()); continue; } r -= 2 * I_O;
        if (r < 8 * I_B) { const int w = r / I_B; tr_item(w_branch + (size_t)w * 256 * DM, DM, 256, nullptr, (bf16*)(ws + WS_WB) + (size_t)w * DM * 256, 32, r % I_B, scr, lane, CmId()); continue; } r -= 8 * I_B;
    }
    const float* x = a.in[0]; bf16* xb = (bf16*)(ws + WS_XB); float* ssq = (float*)(ws + WS_SSQ);
    for (int m0 = gw; m0 < M; m0 += 2 * NGW) {
        f32x4 v[2][4]; float sacc[2] = {0.f, 0.f};
#pragma unroll
        for (int r = 0; r < 2; ++r) { const int m = m0 + r * NGW; if (m < M) { const f32x4* xr = (const f32x4*)(x + (size_t)m * DM) + lane;
#pragma unroll
                for (int j = 0; j < 4; ++j) v[r][j] = xr[64 * j]; } }
#pragma unroll
        for (int r = 0; r < 2; ++r) { const int m = m0 + r * NGW; if (m < M) { unsigned long long* o8 = (unsigned long long*)(xb + (size_t)m * DM) + lane;
#pragma unroll
                for (int j = 0; j < 4; ++j) { const f32x4 t = v[r][j]; o8[64 * j] = (unsigned long long)pk2(t[0], t[1]) | ((unsigned long long)pk2(t[2], t[3]) << 32);
                    sacc[r] += (t[0] * t[0] + t[1] * t[1]) + (t[2] * t[2] + t[3] * t[3]); } } }
#pragma unroll
        for (int r = 0; r < 2; ++r) { const int m = m0 + r * NGW; float s = sacc[r];
            s += bperm_f(lane ^ 1, s); s += bperm_f(lane ^ 2, s); s += bperm_f(lane ^ 4, s); s += bperm_f(lane ^ 8, s); s += bperm_f(lane ^ 16, s); s = xsum32(s);
            if (m < M && lane < 16) ssq[(size_t)m * 16 + lane] = lane == 0 ? s : 0.f; }
    }
    const int gt = gw * 64 + lane, NGT = NGW * 64;
    for (int i = gt; i < 2 * 4 * 24 * 3 * 64; i += NGT) { const int ln = i & 63, nb = (i >> 6) % 3, s = ((i >> 6) / 3) % 24, h = ((i >> 6) / 72) & 3, l = (i >> 6) / 288; const int n = 96 * h + 32 * nb + (ln & 31), k0 = 16 * s + 8 * (ln >> 5);
        float v[8];
#pragma unroll
        for (int j = 0; j < 8; ++j) v[j] = w_uq[(size_t)l * 384 * 384 + (size_t)(k0 + j) * 384 + n] * mla_nq[l * 384 + k0 + j];
        v4u o; o.x = pk2(v[0], v[1]); o.y = pk2(v[2], v[3]); o.z = pk2(v[4], v[5]); o.w = pk2(v[6], v[7]); *(v4u*)(ws + WS_WUQ + (size_t)i * 16) = o; }
    for (int i = gt; i < 2 * 4 * 16 * 4 * 64; i += NGT) { const int ln = i & 63, nb = (i >> 6) & 3, s = (i >> 8) & 15, h = (i >> 12) & 3, l = i >> 14; const int n = 128 * h + 32 * nb + (ln & 31), k0 = 16 * s + 8 * (ln >> 5);
        float v[8];
#pragma unroll
        for (int j = 0; j < 8; ++j) v[j] = w_ukv[(size_t)l * 256 * 512 + (size_t)(k0 + j) * 512 + n] * mla_nkv[l * 256 + k0 + j];
        v4u o; o.x = pk2(v[0], v[1]); o.y = pk2(v[2], v[3]); o.z = pk2(v[4], v[5]); o.w = pk2(v[6], v[7]); *(v4u*)(ws + WS_WUKV + (size_t)i * 16) = o; }
    float* bias = (float*)(ws + WS_BIAS); float* biasd = (float*)(ws + WS_BIASD); float* rope = (float*)(ws + WS_ROPE);
    for (int i = gt; i < 20 * 2112; i += NGT) { const int h = i / 2112, d = i % 2112 - 64; bias[i] = d >= 0 ? rel_bias[h * 32 + rel_bucket_dev(d)] * LOG2E : 0.f; }
    for (int i = gt; i < 12 * 192; i += NGT) { const int gh = i / 192, sd = i % 192, g = gh >> 2, dil = g == 0 ? 1 : g == 1 ? 4 : 16; const int d = sd * dil; biasd[i] = (sd <= 128) ? rel_bias[(8 + gh) * 32 + rel_bucket_dev(d)] * LOG2E : 0.f; }
    { unsigned char* bid = ws + WS_BID; for (int i = gt; i < 2112; i += NGT) { const int d = i - 64; bid[i] = (unsigned char)(d >= 0 ? rel_bucket_dev(d) : 0); } }
    for (int i = gt; i < SEQ * 16; i += NGT) { const int t = i >> 4, j = i & 15; const float fr = powf(10000.f, -(float)j / 16.f), ang = (float)t * fr; rope[i] = cosf(ang); rope[SEQ * 16 + i] = sinf(ang); }
}

typedef __attribute__((address_space(4))) const Args KArgs;
__global__ void __launch_bounds__(NTHR, 2) mega(Args args) {
    extern __shared__ __attribute__((aligned(16))) unsigned char lds_raw[];
    LAS unsigned char* lds0 = (LAS unsigned char*)lds_raw; LAS unsigned char* lds = lds0;
    volatile LAS unsigned* MISC = (volatile LAS unsigned*)(lds + MISC_OFF);
    const int tid = threadIdx.x, lane = tid & 63, wave = __builtin_amdgcn_readfirstlane(tid >> 6);
    const int G = gridDim.x; const int bx = blockIdx.x; const int vcu = (G % 8 == 0) ? (bx % 8) * (G / 8) + bx / 8 : bx;
    unsigned char* const ws0 = args.ws; unsigned char* ws = ws0; unsigned* ctl = (unsigned*)(ws + WS_CTL);
    for (int u = tid; u < (LDS_BYTES - RING_BYTES) / 4; u += NTHR) ((LAS unsigned*)(lds + RING_BYTES))[u] = 0u;
    __syncthreads();
    XcdBarrier bar = xcd_barrier_post(ctl + CW_BAR, MISC + 8);
    const int lo = args.ph_lo, hi = args.ph_hi;
#ifdef PROBE_T
    if (threadIdx.x == 0) { volatile LAS unsigned long long* pt_ = (volatile LAS unsigned long long*)(lds0 + 131072 + 2048); pt_[0] = 0ull; pt_[1] = __builtin_amdgcn_s_memrealtime(); }
#endif
#define IN(k) (lo <= (k) && (k) < hi)
#define PHASE_LOCALS LAS unsigned char* lds = lds0; const KArgs* ap = (const KArgs*)__builtin_amdgcn_kernarg_segment_ptr(); asm volatile("" : "+s"(lds), "+s"(ap)); unsigned char* ws = ap->ws;
#ifdef PROBE_BAR
#define SEAM(k) do { if (IN(k) && IN((k) + 1)) { xcd_barrier(bar); xcd_barrier(bar); } } while (0)
#else
#ifdef PROBE_T
#if PROBE_T == 99
#define PTICK(c) do {} while (0)
#else
#define PTICK(c) do { if (threadIdx.x == 0) { volatile LAS unsigned long long* pt_ = (volatile LAS unsigned long long*)(lds0 + 131072 + 2048); const unsigned long long n_ = __builtin_amdgcn_s_memrealtime(); \
        if ((c) == PROBE_T) pt_[0] += n_ - pt_[1]; pt_[1] = n_; } } while (0)
#endif
#else
#define PTICK(c) do {} while (0)
#endif
#define SEAMC(k, c) do { if (IN(k) && IN((k) + 1)) xcd_barrier(bar); PTICK(c); } while (0)
#endif
    #ifndef NOPRO
    if (IN(PH_PRO)) { PHASE_LOCALS; (void)ws; (void)ap; prologue(args, lds, vcu, G, wave, lane); }
#ifdef PROBE_PRO2
    if (IN(PH_PRO)) { xcd_barrier(bar); PHASE_LOCALS; (void)ws; prologue(args, lds, vcu, G, wave, lane); xcd_barrier(bar); prologue(args, lds, vcu, G, wave, lane); xcd_barrier(bar); prologue(args, lds, vcu, G, wave, lane); }
#endif
#endif
    SEAMC(PH_PRO, 0);
    for (int l = 0; l < DEPTH; ++l) {
        const int pb = PH_L0 + l * PH_PER_LAYER;
#pragma unroll 1
        for (int f = 0; f < 2; ++f) {
            if (f == 1) {
#pragma unroll 1
                for (int hf = 0; hf < 2; ++hf) {
                    const int ph = pb + PO_INP + 6 * hf;
#ifndef NOINP
                    if (IN(ph)) {
                        PHASE_LOCALS; bf16* const xb = (bf16*)(ws + WS_XB); float* const ssq = (float*)(ws + WS_SSQ);
                        pg8::Gemm g{xb + (size_t)hf * MH * DM, (const bf16*)(ws + WS_WIN) + (size_t)l * N_INP * DM, MH, N_INP - 256, DM}; pg8::StaticOrder S; S.init(MH, N_INP - 256, G, bx, WGM_INP);
                        EpiInProj E{ssq + (size_t)hf * MH * 16, ws, ap->in[4] + l * 128, ap->in[5] + l * 128, ap->in[7] + l * 128, ap->in[3] + (size_t)l * 4 * DM};
#ifdef SKEW_TICKS
                        { const unsigned long long t0_ = __builtin_amdgcn_s_memrealtime(), d_ = (unsigned long long)((bx & 7) * SKEW_TICKS); while (__builtin_amdgcn_s_memrealtime() - t0_ < d_) __builtin_amdgcn_s_sleep(1); }
#endif
                        pg8::gemm_phase<EpiInProj, pg8::StaticOrder, true, true>(lds, g, S, E);
#ifdef PROBE_INP2
                        xcd_barrier(bar); pg8::gemm_phase<EpiInProj, pg8::StaticOrder, true, true>(lds, g, S, E);
#endif
                    }
#endif
                    SEAMC(ph, 3);
#ifndef NOPREP
                    if (IN(ph + 1)) { PHASE_LOCALS; bf16* const xb = (bf16*)(ws + WS_XB); float* const ssq = (float*)(ws + WS_SSQ); int kq = DM; asm volatile("" : "+s"(kq));
                        pg8::Gemm gg{xb + (size_t)hf * MH * DM, (const bf16*)(ws + WS_WIN) + (size_t)l * N_INP * DM, MH, N_INP, kq};
                        EpiInProj ge{ssq + (size_t)hf * MH * 16, ws, ap->in[4] + l * 128, ap->in[5] + l * 128, ap->in[7] + l * 128, ap->in[3] + (size_t)l * 4 * DM};
#ifdef PROBE_PREP3
                        { unsigned pk_ = PROBE_PREP3; asm volatile("" : "+s"(pk_)); prep::phase(ws, lds, l, ap->in[6] + l * 192, (unsigned*)(ws + WS_CTL) + CW_QUEUE + 64 * (16 + l * 2 + hf), gg, ge, pk_); xcd_barrier(bar); }
#endif
                        prep::phase(ws, lds, l, ap->in[6] + l * 192, (unsigned*)(ws + WS_CTL) + CW_QUEUE + 64 * (8 + l * 2 + hf), gg, ge);
                    }
#ifdef PROBE_PREP2_OLD
                    if (IN(ph + 1)) { xcd_barrier(bar); PHASE_LOCALS; prep::phase(ws, lds, l, ap->in[6] + l * 192, (unsigned*)(ws + WS_CTL) + CW_QUEUE + 64 * (16 + l * 2 + hf), gg, ge, PROBE_PREP2); }
#endif
#endif
                    SEAMC(ph + 1, 4);
#ifdef PROBE_ATT2
                    if (IN(ph + 2)) { PHASE_LOCALS; att::phase(ws, lds, (unsigned*)(ws + WS_CTL) + CW_QUEUE + 64 * (24 + l * 2 + hf), true, PROBE_ATT2); xcd_barrier(bar); }
#endif
                    if (IN(ph + 2)) { PHASE_LOCALS; att::phase(ws, lds, (unsigned*)(ws + WS_CTL) + CW_QUEUE + 64 * (l * 2 + hf)); }
                    SEAMC(ph + 2, 5);
                    if (IN(ph + 4)) {
                        PHASE_LOCALS;
                        int kq = 256; asm volatile("" : "+s"(kq));
                        pg8::Gemm g{(const bf16*)(ws + WS_R), (const bf16*)(ws + WS_WB) + (size_t)l * 4 * DM * 256, MH, DM, kq};
                        MergeOrder S; S.S.init(MH, DM, G, bx); S.a1 = (int)(5 * TILE_B); S.a2 = (int)(WS_OC - WS_R); S.a3 = (int)(WS_DC - WS_R);
                        unsigned* cnt = (unsigned*)(ws + WS_CTL) + CW_SEAM + (l * 2 + hf) * 64 * 64; S.ready = cnt; S.tmo = (unsigned*)(ws + WS_CTL) + 2;
                        {
                            const bf16* tiles = (const bf16*)(ws + WS_R); const float* lse = (const float*)(ws + WS_LSED); bf16* dc = (bf16*)(ws + WS_DC);
                            int tid_ = threadIdx.x; asm volatile("" : "+v"(tid_)); const int ln = tid_ & 63, wv = tid_ >> 6, h = ln >> 4;
                            pg8::Unit tu;
                            for (int i = 0; S.S.next(i, tu); ++i) {
#pragma unroll 1
                                for (int half = 0; half < 2; ++half) { const int rbase = tu.pm * 256 + tu.pn * 64 + wv * 8 + half * 4;
                                    v2u va[4], vb[4], vc[4]; float la[4], lb[4], lc[4];
#pragma unroll
                                    for (int r = 0; r < 4; ++r) { const int row = rbase + r; const size_t o = (size_t)row * 256 + 4 * ln;
                                        la[r] = lse[(size_t)row * 16 + h]; lb[r] = lse[(size_t)row * 16 + 4 + h]; lc[r] = lse[(size_t)row * 16 + 8 + h];
                                        va[r] = *(const v2u*)(tiles + (size_t)8 * MH * 256 + o); vb[r] = *(const v2u*)(tiles + (size_t)9 * MH * 256 + o); vc[r] = *(const v2u*)(tiles + (size_t)10 * MH * 256 + o); }
#pragma unroll
                                    for (int r = 0; r < 4; ++r) { const int row = rbase + r;
                                        const float l0 = la[r], l1 = lb[r], l2 = lc[r], mx = fmaxf(l0, fmaxf(l1, l2));
                                        const float e0 = __builtin_amdgcn_exp2f(l0 - mx), e1 = __builtin_amdgcn_exp2f(l1 - mx), e2 = __builtin_amdgcn_exp2f(l2 - mx), inv = 1.0f / (e0 + e1 + e2);
                                        const v2u a = va[r], b = vb[r], c = vc[r];
                                        const unsigned lo = pk2((e0 * __uint_as_float(a.x << 16) + e1 * __uint_as_float(b.x << 16) + e2 * __uint_as_float(c.x << 16)) * inv, (e0 * __uint_as_float(a.x & 0xffff0000u) + e1 * __uint_as_float(b.x & 0xffff0000u) + e2 * __uint_as_float(c.x & 0xffff0000u)) * inv);
                                        const unsigned hi2 = pk2((e0 * __uint_as_float(a.y << 16) + e1 * __uint_as_float(b.y << 16) + e2 * __uint_as_float(c.y << 16)) * inv, (e0 * __uint_as_float(a.y & 0xffff0000u) + e1 * __uint_as_float(b.y & 0xffff0000u) + e2 * __uint_as_float(c.y & 0xffff0000u)) * inv);
                                        __hip_atomic_store((unsigned long long*)(dc + (size_t)row * 256 + 4 * ln), ((unsigned long long)hi2 << 32) | lo, __ATOMIC_RELAXED, __HIP_MEMORY_SCOPE_AGENT); } }
                                asm volatile("s_waitcnt vmcnt(0)" ::: "memory");
                                if (ln == 0) (void)__hip_atomic_fetch_add(cnt + 64 * tu.pm, 1u, __ATOMIC_RELAXED, __HIP_MEMORY_SCOPE_AGENT);
                            }
                        }
                        EpiMerge E{(const bf16*)(ws + WS_R) + (size_t)17 * MH * 256, (bf16*)(ws + WS_U)};
                        pg8::gemm_phase<EpiMerge, MergeOrder, true, true>(lds, g, S, E);
#ifdef PROBE_MRG4
                        { EpiMergeCheap Ec{(bf16*)(ws + WS_U)}; xcd_barrier(bar); pg8::gemm_phase<EpiMergeCheap, MergeOrder, true, true>(lds, g, S, Ec); xcd_barrier(bar); pg8::gemm_phase<EpiMerge, MergeOrder, true, true>(lds, g, S, E); }
#endif
#ifdef PROBE_MRG3
                        xcd_barrier(bar); pg8::gemm_phase<EpiMerge, MergeOrder, true, true>(lds, g, S, E);
#endif
                    }
                    SEAMC(ph + 4, 6);
#ifndef NORES
                    if (IN(ph + 5)) {
                        PHASE_LOCALS; bf16* const xb = (bf16*)(ws + WS_XB); float* const ssq = (float*)(ws + WS_SSQ);
                        pg8::Gemm g{(const bf16*)(ws + WS_U), (const bf16*)(ws + WS_WO) + (size_t)l * DM * DM, MH, DM, DM}; pg8::StaticOrder S; S.init(MH, DM, G, bx);
                        EpiResid E{nullptr, xb + (size_t)hf * MH * DM, ssq + (size_t)hf * MH * 16, 1.0f};
                        pg8::gemm_phase<EpiResid, pg8::StaticOrder, true, true>(lds, g, S, E);
                    }
#endif
                    SEAMC(ph + 5, 7);
                }
            }
            const int p1 = pb + (f ? PO_F2I : PO_F1I);
#ifdef PROBE_K
            if (IN(p1) && l == 1 && f == 1) {
                PHASE_LOCALS;
#if PROBE_K != 2
                pg8::Gemm g2{(const bf16*)(ws + WS_XB), (const bf16*)(ws + WS_WFI) + (size_t)(l * 2 + f) * 5632 * DM, M, 5632, DM};
#else
                pg8::Gemm g2{(const bf16*)(ws + WS_R), (const bf16*)(ws + WS_WFI), M, 5632, 2048};
#endif
                pg8::StaticOrder S; S.init(M, 5632, G, bx, WGM_FFI);
#if PROBE_K == 5
                EpiFfnIn Ef{(const float*)(ws + WS_SSQ), (bf16*)(ws + WS_R)};
#pragma unroll 1
                for (int rep = 0; rep < 3; ++rep) { pg8::gemm_phase<EpiFfnIn, pg8::StaticOrder, true, true>(lds, g2, S, Ef); xcd_barrier(bar); }
#elif PROBE_K >= 3
                EpiFfnInCheap Ec{(const float*)(ws + WS_SSQ), (bf16*)(ws + WS_R)}; pg8::gemm_phase<EpiFfnInCheap, pg8::StaticOrder, true, true>(lds, g2, S, Ec); xcd_barrier(bar);
#else
                EpiNull En{(float*)(ws + WS_CTL) + 8};
                pg8::gemm_phase<EpiNull, pg8::StaticOrder, true, true>(lds, g2, S, En); xcd_barrier(bar);
#endif
            }
#endif
#ifndef NOFFNI
            if (IN(p1)) {
                PHASE_LOCALS; bf16* const xb = (bf16*)(ws + WS_XB); float* const ssq = (float*)(ws + WS_SSQ); bf16* const h2 = (bf16*)(ws + WS_R);
                pg8::Gemm g{xb, (const bf16*)(ws + WS_WFI) + (size_t)(l * 2 + f) * 5632 * DM, M, 5632, DM}; pg8::StaticOrder S; S.init(M, 5632, G, bx, WGM_FFI);
                EpiFfnIn E{ssq, h2};
#ifdef PROBE_FFI3
                { EpiFfnInCheap Ec{ssq, h2}; pg8::gemm_phase<EpiFfnInCheap, pg8::StaticOrder, true, true>(lds, g, S, Ec); xcd_barrier(bar); }
#endif
                pg8::gemm_phase<EpiFfnIn, pg8::StaticOrder, true, true>(lds, g, S, E);
#ifdef PROBE_FFI2
                xcd_barrier(bar); pg8::gemm_phase<EpiFfnIn, pg8::StaticOrder, true, true>(lds, g, S, E);
#endif
            }
#endif
            SEAMC(p1, 1);
#ifndef NORES2
            if (IN(p1 + 1)) {
                PHASE_LOCALS; bf16* const xb = (bf16*)(ws + WS_XB); float* const ssq = (float*)(ws + WS_SSQ); bf16* const h2 = (bf16*)(ws + WS_R);
                float* const xout = (l == DEPTH - 1 && f == 1) ? ap->out : nullptr;
                pg8::Gemm g{h2, (const bf16*)(ws + WS_WFO) + (size_t)(l * 2 + f) * DM * DFF, M, DM, DFF}; pg8::StaticOrder S; S.init(M, DM, G, bx, WGM_FFO);
                EpiResid E{xout, xb, ssq, 0.5f};
                pg8::gemm_phase<EpiResid, pg8::StaticOrder, true, true>(lds, g, S, E);
            }
#endif
            SEAMC(p1 + 1, 2);
        }
    }
#ifdef PROBE_T
    if (blockIdx.x == 0 && threadIdx.x == 0) { volatile LAS unsigned long long* pt_ = (volatile LAS unsigned long long*)(lds0 + 131072 + 2048); const unsigned long long t0_ = __builtin_amdgcn_s_memrealtime(), w_ = 8ull * (PROBE_T == 99 ? t0_ - pt_[1] : pt_[0]);
        while (__builtin_amdgcn_s_memrealtime() - t0_ < w_) __builtin_amdgcn_s_sleep(8); }
#endif
#undef IN
#undef SEAMC
}
static void launch_mega(const Args& a0, int lo, int hi, int grid, hipStream_t st) {
    Args a = a0; a.ph_lo = lo; a.ph_hi = hi;
    hipMemsetAsync(a.ws + WS_CTL, 0, CTL_BYTES, st);
    hipLaunchKernelGGL(mega, dim3(grid), dim3(NTHR), LDS_BYTES, st, a);
}
extern "C" void kernel_launch(void* const* d_in, const int* in_sizes, int n_in, void* d_out, int out_size, void* d_ws, size_t ws_size, hipStream_t stream) {
    static int grid = 0;
    if (grid == 0) {
        if (n_in != 17 || ws_size < WS_END) { fprintf(stderr, "kernel_launch: unexpected n_in %d / ws %zu\n", n_in, ws_size); grid = -1; return; }
        int dev = 0, cus = 0; hipGetDevice(&dev); hipDeviceGetAttribute(&cus, hipDeviceAttributeMultiprocessorCount, dev);
        if (hipFuncSetAttribute((const void*)mega, hipFuncAttributeMaxDynamicSharedMemorySize, LDS_BYTES) != hipSuccess) { fprintf(stderr, "hipFuncSetAttribute failed\n"); grid = -1; return; }
        int per_cu = 0; hipOccupancyMaxActiveBlocksPerMultiprocessor(&per_cu, (const void*)mega, NTHR, LDS_BYTES); (void)hipGetLastError();
        if (per_cu < 1) fprintf(stderr, "note: occupancy query says %d\n", per_cu);
        grid = cus;
    }
    if (grid < 0) return;
    Args a{}; for (int i = 0; i < 17; ++i) a.in[i] = (const float*)d_in[i]; a.out = (float*)d_out; a.ws = (unsigned char*)d_ws; a.ph_lo = 0; a.ph_hi = 0;
    int cur = 0;
    launch_mega(a, cur, N_PHASES, grid, stream);
}
```
